# Optimizing an MI355X kernel written in HIP

```python
import math
import jax, jax.numpy as jnp
from jax import lax
import numpy as np

D_MODEL = 2048
BATCH = 2
SEQ = 4096
DEPTH = 2

GRID_W = 64
CTX_LEN = 256
NA_HEADS = 16
NA_HEAD_DIM = 64
NA_WIN_R = 8
NA_WIN_C = 16
GLA_HEADS = 4
GLA_DK = 64
GLA_DV = 128
GLA_GATE_RANK = 16
GLA_GATE_TAU = 16.0
GLA_CHUNK = 64
GDN_HEADS = 4
GDN_DK = 128
GDN_DV = 128
GDN_CONV = 5
GDN_CHUNK = 64
NA_W = NA_HEADS * NA_HEAD_DIM
GLA_W = GLA_HEADS * GLA_DV
GDN_W = GDN_HEADS * GDN_DV
GDN_QKV_W = 2 * GDN_HEADS * GDN_DK + GDN_W
MIX_W = NA_W + GLA_W + GDN_W
IN_SPLITS = (
    NA_W, NA_W, NA_W,
    GLA_HEADS * GLA_DK, GLA_HEADS * GLA_DK, GLA_W, GLA_W,
    2 * GLA_GATE_RANK,
    GDN_QKV_W,
    GDN_W,
    2 * GDN_HEADS, 2 * GDN_HEADS,
)
IN_W = sum(IN_SPLITS)
N_EXPERTS = 16
EXPERT_FF = 2048
EC_CAPACITY = 2
ROPE_BASE = 10000.0
NORM_EPS = 1e-6

kernel_name = "hybrid_na_gla_gdn_ec_moe_prefix_dit"


def rmsnorm(x, w):
    xf = x.astype(jnp.float32)
    y = xf * lax.rsqrt(jnp.mean(xf * xf, axis=-1, keepdims=True) + NORM_EPS)
    return (y * w.astype(jnp.float32)).astype(x.dtype)


def l2norm(x):
    return x * lax.rsqrt(jnp.sum(x * x, axis=-1, keepdims=True) + 1e-6)


def split_proj(p):
    return jnp.split(p, np.cumsum(IN_SPLITS)[:-1].tolist(), axis=-1)


def to_heads(a, n_heads):
    b, t, _ = a.shape
    return jnp.swapaxes(a.reshape(b, t, n_heads, -1), 1, 2).astype(jnp.float32)


def axial_rope(x, row_pos, col_pos):
    half = x.shape[-1] // 2
    nf = half // 2
    freqs = ROPE_BASE ** (-jnp.arange(nf, dtype=jnp.float32) / nf)

    def rot(xp, pos):
        ang = jnp.asarray(pos, jnp.float32)[:, None] * freqs[None, :]
        cos = jnp.cos(ang).astype(x.dtype)[None, :, None, :]
        sin = jnp.sin(ang).astype(x.dtype)[None, :, None, :]
        x1, x2 = xp[..., :nf], xp[..., nf:]
        return jnp.concatenate([x1 * cos - x2 * sin, x2 * cos + x1 * sin], axis=-1)

    return jnp.concatenate([rot(x[..., :half], row_pos), rot(x[..., half:], col_pos)], axis=-1)


def na_latent(q, k, v, k_ctx, v_ctx, rpb):
    b, s, h, dh = q.shape
    rows = s // GRID_W
    wr = min(NA_WIN_R, rows)
    r = np.arange(rows)
    ridx = np.clip(r - wr // 2, 0, rows - wr)[:, None] + np.arange(wr)[None, :]
    cq = np.arange(GRID_W)
    cstart = np.clip(cq - NA_WIN_C // 2, 0, GRID_W - NA_WIN_C)
    colmask = (cq[None, :] >= cstart[:, None]) & (cq[None, :] < cstart[:, None] + NA_WIN_C)
    dr = ridx - r[:, None] + NA_WIN_R - 1
    dc = np.clip(cq[None, :] - cq[:, None] + NA_WIN_C - 1, 0, 2 * NA_WIN_C - 2)
    bias = rpb[:, dr[:, None, :, None], dc[None, :, None, :]].astype(jnp.float32)
    bias = jnp.where(colmask[None, None, :, None, :], bias, -jnp.inf).reshape(h, rows, GRID_W, wr * GRID_W)
    qg = (q * dh ** -0.5).reshape(b, rows, GRID_W, h, dh)
    kg = k.reshape(b, rows, GRID_W, h, dh)[:, ridx]
    vg = v.reshape(b, rows, GRID_W, h, dh)[:, ridx]
    n_loc = wr * GRID_W
    s_loc = jnp.einsum('brqhd,brjkhd->bhrqjk', qg, kg).astype(jnp.float32).reshape(b, h, rows, GRID_W, n_loc) + bias
    s_ctx = jnp.einsum('brqhd,blhd->bhrql', qg, k_ctx).astype(jnp.float32)
    p = jax.nn.softmax(jnp.concatenate([s_loc, s_ctx], axis=-1), axis=-1).astype(v.dtype)
    p_loc = p[..., :n_loc].reshape(b, h, rows, GRID_W, wr, GRID_W)
    o = (jnp.einsum('bhrqjk,brjkhd->brqhd', p_loc, vg)
         + jnp.einsum('bhrql,blhd->brqhd', p[..., n_loc:], v_ctx))
    return o.reshape(b, s, h * dh)


def na_context(q, k, v):
    b, l, h, dh = q.shape
    s = jnp.einsum('blhd,bmhd->bhlm', q * dh ** -0.5, k).astype(jnp.float32)
    p = jax.nn.softmax(s, axis=-1).astype(v.dtype)
    return jnp.einsum('bhlm,bmhd->blhd', p, v).reshape(b, l, h * dh)


def gla_chunked(q, k, v, log_a, s0):
    b, h, t, dk = q.shape
    dv = v.shape[-1]
    n = t // GLA_CHUNK
    ar = np.arange(GLA_CHUNK)
    incl = ar[:, None] >= ar[None, :]

    def chunks(a):
        return jnp.moveaxis(a.reshape(b, h, n, GLA_CHUNK, a.shape[-1]), 2, 0)

    def step(state, xs):
        qc, kc, vc, lac = xs
        cum = jnp.cumsum(lac, axis=2)
        diff = jnp.where(incl[None, None, :, :, None], cum[:, :, :, None, :] - cum[:, :, None, :, :], -jnp.inf)
        att = jnp.einsum('bhtd,bhsd,bhtsd->bhts', qc, kc, jnp.exp(diff))
        o = jnp.einsum('bhtd,bhde->bhte', qc * jnp.exp(cum), state) + jnp.einsum('bhts,bhse->bhte', att, vc)
        last = cum[:, :, -1:, :]
        state = (jnp.exp(last[:, :, 0, :])[..., None] * state
                 + jnp.einsum('bhsd,bhse->bhde', kc * jnp.exp(last - cum), vc))
        return state, o

    state, o = lax.scan(step, s0, tuple(chunks(a) for a in (q, k, v, log_a)))
    return state, jnp.moveaxis(o, 0, 2).reshape(b, h, t, dv)


def gdn_chunked(q, k, v, g, beta, s0):
    b, h, t, dk = q.shape
    dv = v.shape[-1]
    cs = GDN_CHUNK
    n = t // cs
    q = q.reshape(b, h, n, cs, dk)
    k = k.reshape(b, h, n, cs, dk)
    v = v.reshape(b, h, n, cs, dv)
    gc = jnp.cumsum(g.reshape(b, h, n, cs), axis=-1)
    beta = beta.reshape(b, h, n, cs)
    ar = np.arange(cs)
    incl = ar[:, None] >= ar[None, :]
    strict = ar[:, None] > ar[None, :]
    decay = jnp.exp(jnp.where(incl, gc[..., :, None] - gc[..., None, :], -jnp.inf))
    kb = k * beta[..., None]
    m = jnp.where(strict, jnp.einsum('bhntd,bhnsd->bhnts', kb, k) * decay, 0.0)
    lower = m + jnp.eye(cs, dtype=m.dtype)
    rhs = jnp.concatenate([v * beta[..., None], kb * jnp.exp(gc)[..., None]], axis=-1)
    sol = lax.linalg.triangular_solve(lower, rhs, left_side=True, lower=True)
    u, w = sol[..., :dv], sol[..., dv:]
    a_qk = jnp.einsum('bhntd,bhnsd->bhnts', q, k) * decay
    q_dec = q * jnp.exp(gc)[..., None]
    k_dec = k * jnp.exp(gc[..., -1:] - gc)[..., None]
    g_last = jnp.exp(gc[..., -1])

    def step(state, xs):
        u_c, w_c, qd_c, a_c, kd_c, gl_c = xs
        v_new = u_c - jnp.einsum('bhtd,bhde->bhte', w_c, state)
        o = jnp.einsum('bhtd,bhde->bhte', qd_c, state) + jnp.einsum('bhts,bhse->bhte', a_c, v_new)
        state = state * gl_c[..., None, None] + jnp.einsum('bhsd,bhse->bhde', kd_c, v_new)
        return state, o

    xs = tuple(jnp.moveaxis(a, 2, 0) for a in (u, w, q_dec, a_qk, k_dec, g_last))
    state, o = lax.scan(step, s0, xs)
    return state, jnp.moveaxis(o, 0, 2).reshape(b, h, t, dv)


def bidir_scan(scan_fn, ctx_f, ctx_b, lat_f, lat_b, s0):
    def flip(args):
        return tuple(jnp.flip(a, axis=2) for a in args)
    s_cf, o_cf = scan_fn(*ctx_f, s0)
    s_cb, o_cb = scan_fn(*flip(ctx_b), s0)
    _, o_xf = scan_fn(*lat_f, s_cf)
    _, o_xb = scan_fn(*flip(lat_b), s_cb)
    return o_xf + jnp.flip(o_xb, axis=2), o_cf + jnp.flip(o_cb, axis=2)


def gated_head_norm(o, gate, norm_w, dtype):
    b, h, t, dv = o.shape
    o = rmsnorm(jnp.swapaxes(o, 1, 2), norm_w).reshape(b, t, h * dv)
    return (o * jax.nn.silu(gate.astype(jnp.float32))).astype(dtype)


def short_conv(u, w):
    kw = w.shape[0]
    y = lax.conv_general_dilated(u, w[:, None, :], window_strides=(1,), padding=((kw // 2, kw // 2),),
                                 dimension_numbers=('NWC', 'WIO', 'NWC'), feature_group_count=u.shape[-1])
    return jax.nn.silu(y)


def gla_prep(p, gate_w, gate_b, row_pos, col_pos, rope):
    q, k, v, g, lr = p[3:8]
    b, t, _ = q.shape
    if rope:
        q = axial_rope(q.reshape(b, t, GLA_HEADS, GLA_DK), row_pos, col_pos).reshape(b, t, -1)
        k = axial_rope(k.reshape(b, t, GLA_HEADS, GLA_DK), row_pos, col_pos).reshape(b, t, -1)
    z = jnp.einsum('btnr,nrk->nbtk', lr.reshape(b, t, 2, GLA_GATE_RANK), gate_w) + gate_b[:, None, None, :]
    log_a = jax.nn.log_sigmoid(z.astype(jnp.float32)) / GLA_GATE_TAU
    qh = to_heads(q, GLA_HEADS) * GLA_DK ** -0.5
    return (qh, to_heads(k, GLA_HEADS), to_heads(v, GLA_HEADS),
            to_heads(log_a[0], GLA_HEADS), to_heads(log_a[1], GLA_HEADS), g)


def gdn_prep(p, conv_w, a_log, dt_bias):
    qkv, z, a, bb = p[8:12]
    b, t, _ = qkv.shape
    qkv = short_conv(qkv, conv_w)
    q, k, v = jnp.split(qkv, [GDN_HEADS * GDN_DK, 2 * GDN_HEADS * GDN_DK], axis=-1)
    q = l2norm(to_heads(q, GDN_HEADS)) * GDN_DK ** -0.5
    k = l2norm(to_heads(k, GDN_HEADS))
    v = to_heads(v, GDN_HEADS)
    a = jnp.transpose(a.reshape(b, t, 2, GDN_HEADS).astype(jnp.float32), (2, 0, 3, 1))
    bb = jnp.transpose(bb.reshape(b, t, 2, GDN_HEADS).astype(jnp.float32), (2, 0, 3, 1))
    a_log = a_log.astype(jnp.float32)[:, None, :, None]
    dt_bias = dt_bias.astype(jnp.float32)[:, None, :, None]
    g = -jnp.exp(a_log) * jax.nn.softplus(a + dt_bias)
    beta = jax.nn.sigmoid(bb)
    return q, k, v, g, beta, z


def token_mixers(nx, nc, w_in, w_out, na_rpb, gla_gate_w, gla_gate_b, gla_norm_w,
                 gdn_conv_w, gdn_a_log, gdn_dt_bias, gdn_norm_w, row_pos, col_pos, with_ctx_out):
    b = nx.shape[0]
    dt = nx.dtype
    px = split_proj(nx @ w_in)
    pc = split_proj(nc @ w_in)

    def heads(a, nh):
        return a.reshape(a.shape[0], a.shape[1], nh, -1)

    qx, kx, vx = (heads(a, NA_HEADS) for a in px[0:3])
    qc, kc, vc = (heads(a, NA_HEADS) for a in pc[0:3])
    ox_na = na_latent(qx, kx, vx, kc, vc, na_rpb)

    xq, xk, xv, xaf, xab, xg = gla_prep(px, gla_gate_w, gla_gate_b, row_pos, col_pos, True)
    cq, ck, cv, caf, cab, cg = gla_prep(pc, gla_gate_w, gla_gate_b, row_pos, col_pos, False)
    s0 = jnp.zeros((b, GLA_HEADS, GLA_DK, GLA_DV), jnp.float32)
    ox_gla, oc_gla = bidir_scan(gla_chunked, (cq, ck, cv, caf), (cq, ck, cv, cab),
                                (xq, xk, xv, xaf), (xq, xk, xv, xab), s0)

    yq, yk, yv, yg, yb, yz = gdn_prep(px, gdn_conv_w, gdn_a_log, gdn_dt_bias)
    dq, dk, dv, dg, db, dz = gdn_prep(pc, gdn_conv_w, gdn_a_log, gdn_dt_bias)
    s0d = jnp.zeros((b, GDN_HEADS, GDN_DK, GDN_DV), jnp.float32)
    ox_gdn, oc_gdn = bidir_scan(gdn_chunked, (dq, dk, dv, dg[0], db[0]), (dq, dk, dv, dg[1], db[1]),
                                (yq, yk, yv, yg[0], yb[0]), (yq, yk, yv, yg[1], yb[1]), s0d)

    out_x = jnp.concatenate([ox_na, gated_head_norm(ox_gla, xg, gla_norm_w, dt),
                             gated_head_norm(ox_gdn, yz, gdn_norm_w, dt)], axis=-1) @ w_out
    if not with_ctx_out:
        return out_x, None
    out_c = jnp.concatenate([na_context(qc, kc, vc), gated_head_norm(oc_gla, cg, gla_norm_w, dt),
                             gated_head_norm(oc_gdn, dz, gdn_norm_w, dt)], axis=-1) @ w_out
    return out_x, out_c


def expert_choice_ffn(h, w_router, w_gate, w_up, w_down):
    b, n, _ = h.shape
    cap = EC_CAPACITY * n // N_EXPERTS
    aff = jax.nn.softmax((h @ w_router).astype(jnp.float32), axis=-1)
    gate, idx = lax.top_k(jnp.swapaxes(aff, 1, 2), cap)
    bidx = jnp.arange(b)[:, None, None]
    xs = h[bidx, idx]
    hid = jax.nn.silu(jnp.einsum('becd,edf->becf', xs, w_gate)) * jnp.einsum('becd,edf->becf', xs, w_up)
    y = jnp.einsum('becf,efd->becd', hid, w_down) * gate[..., None].astype(h.dtype)
    return jnp.zeros_like(h).at[bidx, idx].add(y)


def setup_inputs(seed: int = 0) -> dict:
    key = jax.random.key(seed)
    ks = jax.random.split(key, 24)
    f32 = jnp.float32
    D = D_MODEL

    def nrm(k, shape, scale):
        return jax.random.normal(k, shape, f32) * scale

    dt = jnp.exp(jax.random.uniform(ks[16], (DEPTH, 2, GDN_HEADS), f32, math.log(1e-3), math.log(1e-1)))
    return {
        "x": nrm(ks[0], (BATCH, SEQ, D), 1.0),
        "c": nrm(ks[1], (BATCH, D), 1.0),
        "ctx": nrm(ks[2], (BATCH, CTX_LEN, D), 1.0),
        "c_ctx": nrm(ks[3], (D,), 1.0),
        "w_ada": nrm(ks[4], (DEPTH, D, 6 * D), 0.5 * D ** -0.5),
        "b_ada": nrm(ks[5], (DEPTH, 6 * D), 0.02),
        "norm_mix_w": 1.0 + nrm(ks[6], (DEPTH, D), 0.02),
        "norm_ffn_w": 1.0 + nrm(ks[7], (DEPTH, D), 0.02),
        "w_in": nrm(ks[8], (DEPTH, D, IN_W), D ** -0.5),
        "w_out": nrm(ks[9], (DEPTH, MIX_W, D), MIX_W ** -0.5),
        "na_rpb": nrm(ks[10], (DEPTH, NA_HEADS, 2 * NA_WIN_R - 1, 2 * NA_WIN_C - 1), 0.1),
        "gla_gate_w": nrm(ks[11], (DEPTH, 2, GLA_GATE_RANK, GLA_HEADS * GLA_DK), GLA_GATE_RANK ** -0.5),
        "gla_gate_b": nrm(ks[12], (DEPTH, 2, GLA_HEADS * GLA_DK), 0.1),
        "gla_norm_w": 1.0 + nrm(ks[13], (DEPTH, GLA_DV), 0.02),
        "gdn_conv_w": nrm(ks[14], (DEPTH, GDN_CONV, GDN_QKV_W), GDN_CONV ** -0.5),
        "gdn_a_log": jnp.log(jax.random.uniform(ks[15], (DEPTH, 2, GDN_HEADS), f32, 1.0, 16.0)),
        "gdn_dt_bias": dt + jnp.log(-jnp.expm1(-dt)),
        "gdn_norm_w": 1.0 + nrm(ks[17], (DEPTH, GDN_DV), 0.02),
        "w_router": nrm(ks[18], (DEPTH, D, N_EXPERTS), D ** -0.5),
        "w_exp_gate": nrm(ks[19], (DEPTH, N_EXPERTS, D, EXPERT_FF), D ** -0.5),
        "w_exp_up": nrm(ks[20], (DEPTH, N_EXPERTS, D, EXPERT_FF), D ** -0.5),
        "w_exp_down": nrm(ks[21], (DEPTH, N_EXPERTS, EXPERT_FF, D), EXPERT_FF ** -0.5),
        "final_norm_w": 1.0 + nrm(ks[22], (D,), 0.02),
    }


def modulated_norm(h, w, shift, scale):
    return rmsnorm(h, w) * (1 + scale) + shift


def reference(x, c, ctx, c_ctx, w_ada, b_ada, norm_mix_w, norm_ffn_w, w_in, w_out, na_rpb,
              gla_gate_w, gla_gate_b, gla_norm_w, gdn_conv_w, gdn_a_log, gdn_dt_bias, gdn_norm_w,
              w_router, w_exp_gate, w_exp_up, w_exp_down, final_norm_w):
    s = x.shape[1]
    pos = np.arange(s)
    row_pos, col_pos = pos // GRID_W, pos % GRID_W
    hx, hc = x, ctx
    for l in range(DEPTH):
        ctx_out = l < DEPTH - 1
        mod_x = (jax.nn.silu(c) @ w_ada[l] + b_ada[l])[:, None, :]
        mod_c = (jax.nn.silu(c_ctx) @ w_ada[l] + b_ada[l])[None, None, :]
        sh1x, sc1x, g1x, sh2x, sc2x, g2x = jnp.split(mod_x, 6, axis=-1)
        sh1c, sc1c, g1c, sh2c, sc2c, g2c = jnp.split(mod_c, 6, axis=-1)
        nx = modulated_norm(hx, norm_mix_w[l], sh1x, sc1x)
        nc = modulated_norm(hc, norm_mix_w[l], sh1c, sc1c)
        ox, oc = token_mixers(nx, nc, w_in[l], w_out[l], na_rpb[l], gla_gate_w[l], gla_gate_b[l], gla_norm_w[l],
                              gdn_conv_w[l], gdn_a_log[l], gdn_dt_bias[l], gdn_norm_w[l], row_pos, col_pos, ctx_out)
        hx = hx + g1x * ox
        hx = hx + g2x * expert_choice_ffn(modulated_norm(hx, norm_ffn_w[l], sh2x, sc2x), w_router[l],
                                          w_exp_gate[l], w_exp_up[l], w_exp_down[l])
        if ctx_out:
            hc = hc + g1c * oc
            hc = hc + g2c * expert_choice_ffn(modulated_norm(hc, norm_ffn_w[l], sh2c, sc2c), w_router[l],
                                              w_exp_gate[l], w_exp_up[l], w_exp_down[l])
    return rmsnorm(hx, final_norm_w)
```

```cpp
#include <hip/hip_runtime.h>
#include <cstdio>
#include <cstdint>
#include <cstring>

#ifndef ONE_LAUNCH
#define ONE_LAUNCH 1
#endif

#define LAS __attribute__((address_space(3)))
typedef unsigned short bf16;
typedef float f4 __attribute__((ext_vector_type(4)));
typedef unsigned u4 __attribute__((ext_vector_type(4)));
typedef unsigned u2 __attribute__((ext_vector_type(2)));

constexpr int D = 2048, NB = 2, SEQ = 4096, CTX = 256;
constexpr int ML = NB * SEQ, MC = NB * CTX, MROWS = ML + MC;
constexpr int INW = 6704, NP = 6912;
constexpr int NE = 16, FF = 2048, ESLOT = 1280;
constexpr int MODW = 6 * D;
constexpr int PC_NAQ = 0, PC_NAK = 1024, PC_NAV = 2048, PC_GLQ = 3072, PC_GLK = 3328, PC_GLV = 3584, PC_GLG = 4096, PC_GDQ = 4608, PC_GDZ = 6144, PC_SMALL = 6656;
constexpr int NTHREADS = 512, NWAVES = 8;
constexpr int LDS_BYTES = 147456, MISC_OFF = LDS_BYTES - 256;

constexpr size_t al256(size_t x) { return (x + 255) & ~(size_t)255; }
constexpr size_t WS_CTL = 0, CTL_BYTES = 1u << 20;
constexpr size_t WS_MOD = WS_CTL + CTL_BYTES;
constexpr size_t WS_ROPE = al256(WS_MOD + (size_t)2 * 3 * MODW * 4);
constexpr size_t WS_WIN = al256(WS_ROPE + 64 * 16 * 2 * 4);
constexpr size_t WS_WOUT = al256(WS_WIN + (size_t)2 * NP * D * 2);
constexpr size_t WS_WGU = al256(WS_WOUT + (size_t)2 * D * D * 2);
constexpr size_t WS_WDN = al256(WS_WGU + (size_t)2 * NE * 2 * FF * D * 2);
constexpr size_t WS_HX = al256(WS_WDN + (size_t)2 * NE * D * FF * 2);
constexpr size_t WS_NX = al256(WS_HX + (size_t)MROWS * D * 4);
constexpr size_t WS_P = al256(WS_NX + (size_t)MROWS * D * 2);
constexpr size_t WS_PS = al256(WS_P + (size_t)MROWS * NP * 2);
constexpr size_t WS_GQKV = al256(WS_PS + (size_t)MROWS * 64 * 4);
constexpr size_t WS_GGB = al256(WS_GQKV + (size_t)MROWS * 1536 * 4);
constexpr size_t WS_LQ = al256(WS_GGB + (size_t)MROWS * 16 * 4);
constexpr size_t WS_LK = al256(WS_LQ + (size_t)MROWS * 256 * 4);
constexpr size_t WS_LA = al256(WS_LK + (size_t)MROWS * 256 * 4);
constexpr size_t WS_OGLA = al256(WS_LA + (size_t)2 * MROWS * 256 * 4);
constexpr size_t WS_OGDN = al256(WS_OGLA + (size_t)2 * MROWS * 512 * 4);
constexpr size_t WS_CAT = al256(WS_OGDN + (size_t)2 * MROWS * 512 * 4);
constexpr size_t WS_AFF = al256(WS_CAT + (size_t)MROWS * D * 2);
constexpr size_t WS_IDX = al256(WS_AFF + (size_t)MROWS * 16 * 4);
constexpr size_t WS_GATE = al256(WS_IDX + (size_t)NE * ESLOT * 4);
constexpr size_t WS_AMOE = al256(WS_GATE + (size_t)NE * ESLOT * 4);
constexpr size_t WS_HID = al256(WS_AMOE + (size_t)NE * ESLOT * D * 2);
constexpr size_t WS_END = al256(WS_HID + (size_t)NE * ESLOT * FF * 2);
constexpr int CW_BAR = 1024;
constexpr int CW_NAQ = 8192;

__device__ __forceinline__ float bf2f(unsigned b) { return __uint_as_float(b << 16); }
__device__ __forceinline__ unsigned f2bf(float f) { unsigned u = __float_as_uint(f); return (u + 0x7fffu + ((u >> 16) & 1u)) >> 16; }
__device__ __forceinline__ unsigned pk2(float lo, float hi) { return f2bf(lo) | (f2bf(hi) << 16); }
__device__ __forceinline__ float wave_sum(float v) {
#pragma unroll
    for (int o = 1; o < 64; o <<= 1) v += __shfl_xor(v, o);
    return v;
}
__device__ __forceinline__ float wave_max(float v) {
#pragma unroll
    for (int o = 1; o < 64; o <<= 1) v = fmaxf(v, __shfl_xor(v, o));
    return v;
}
__device__ __forceinline__ float silu_f(float x) { return x / (1.f + expf(-x)); }
__device__ __forceinline__ float softplus_f(float x) { return x > 20.f ? x : log1pf(expf(x)); }
__device__ __forceinline__ float logsigmoid_f(float z) { return fminf(z, 0.f) - log1pf(expf(-fabsf(z))); }
#define LDS_WAIT() asm volatile("s_waitcnt lgkmcnt(0)" ::: "memory")
#define XB_TMO      128
#define XB_XCNT(j)  (256  + 64 * (j))
#define XB_XSUB(j)  (1280 + 64 * (j))
#define XB_XGEN(j)  (2304 + 64 * (j))
#define XB_TOP      3328
#define XB_TOPGEN   3392
#define XCD_BAR_WORDS 3456
#define XB_SPIN_CAP (1u << 20)

__device__ __forceinline__ unsigned xb_ld(unsigned* p)              { return __hip_atomic_load(p, __ATOMIC_RELAXED, __HIP_MEMORY_SCOPE_AGENT); }
__device__ __forceinline__ unsigned xb_add(unsigned* p, unsigned v) { return __hip_atomic_fetch_add(p, v, __ATOMIC_RELAXED, __HIP_MEMORY_SCOPE_AGENT); }
__device__ __forceinline__ unsigned xb_xcc_id() { return (unsigned)__builtin_amdgcn_s_getreg((3 << 11) | 20) & 0xFu; }
#define XB_SPIN(cond, bar) do { unsigned _sp = 0; while (cond) { __builtin_amdgcn_s_sleep(1); \
    if ((++_sp & 255u) == 0u) { if (xb_ld(&(bar)[XB_TMO])) break; if (_sp > XB_SPIN_CAP) { atomicAdd(&(bar)[XB_TMO], 1u); break; } } } } while (0)

struct XcdBarrier {
    unsigned* bar; unsigned x;
    volatile LAS unsigned* st;
};

__device__ __forceinline__ XcdBarrier xcd_barrier_post(unsigned* bar, volatile LAS unsigned* st) {
    XcdBarrier b; b.bar = bar; b.x = xb_xcc_id(); b.st = st;
    if (threadIdx.x == 0) (void)xb_add(&bar[XB_XCNT(b.x)], 1u);
    return b;
}
__device__ __forceinline__ void xcd_barrier_complete(unsigned* bar, unsigned x, unsigned& nloc, unsigned& nx) {
    const unsigned G = gridDim.x * gridDim.y * gridDim.z;
    unsigned sum, cnt, mine, sp = 0u;
    for (;;) {
        sum = 0u; cnt = 0u; mine = 0u;
#pragma unroll
        for (unsigned j = 0; j < 16; ++j) { const unsigned c = xb_ld(&bar[XB_XCNT(j)]); sum += c; cnt += (c > 0u) ? 1u : 0u; mine = (j == x) ? c : mine; }
        if (sum == G) break;
        __builtin_amdgcn_s_sleep(1);
        if ((++sp & 255u) == 0u) { if (xb_ld(&bar[XB_TMO])) break; if (sp > XB_SPIN_CAP) { atomicAdd(&bar[XB_TMO], 1u); break; } }
    }
    nloc = mine > 0u ? mine : 1u; nx = cnt > 0u ? cnt : 1u;
}

__device__ __forceinline__ void xcd_barrier(const XcdBarrier& b) {
    asm volatile("s_waitcnt vmcnt(0)" ::: "memory");
    __syncthreads();
    if (threadIdx.x == 0) {
        unsigned* bar = b.bar;
        __builtin_amdgcn_s_waitcnt(0);
        unsigned nloc = b.st[0], nx = b.st[1];
        if (nloc == 0u) { xcd_barrier_complete(bar, b.x, nloc, nx); b.st[0] = nloc; b.st[1] = nx; }
        const unsigned old = xb_add(&bar[XB_XSUB(b.x)], 1u);
        const unsigned gen = old / nloc;
        if (old + 1u == (gen + 1u) * nloc) {
            __builtin_amdgcn_fence(__ATOMIC_RELEASE, "agent");
            asm volatile("s_waitcnt vmcnt(0)" ::: "memory");
            const unsigned og = xb_add(&bar[XB_TOP], 1u);
            const unsigned tg = og / nx;
            if (og + 1u == (tg + 1u) * nx) xb_add(&bar[XB_TOPGEN], 1u);
            else XB_SPIN(xb_ld(&bar[XB_TOPGEN]) == tg, bar);
            __builtin_amdgcn_fence(__ATOMIC_ACQUIRE, "agent");
            xb_add(&bar[XB_XGEN(b.x)], 1u);
            asm volatile("s_waitcnt vmcnt(0)" ::: "memory");
        } else {
            XB_SPIN(xb_ld(&bar[XB_XGEN(b.x)]) == gen, bar);
            __builtin_amdgcn_fence(__ATOMIC_ACQUIRE, "agent");
            asm volatile("s_waitcnt vmcnt(0)" ::: "memory");
        }
    }
    __syncthreads();
}

namespace pg8 {
#define PG8_LAS __attribute__((address_space(3)))
typedef unsigned short bf16_t;
typedef short bf16x8 __attribute__((ext_vector_type(8)));
typedef float f32x4 __attribute__((ext_vector_type(4)));
typedef unsigned u32x4 __attribute__((ext_vector_type(4)));
constexpr int BM = 256, BK = 64, HALF = 128, HTB = HALF * BK * 2  , STAGE_BYTES = 8 * HTB, NXCD = 8, WGM = 8;

__host__ __device__ __forceinline__ int lds_byte(int r, int c) { const int st = (r >> 4) * 2 + (c >> 5), rr = r & 15, cc = c & 31, ob = rr * 64 + cc * 2; return st * 1024 + (ob ^ (((ob >> 9) & 1) << 5)); }
__host__ __device__ __forceinline__ void stage_rc(int b, int& R, int& C) { const int st = b / 1024, sb = b % 1024, swz = sb ^ (((sb >> 9) & 1) << 5); R = (st >> 1) * 16 + swz / 64; C = (st & 1) * 32 + (swz % 64) / 2; }
__host__ __device__ __forceinline__ int perm32(int rho) { const int n = rho >> 4, i = rho & 15; return 8 * (i >> 2) + 4 * n + (i & 3); }

struct Unit { int pm, pn; };
struct Gemm { const bf16_t* A; const bf16_t* Bt; int M, N, K; };
struct StaticOrder {
    int nM, nN, nwg, G, c;
    __host__ __device__ void init(int M, int N, int G_, int c_) { nM = M / BM; nN = N / BM; nwg = nM * nN; G = G_; c = c_; }
    __host__ __device__ bool next(int i, Unit& u) const {
        const long L = (long)i * G + c; if (L >= nwg) return false;
        int wgid = (int)L; { const int q = nwg / NXCD, r = nwg % NXCD, xcd = wgid % NXCD, off = wgid / NXCD; wgid = (xcd < r ? xcd * (q + 1) : r * (q + 1) + (xcd - r) * q) + off; }
        const int nig = WGM * nN, gid = wgid / nig, fm = gid * WGM, gsz = (nM - fm) < WGM ? (nM - fm) : WGM;
        u.pm = fm + ((wgid % nig) % gsz); u.pn = (wgid % nig) / gsz; return true;
    }
    __device__ __forceinline__ void a_ready(const Unit&) const {}
    __device__ __forceinline__ void done(const Unit&) const {}
};
__device__ __forceinline__ unsigned cvt_pk_bf16(float lo, float hi) { unsigned r; asm volatile("v_cvt_pk_bf16_f32 %0, %1, %2" : "=v"(r) : "v"(lo), "v"(hi)); return r; }

template <class Epi, class Sched, bool STAMP = false>
__device__ __forceinline__ void gemm_phase(PG8_LAS unsigned char* lds, const Gemm g, const Sched& S, const Epi& E, unsigned long long* stamps) {
    int tid_ = threadIdx.x; asm volatile("" : "+v"(tid_));
    const int tid = tid_, wid = __builtin_amdgcn_readfirstlane(tid >> 6), lane = tid & 63, wr = wid >> 2, wc = wid & 3, fr = lane & 15, fq = lane >> 4;
    const int K = g.K, nt = K / BK;
    int ts_lo = 0, ts_hi = 0, nts = 0; const unsigned long long rt_entry = STAMP ? (unsigned long long)wall_clock64() : 0ull;
#define PG8_STAMP() do { if (STAMP && wid == 0 && nts < 64) { const unsigned long long _c = (unsigned long long)clock64(); \
        ts_lo = (lane == nts) ? (int)(unsigned)_c : ts_lo; ts_hi = (lane == nts) ? (int)(unsigned)(_c >> 32) : ts_hi; ++nts; } } while (0)
    PG8_STAMP();
    unsigned voffA[2], voffB[2];
#pragma unroll
    for (int i = 0; i < 2; ++i) { int R, C; stage_rc(tid * 16 + i * 8192, R, C); const int Rb = Epi::PERM ? ((R & ~31) + perm32(R & 31)) : R;
        voffA[i] = (unsigned)(R * K + C) * 2u; voffB[i] = (unsigned)(Rb * K + C) * 2u; }
    const size_t kstep = (size_t)(BK * 2);
    const size_t hstep = (size_t)HALF * K * 2;
    const size_t tstep = 2 * hstep;
    const unsigned ldsw = (unsigned)wid * 1024u;
    const int aoff = lds_byte(wr * 64 + fr, fq * 8), boff = lds_byte(wc * 32 + fr, fq * 8);
#define PG8_SA(b, h) (((b) * 2 + (h)) * HTB)
#define PG8_SB(b, h) ((4 + (b) * 2 + (h)) * HTB)
#define PG8_STAGE(bufoff, gbase, voff) do { _Pragma("unroll") for (int _i = 0; _i < 2; ++_i) \
        __builtin_amdgcn_global_load_lds((const unsigned*)((const char*)(gbase) + (voff)[_i]), (PG8_LAS unsigned*)(lds + (bufoff) + ldsw + _i * 8192), 16, 0, 0); } while (0)
#define PG8_LDA(dst, b, h) do { _Pragma("unroll") for (int m = 0; m < 4; ++m) _Pragma("unroll") for (int k = 0; k < 2; ++k) dst[m][k] = *(const PG8_LAS bf16x8*)(lds + PG8_SA(b, h) + aoff + m * 2048 + k * 1024); } while (0)
#define PG8_LDB(dst, b, h) do { _Pragma("unroll") for (int n = 0; n < 2; ++n) _Pragma("unroll") for (int k = 0; k < 2; ++k) dst[n][k] = *(const PG8_LAS bf16x8*)(lds + PG8_SB(b, h) + boff + n * 2048 + k * 1024); } while (0)
#define PG8_MMA(ai, bj, At, Bt) do { __builtin_amdgcn_s_setprio(1); _Pragma("unroll") for (int m = 0; m < 4; ++m) _Pragma("unroll") for (int n = 0; n < 2; ++n) _Pragma("unroll") for (int k = 0; k < 2; ++k) \
        acc[ai][bj][m][n] = __builtin_amdgcn_mfma_f32_16x16x32_bf16(Bt[n][k], At[m][k], acc[ai][bj][m][n], 0, 0, 0); __builtin_amdgcn_s_setprio(0); } while (0)
#define PG8_WAIT_V(n) asm volatile("s_waitcnt vmcnt(" #n ")" ::: "memory")
#define PG8_WAIT_L(n) asm volatile("s_waitcnt lgkmcnt(" #n ")" ::: "memory")
#define PG8_BAR __builtin_amdgcn_s_barrier()
#define PG8_SCHED __builtin_amdgcn_sched_barrier(0)
    Unit cur, nxt; int ui = 0;
    if (!S.next(0, cur)) return;
    f32x4 acc[2][2][4][2];
#pragma unroll
    for (int a = 0; a < 2; ++a)
#pragma unroll
        for (int b = 0; b < 2; ++b)
#pragma unroll
            for (int m = 0; m < 4; ++m)
#pragma unroll
                for (int n = 0; n < 2; ++n) acc[a][b][m][n] = (f32x4){0.f, 0.f, 0.f, 0.f};
    bf16x8 At[4][2], B0[2][2], B1[2][2];
    const char* cA = (const char*)g.A + (size_t)cur.pm * tstep; const char* cB = (const char*)g.Bt + (size_t)cur.pn * tstep;
    S.a_ready(cur);
    PG8_STAGE(PG8_SB(0, 0), cB, voffB); PG8_STAGE(PG8_SA(0, 0), cA, voffA); PG8_STAGE(PG8_SB(0, 1), cB + hstep, voffB); PG8_STAGE(PG8_SA(0, 1), cA + hstep, voffA);
    if (wr == 1) PG8_BAR;
    PG8_WAIT_V(4); PG8_BAR;
    PG8_STAGE(PG8_SB(1, 0), cB + kstep, voffB); PG8_STAGE(PG8_SA(1, 0), cA + kstep, voffA); PG8_STAGE(PG8_SB(1, 1), cB + hstep + kstep, voffB);
    PG8_WAIT_V(6); PG8_BAR;
    PG8_STAMP();
    for (;;) {
        const bool has_next = S.next(ui + 1, nxt);
        const char* nA = has_next ? (const char*)g.A + (size_t)nxt.pm * tstep : cA; const char* nB = has_next ? (const char*)g.Bt + (size_t)nxt.pn * tstep : cB;
        for (int t = 0; t < nt; t += 2) {
            const bool last = (t == nt - 2);
            const char* a1 = cA + (size_t)(t + 1) * kstep;
            const char* a2 = last ? nA : cA + (size_t)(t + 2) * kstep; const char* b2 = last ? nB : cB + (size_t)(t + 2) * kstep;
            const char* a3 = a2 + kstep; const char* b3 = b2 + kstep;
            if (last && has_next) S.a_ready(nxt);
            PG8_LDB(B0, 0, 0); PG8_SCHED; PG8_LDA(At, 0, 0); PG8_STAGE(PG8_SA(1, 1), a1 + hstep, voffA);
            PG8_WAIT_L(8); PG8_BAR; PG8_WAIT_L(0); PG8_MMA(0, 0, At, B0); PG8_BAR; PG8_SCHED;
            PG8_LDB(B1, 0, 1); PG8_STAGE(PG8_SB(0, 0), b2, voffB);
            PG8_BAR; PG8_WAIT_L(0); PG8_MMA(0, 1, At, B1); PG8_BAR;
            PG8_LDA(At, 0, 1); PG8_STAGE(PG8_SA(0, 0), a2, voffA);
            PG8_BAR; PG8_WAIT_L(0); PG8_MMA(1, 0, At, B0); PG8_BAR; PG8_SCHED;
            PG8_STAGE(PG8_SB(0, 1), b2 + hstep, voffB);
            PG8_WAIT_V(6); PG8_BAR; PG8_MMA(1, 1, At, B1); PG8_BAR;
            PG8_LDB(B0, 1, 0); PG8_SCHED; PG8_LDA(At, 1, 0); PG8_STAGE(PG8_SA(0, 1), a2 + hstep, voffA);
            PG8_WAIT_L(8); PG8_BAR; PG8_WAIT_L(0); PG8_MMA(0, 0, At, B0); PG8_BAR; PG8_SCHED;
            PG8_LDB(B1, 1, 1); PG8_STAGE(PG8_SB(1, 0), b3, voffB);
            PG8_BAR; PG8_WAIT_L(0); PG8_MMA(0, 1, At, B1); PG8_BAR;
            PG8_LDA(At, 1, 1); PG8_STAGE(PG8_SA(1, 0), a3, voffA);
            PG8_BAR; PG8_WAIT_L(0); PG8_MMA(1, 0, At, B0); PG8_BAR; PG8_SCHED;
            PG8_STAGE(PG8_SB(1, 1), b3 + hstep, voffB);
            PG8_WAIT_V(6); PG8_BAR; PG8_MMA(1, 1, At, B1); PG8_BAR;
        }
        PG8_STAMP();
        if constexpr (!Epi::AFTER_DRAIN) { E(acc, cur, wr, wc, fr, fq); S.done(cur); }
        PG8_STAMP();
        if (!has_next) break;
#pragma unroll
        for (int a = 0; a < 2; ++a)
#pragma unroll
            for (int b = 0; b < 2; ++b)
#pragma unroll
                for (int m = 0; m < 4; ++m)
#pragma unroll
                    for (int n = 0; n < 2; ++n) acc[a][b][m][n] = (f32x4){0.f, 0.f, 0.f, 0.f};
        cur = nxt; cA = nA; cB = nB; ++ui;
    }
    PG8_WAIT_V(0);
    if (wr == 0) PG8_BAR;
    PG8_BAR;
    if constexpr (Epi::AFTER_DRAIN) { E.fused(acc, cur, wr, wc, fr, fq, lds, wid, lane); S.done(cur); }
    PG8_STAMP();
    if (STAMP && wid == 0) { stamps[lane] = lane < nts ? (((unsigned long long)(unsigned)ts_hi << 32) | (unsigned)ts_lo) : 0ull;
        if (lane == 62) stamps[62] = rt_entry; if (lane == 63) stamps[63] = (unsigned long long)wall_clock64(); }
#undef PG8_STAMP
#undef PG8_SA
#undef PG8_SB
#undef PG8_STAGE
#undef PG8_LDA
#undef PG8_LDB
#undef PG8_MMA
#undef PG8_WAIT_V
#undef PG8_WAIT_L
#undef PG8_BAR
#undef PG8_SCHED
}
}

#include <cstdio>
#include <ctime>

struct Params { const float* in[23]; float* out; unsigned char* ws; int ph_lo, ph_hi; };
typedef const __attribute__((address_space(4))) Params* KParams;
struct Ctx {
    unsigned char* lds; unsigned char* ws; KParams kp;
    int tid, lane, wave, gw, ngw;
    __device__ __forceinline__ const float* x() const { return kp->in[0]; }
    __device__ __forceinline__ const float* cvec() const { return kp->in[1]; }
    __device__ __forceinline__ const float* ctxin() const { return kp->in[2]; }
    __device__ __forceinline__ const float* c_ctx() const { return kp->in[3]; }
    __device__ __forceinline__ const float* w_ada() const { return kp->in[4]; }
    __device__ __forceinline__ const float* b_ada() const { return kp->in[5]; }
    __device__ __forceinline__ const float* norm_mix_w() const { return kp->in[6]; }
    __device__ __forceinline__ const float* norm_ffn_w() const { return kp->in[7]; }
    __device__ __forceinline__ const float* w_in() const { return kp->in[8]; }
    __device__ __forceinline__ const float* w_out() const { return kp->in[9]; }
    __device__ __forceinline__ const float* na_rpb() const { return kp->in[10]; }
    __device__ __forceinline__ const float* gla_gate_w() const { return kp->in[11]; }
    __device__ __forceinline__ const float* gla_gate_b() const { return kp->in[12]; }
    __device__ __forceinline__ const float* gla_norm_w() const { return kp->in[13]; }
    __device__ __forceinline__ const float* gdn_conv_w() const { return kp->in[14]; }
    __device__ __forceinline__ const float* gdn_a_log() const { return kp->in[15]; }
    __device__ __forceinline__ const float* gdn_dt_bias() const { return kp->in[16]; }
    __device__ __forceinline__ const float* gdn_norm_w() const { return kp->in[17]; }
    __device__ __forceinline__ const float* w_router() const { return kp->in[18]; }
    __device__ __forceinline__ const float* w_exp_gate() const { return kp->in[19]; }
    __device__ __forceinline__ const float* w_exp_up() const { return kp->in[20]; }
    __device__ __forceinline__ const float* w_exp_down() const { return kp->in[21]; }
    __device__ __forceinline__ const float* final_norm_w() const { return kp->in[22]; }
    __device__ __forceinline__ float* out() const { return kp->out; }
    __device__ __forceinline__ float* MOD() const { return (float*)(ws + WS_MOD); }
    __device__ __forceinline__ float* ROPE() const { return (float*)(ws + WS_ROPE); }
    __device__ __forceinline__ float* HX() const { return (float*)(ws + WS_HX); }
    __device__ __forceinline__ float* PS() const { return (float*)(ws + WS_PS); }
    __device__ __forceinline__ float* GQKV() const { return (float*)(ws + WS_GQKV); }
    __device__ __forceinline__ float* GGB() const { return (float*)(ws + WS_GGB); }
    __device__ __forceinline__ float* LQ() const { return (float*)(ws + WS_LQ); }
    __device__ __forceinline__ float* LK() const { return (float*)(ws + WS_LK); }
    __device__ __forceinline__ float* LA() const { return (float*)(ws + WS_LA); }
    __device__ __forceinline__ float* OGLA() const { return (float*)(ws + WS_OGLA); }
    __device__ __forceinline__ float* OGDN() const { return (float*)(ws + WS_OGDN); }
    __device__ __forceinline__ float* AFF() const { return (float*)(ws + WS_AFF); }
    __device__ __forceinline__ float* GATEV() const { return (float*)(ws + WS_GATE); }
    __device__ __forceinline__ bf16* WIN() const { return (bf16*)(ws + WS_WIN); }
    __device__ __forceinline__ bf16* WOUT() const { return (bf16*)(ws + WS_WOUT); }
    __device__ __forceinline__ bf16* WGU() const { return (bf16*)(ws + WS_WGU); }
    __device__ __forceinline__ bf16* WDN() const { return (bf16*)(ws + WS_WDN); }
    __device__ __forceinline__ bf16* NX() const { return (bf16*)(ws + WS_NX); }
    __device__ __forceinline__ bf16* P() const { return (bf16*)(ws + WS_P); }
    __device__ __forceinline__ bf16* CAT() const { return (bf16*)(ws + WS_CAT); }
    __device__ __forceinline__ bf16* AMOE() const { return (bf16*)(ws + WS_AMOE); }
    __device__ __forceinline__ bf16* HID() const { return (bf16*)(ws + WS_HID); }
    __device__ __forceinline__ int* IDX() const { return (int*)(ws + WS_IDX); }
    __device__ __forceinline__ unsigned* ctl() const { return (unsigned*)(ws + WS_CTL); }
};
__device__ __forceinline__ int modrow(int row) { return row < ML ? (row >> 12) : 2; }
__device__ __forceinline__ const float* src_row_ptr(const Ctx& c, int l, int row) {
    if (l == 0) return row < ML ? c.x() + (size_t)row * D : c.ctxin() + (size_t)(row - ML) * D;
    return c.HX() + (size_t)row * D;
}

__device__ __forceinline__ void transpose_item(const float* W, int ldw, int k0, int sn0, int nvalid, bf16* dst, int K, float* scr, int lane) {
#pragma unroll 8
    for (int i = 0; i < 32; ++i) { const int kk = 2 * i + (lane >> 5), cl = lane & 31; const float v = (cl < nvalid) ? W[(size_t)(k0 + kk) * ldw + sn0 + cl] : 0.f; scr[kk * 33 + cl] = v; }
    LDS_WAIT();
    const int cc = lane & 7;
#pragma unroll
    for (int j = 0; j < 4; ++j) { const int n = (lane >> 3) + 8 * j; const float* s = scr + (8 * cc) * 33 + n;
        u4 o; o.x = pk2(s[0 * 33], s[1 * 33]); o.y = pk2(s[2 * 33], s[3 * 33]); o.z = pk2(s[4 * 33], s[5 * 33]); o.w = pk2(s[6 * 33], s[7 * 33]);
        *(u4*)(dst + (size_t)n * K + 8 * cc) = o; }
    LDS_WAIT();
}
__device__ __forceinline__ void ph_prologue(const Ctx& c) {
    float* S3 = (float*)c.lds;
    float* scr = (float*)(c.lds + 32768 + c.wave * 8704);
    for (int i = c.tid; i < 3 * D; i += NTHREADS) { const int r = i / D, k = i % D; const float v = r < 2 ? c.cvec()[r * D + k] : c.c_ctx()[k]; S3[i] = silu_f(v); }
    __syncthreads();
    constexpr int N_MOD = 2 * (MODW / 32);
    constexpr int N_ROPE = 16;
    constexpr int N_WIN = 2 * 32 * 210, N_WOUT = 2 * 32 * 64, N_EXP = 96 * 2048;
    constexpr int NITEMS = N_MOD + N_ROPE + N_WIN + N_WOUT + N_EXP;
    const int lane = c.lane;
    for (int it = c.gw; it < NITEMS; it += c.ngw) {
        int r = it;
        if (r < N_MOD) {
            const int l = r / (MODW / 32), cb = r % (MODW / 32), kg = lane >> 3, cl = lane & 7, col = cb * 32 + 4 * cl;
            const float* wp = c.w_ada() + (size_t)l * D * MODW + col;
            f4 a0 = {0.f, 0.f, 0.f, 0.f}, a1 = a0, a2 = a0;
#pragma unroll 8
            for (int i = 0; i < 256; ++i) { const int k = kg + 8 * i; const f4 w = *(const f4*)(wp + (size_t)k * MODW); a0 += S3[k] * w; a1 += S3[D + k] * w; a2 += S3[2 * D + k] * w; }
#pragma unroll
            for (int q = 0; q < 4; ++q) {
#pragma unroll
                for (int o = 8; o < 64; o <<= 1) { a0[q] += __shfl_xor(a0[q], o); a1[q] += __shfl_xor(a1[q], o); a2[q] += __shfl_xor(a2[q], o); } }
            if (kg == 0) { const f4 bb = *(const f4*)(c.b_ada() + (size_t)l * MODW + col);
                *(f4*)(c.MOD() + (size_t)(l * 3 + 0) * MODW + col) = a0 + bb; *(f4*)(c.MOD() + (size_t)(l * 3 + 1) * MODW + col) = a1 + bb; *(f4*)(c.MOD() + (size_t)(l * 3 + 2) * MODW + col) = a2 + bb; }
            continue; }
        r -= N_MOD;
        if (r < N_ROPE) { const int en = r * 64 + lane, pos = en >> 4, i = en & 15; const float f = powf(10000.f, -(float)i / 16.f), ang = (float)pos * f;
            c.ROPE()[en * 2] = cosf(ang); c.ROPE()[en * 2 + 1] = sinf(ang); continue; }
        r -= N_ROPE;
        if (r < N_WIN) { const int l = r / (32 * 210), q = r % (32 * 210), kb = q / 210, nb = q % 210, n0 = nb * 32;
            int sn0, nv = 32;
            if (n0 < 4608) sn0 = n0; else if (n0 < 6656) sn0 = n0 + 32; else if (n0 < 6688) sn0 = 4608 + (n0 - 6656); else { sn0 = 6688; nv = 16; }
            transpose_item(c.w_in() + (size_t)l * D * INW, INW, kb * 64, sn0, nv, c.WIN() + ((size_t)l * NP + n0) * D + kb * 64, D, scr, lane); continue; }
        r -= N_WIN;
        if (r < N_WOUT) { const int l = r / 2048, q = r % 2048, kb = q / 64, nb = q % 64;
            transpose_item(c.w_out() + (size_t)l * D * D, D, kb * 64, nb * 32, 32, c.WOUT() + ((size_t)l * D + nb * 32) * D + kb * 64, D, scr, lane); continue; }
        r -= N_WOUT;
        { const int mtx = r / 2048, q = r % 2048, kb = q / 64, nb = q % 64; const int ty = mtx / 32, le = mtx % 32;
            if (ty < 2) { const float* W = (ty == 0 ? c.w_exp_gate() : c.w_exp_up()) + (size_t)le * D * FF;
                const int drow = (nb >> 2) * 256 + ty * 128 + (nb & 3) * 32;
                transpose_item(W, FF, kb * 64, nb * 32, 32, c.WGU() + ((size_t)le * 4096 + drow) * D + kb * 64, D, scr, lane); }
            else { const float* W = c.w_exp_down() + (size_t)le * FF * D;
                transpose_item(W, D, kb * 64, nb * 32, 32, c.WDN() + ((size_t)le * D + nb * 32) * FF + kb * 64, FF, scr, lane); } }
    }
}

__device__ __forceinline__ void ph_norm1(const Ctx& c, int l) {
    const int lane = c.lane;
    for (int row = c.gw; row < MROWS; row += c.ngw) {
        const float* xr = src_row_ptr(c, l, row);
        f4 v[8]; float ss = 0.f;
#pragma unroll
        for (int j = 0; j < 8; ++j) { v[j] = *(const f4*)(xr + 4 * lane + 256 * j); ss += v[j].x * v[j].x + v[j].y * v[j].y + v[j].z * v[j].z + v[j].w * v[j].w; }
        ss = wave_sum(ss);
        const float rstd = 1.0f / sqrtf(ss * (1.0f / D) + 1e-6f);
        const float* nw = c.norm_mix_w() + (size_t)l * D; const float* md = c.MOD() + (size_t)(l * 3 + modrow(row)) * MODW;
        bf16* orow = c.NX() + (size_t)row * D;
#pragma unroll
        for (int j = 0; j < 8; ++j) { const int col = 4 * lane + 256 * j; const f4 w = *(const f4*)(nw + col), sh = *(const f4*)(md + col), sc = *(const f4*)(md + D + col);
            const f4 y = v[j] * rstd * w * (1.0f + sc) + sh; u2 o; o.x = pk2(y.x, y.y); o.y = pk2(y.z, y.w); *(u2*)(orow + col) = o; }
    }
}

using pg8::f32x4; using pg8::u32x4; using pg8::Unit;
struct EpiP {
    static constexpr bool PERM = true, AFTER_DRAIN = false;
    bf16* P; float* PS;
    __device__ __forceinline__ void operator()(const f32x4 (&acc)[2][2][4][2], const Unit& u, int wr, int wc, int fr, int fq) const {
        const int row0 = u.pm * 256 + wr * 64 + fr, col0 = u.pn * 256 + wc * 32 + 8 * fq;
#pragma unroll
        for (int ai = 0; ai < 2; ++ai)
#pragma unroll
            for (int m = 0; m < 4; ++m) { const int row = row0 + ai * 128 + m * 16; bf16* rowp = P + (size_t)row * NP + col0;
#pragma unroll
                for (int bj = 0; bj < 2; ++bj) { const f32x4 v0 = acc[ai][bj][m][0], v1 = acc[ai][bj][m][1];
                    u32x4 w; w.x = pg8::cvt_pk_bf16(v0[0], v0[1]); w.y = pg8::cvt_pk_bf16(v0[2], v0[3]); w.z = pg8::cvt_pk_bf16(v1[0], v1[1]); w.w = pg8::cvt_pk_bf16(v1[2], v1[3]);
                    *(u32x4*)(rowp + bj * 128) = w; }
                if (u.pn == 26 && wc < 2) { float* ps = PS + (size_t)row * 64 + wc * 32 + 8 * fq; *(f32x4*)ps = acc[ai][0][m][0]; *(f32x4*)(ps + 4) = acc[ai][0][m][1]; } }
    }
};
struct EpiResid {
    static constexpr bool PERM = false, AFTER_DRAIN = false;
    const float *x, *ctxin, *MOD; float* HX; int l;
    __device__ __forceinline__ void operator()(const f32x4 (&acc)[2][2][4][2], const Unit& u, int wr, int wc, int fr, int fq) const {
#pragma unroll
        for (int ai = 0; ai < 2; ++ai)
#pragma unroll
            for (int m = 0; m < 4; ++m) { const int row = u.pm * 256 + ai * 128 + wr * 64 + m * 16 + fr; float* dst = HX + (size_t)row * D;
                const float* src = (l == 0) ? (row < ML ? x + (size_t)row * D : ctxin + (size_t)(row - ML) * D) : dst;
                const float* g1 = MOD + (size_t)(l * 3 + modrow(row)) * MODW + 2 * D;
#pragma unroll
                for (int bj = 0; bj < 2; ++bj)
#pragma unroll
                    for (int n = 0; n < 2; ++n) { const int col = u.pn * 256 + bj * 128 + wc * 32 + n * 16 + 4 * fq;
                        *(f32x4*)(dst + col) = *(const f32x4*)(src + col) + *(const f32x4*)(g1 + col) * acc[ai][bj][m][n]; } }
    }
};
struct EpiSwiglu {
    static constexpr bool PERM = true, AFTER_DRAIN = false;
    bf16* HID;
    __device__ __forceinline__ void operator()(const f32x4 (&acc)[2][2][4][2], const Unit& u, int wr, int wc, int fr, int fq) const {
        const int row0 = u.pm * 256 + wr * 64 + fr, col0 = (u.pn & 15) * 128 + wc * 32 + 8 * fq;
#pragma unroll
        for (int ai = 0; ai < 2; ++ai)
#pragma unroll
            for (int m = 0; m < 4; ++m) { bf16* rowp = HID + (size_t)(row0 + ai * 128 + m * 16) * FF + col0;
                float h[8];
#pragma unroll
                for (int n = 0; n < 2; ++n)
#pragma unroll
                    for (int i = 0; i < 4; ++i) { const float g = acc[ai][0][m][n][i], up = acc[ai][1][m][n][i]; h[n * 4 + i] = silu_f(g) * up; }
                u32x4 w; w.x = pg8::cvt_pk_bf16(h[0], h[1]); w.y = pg8::cvt_pk_bf16(h[2], h[3]); w.z = pg8::cvt_pk_bf16(h[4], h[5]); w.w = pg8::cvt_pk_bf16(h[6], h[7]);
                *(u32x4*)rowp = w; }
    }
};
struct EpiDown {
    static constexpr bool PERM = false, AFTER_DRAIN = false;
    const int* IDX; const float *GATEV, *MOD; float* HX; int l, nslots;
    __device__ __forceinline__ void operator()(const f32x4 (&acc)[2][2][4][2], const Unit& u, int wr, int wc, int fr, int fq) const {
        const int e = u.pm / 5, mt = u.pm % 5, ntl = u.pn & 7;
#pragma unroll
        for (int ai = 0; ai < 2; ++ai)
#pragma unroll
            for (int m = 0; m < 4; ++m) { const int slot = mt * 256 + ai * 128 + wr * 64 + m * 16 + fr;
                if (slot < nslots) { const int tok = IDX[e * ESLOT + slot]; const float gate = GATEV[e * ESLOT + slot];
                    const float* g2 = MOD + (size_t)(l * 3 + modrow(tok)) * MODW + 5 * D; float* dst = HX + (size_t)tok * D;
#pragma unroll
                    for (int bj = 0; bj < 2; ++bj)
#pragma unroll
                        for (int n = 0; n < 2; ++n) { const int col = ntl * 256 + bj * 128 + wc * 32 + n * 16 + 4 * fq; const f32x4 v = *(const f32x4*)(g2 + col) * acc[ai][bj][m][n] * gate;
                            unsafeAtomicAdd(dst + col, v[0]); unsafeAtomicAdd(dst + col + 1, v[1]); unsafeAtomicAdd(dst + col + 2, v[2]); unsafeAtomicAdd(dst + col + 3, v[3]); } } }
    }
};
struct MoeOrder {
    int MT, NT, G, c;
    __device__ __forceinline__ bool next(int i, Unit& u) const { const int L = i * G + c, per = MT * NT; if (L >= NE * per) return false; const int e = L / per, r = L % per; u.pm = e * 5 + (r % MT); u.pn = e * NT + (r / MT); return true; }
    __device__ __forceinline__ void a_ready(const Unit&) const {}
    __device__ __forceinline__ void done(const Unit&) const {}
};
struct RowOrder {
    int nM, nN, G, c;
    __device__ __forceinline__ bool next(int i, Unit& u) const { const int L = i * G + c; if (L >= nM * nN) return false; u.pm = L % nM; u.pn = L / nM; return true; }
    __device__ __forceinline__ void a_ready(const Unit&) const {}
    __device__ __forceinline__ void done(const Unit&) const {}
};

__device__ __forceinline__ void ph_prep(const Ctx& c, int l) {
    const int lane = c.lane;
    const float* cw = c.gdn_conv_w() + (size_t)l * 5 * 1536;
    for (int row = c.gw; row < MROWS; row += c.ngw) {
        int t, T; if (row < ML) { t = row & (SEQ - 1); T = SEQ; } else { t = (row - ML) & (CTX - 1); T = CTX; }
#pragma unroll
        for (int j = 0; j < 3; ++j) {
            const int cb = j * 512 + lane * 8;
            float a[8];
#pragma unroll
            for (int i = 0; i < 8; ++i) a[i] = 0.f;
#pragma unroll
            for (int tap = 0; tap < 5; ++tap) { const int tt = t + tap - 2;
                if (tt >= 0 && tt < T) { const u4 raw = *(const u4*)(c.P() + (size_t)(row + tap - 2) * NP + PC_GDQ + cb);
                    const f4 w0 = *(const f4*)(cw + tap * 1536 + cb), w1 = *(const f4*)(cw + tap * 1536 + cb + 4);
                    a[0] += w0.x * bf2f(raw.x & 0xffffu); a[1] += w0.y * bf2f(raw.x >> 16); a[2] += w0.z * bf2f(raw.y & 0xffffu); a[3] += w0.w * bf2f(raw.y >> 16);
                    a[4] += w1.x * bf2f(raw.z & 0xffffu); a[5] += w1.y * bf2f(raw.z >> 16); a[6] += w1.z * bf2f(raw.w & 0xffffu); a[7] += w1.w * bf2f(raw.w >> 16); } }
            float ss = 0.f;
#pragma unroll
            for (int i = 0; i < 8; ++i) { a[i] = silu_f(a[i]); ss += a[i] * a[i]; }
            if (j < 2) { ss += __shfl_xor(ss, 1); ss += __shfl_xor(ss, 2); ss += __shfl_xor(ss, 4); ss += __shfl_xor(ss, 8);
                const float sc = (1.0f / sqrtf(ss + 1e-6f)) * (j == 0 ? 0.08838834764831845f : 1.0f);
#pragma unroll
                for (int i = 0; i < 8; ++i) a[i] *= sc; }
            float* o = c.GQKV() + (size_t)row * 1536 + cb;
            *(f4*)o = (f4){a[0], a[1], a[2], a[3]}; *(f4*)(o + 4) = (f4){a[4], a[5], a[6], a[7]};
        }
        const float* ps = c.PS() + (size_t)row * 64;
        if (lane < 8) { const float av = ps[32 + lane], bv = ps[40 + lane];
            const float g = -expf(c.gdn_a_log()[l * 8 + lane]) * softplus_f(av + c.gdn_dt_bias()[l * 8 + lane]);
            c.GGB()[(size_t)row * 16 + lane] = g; c.GGB()[(size_t)row * 16 + 8 + lane] = 1.0f / (1.0f + expf(-bv)); }
        {
            const u2 qr = *(const u2*)(c.P() + (size_t)row * NP + PC_GLQ + lane * 4), kr = *(const u2*)(c.P() + (size_t)row * NP + PC_GLK + lane * 4);
            float q[4] = {bf2f(qr.x & 0xffffu), bf2f(qr.x >> 16), bf2f(qr.y & 0xffffu), bf2f(qr.y >> 16)};
            float k[4] = {bf2f(kr.x & 0xffffu), bf2f(kr.x >> 16), bf2f(kr.y & 0xffffu), bf2f(kr.y >> 16)};
            if (row < ML) {
                const int dl = (lane & 15) * 4;
                const int pos = (dl < 32) ? (t >> 6) : (t & 63);
                const bool lo = (lane & 4) == 0;
                const int fi = (lane & 3) * 4;
#pragma unroll
                for (int i = 0; i < 4; ++i) { const float cs = c.ROPE()[(pos * 16 + fi + i) * 2], sn = c.ROPE()[(pos * 16 + fi + i) * 2 + 1];
                    const float qo = __shfl_xor(q[i], 4), ko = __shfl_xor(k[i], 4);
                    q[i] = lo ? q[i] * cs - qo * sn : q[i] * cs + qo * sn; k[i] = lo ? k[i] * cs - ko * sn : k[i] * cs + ko * sn; }
            }
            *(f4*)(c.LQ() + (size_t)row * 256 + lane * 4) = (f4){q[0] * 0.125f, q[1] * 0.125f, q[2] * 0.125f, q[3] * 0.125f};
            *(f4*)(c.LK() + (size_t)row * 256 + lane * 4) = (f4){k[0], k[1], k[2], k[3]};
            const float* gw = c.gla_gate_w() + (size_t)l * 2 * 16 * 256; const float* gb = c.gla_gate_b() + (size_t)l * 2 * 256;
#pragma unroll
            for (int n = 0; n < 2; ++n) { f4 z = *(const f4*)(gb + n * 256 + lane * 4);
#pragma unroll
                for (int r = 0; r < 16; ++r) z += ps[n * 16 + r] * *(const f4*)(gw + (n * 16 + r) * 256 + lane * 4);
                f4 la; la.x = logsigmoid_f(z.x) * 0.0625f; la.y = logsigmoid_f(z.y) * 0.0625f; la.z = logsigmoid_f(z.z) * 0.0625f; la.w = logsigmoid_f(z.w) * 0.0625f;
                *(f4*)(c.LA() + ((size_t)n * MROWS + row) * 256 + lane * 4) = la; }
        }
    }
}

__device__ __forceinline__ int scan_row(int s, int b, int dir) { if (s < CTX) return ML + b * CTX + (dir ? CTX - 1 - s : s); const int u = s - CTX; return b * SEQ + (dir ? SEQ - 1 - u : u); }
__device__ __forceinline__ void gla_scan_task(const Ctx& c, int b, int h, int dir) {
    float* sq = (float*)c.lds; float* sk = sq + 2048; float* sa = sk + 2048; float* sv = sa + 2048;
    const int e = c.wave * 16 + (c.lane & 15), dg = c.lane >> 4, d0 = dg * 16;
    float S[16];
#pragma unroll
    for (int i = 0; i < 16; ++i) S[i] = 0.f;
    for (int cs = 0; cs < (CTX + SEQ) / 32; ++cs) {
        __syncthreads();
        for (int idx = c.tid; idx < 2048; idx += NTHREADS) { const int tk = idx >> 6, d = idx & 63, row = scan_row(cs * 32 + tk, b, dir);
            sq[idx] = c.LQ()[(size_t)row * 256 + h * 64 + d]; sk[idx] = c.LK()[(size_t)row * 256 + h * 64 + d]; sa[idx] = expf(c.LA()[((size_t)dir * MROWS + row) * 256 + h * 64 + d]); }
        for (int idx = c.tid; idx < 4096; idx += NTHREADS) { const int tk = idx >> 7, e2 = idx & 127, row = scan_row(cs * 32 + tk, b, dir);
            sv[idx] = bf2f(c.P()[(size_t)row * NP + PC_GLV + h * 128 + e2]); }
        __syncthreads();
        for (int tk = 0; tk < 32; ++tk) {
            const float ve = sv[tk * 128 + e]; float o = 0.f;
#pragma unroll
            for (int i = 0; i < 16; ++i) { const int d = tk * 64 + d0 + i; S[i] = sa[d] * S[i] + sk[d] * ve; o += sq[d] * S[i]; }
            o += __shfl_xor(o, 16); o += __shfl_xor(o, 32);
            if (dg == 0) c.OGLA()[((size_t)dir * MROWS + scan_row(cs * 32 + tk, b, dir)) * 512 + h * 128 + e] = o;
        }
    }
}
__device__ __forceinline__ void gdn_scan_task(const Ctx& c, int b, int h, int dir) {
    float* sq = (float*)c.lds; float* sk = sq + 4096; float* sv = sk + 4096; float* sg = sv + 4096; float* sb = sg + 32;
    const int e = c.wave * 16 + (c.lane & 15), dg = c.lane >> 4, d0 = dg * 32;
    float S[32];
#pragma unroll
    for (int i = 0; i < 32; ++i) S[i] = 0.f;
    for (int cs = 0; cs < (CTX + SEQ) / 32; ++cs) {
        __syncthreads();
        for (int idx = c.tid; idx < 4096; idx += NTHREADS) { const int tk = idx >> 7, d = idx & 127, row = scan_row(cs * 32 + tk, b, dir); const float* g = c.GQKV() + (size_t)row * 1536 + h * 128 + d;
            sq[idx] = g[0]; sk[idx] = g[512]; sv[idx] = g[1024]; }
        if (c.tid < 32) { const int row = scan_row(cs * 32 + c.tid, b, dir); sg[c.tid] = expf(c.GGB()[(size_t)row * 16 + dir * 4 + h]); sb[c.tid] = c.GGB()[(size_t)row * 16 + 8 + dir * 4 + h]; }
        __syncthreads();
        for (int tk = 0; tk < 32; ++tk) {
            float ks = 0.f;
#pragma unroll
            for (int i = 0; i < 32; ++i) ks += sk[tk * 128 + d0 + i] * S[i];
            ks += __shfl_xor(ks, 16); ks += __shfl_xor(ks, 32);
            const float eg = sg[tk], delta = sb[tk] * (sv[tk * 128 + e] - eg * ks);
            float o = 0.f;
#pragma unroll
            for (int i = 0; i < 32; ++i) { const int d = tk * 128 + d0 + i; S[i] = eg * S[i] + sk[d] * delta; o += sq[d] * S[i]; }
            o += __shfl_xor(o, 16); o += __shfl_xor(o, 32);
            if (dg == 0) c.OGDN()[((size_t)dir * MROWS + scan_row(cs * 32 + tk, b, dir)) * 512 + h * 128 + e] = o;
        }
    }
}
__device__ __forceinline__ void na_task(const Ctx& c, int l, int task, int lane) {
    const bool lat = task < ML * 16;
    const int tq = lat ? task : task - ML * 16;
    const int h = tq & 15, row = (tq >> 4) + (lat ? 0 : ML);
    const int b = lat ? (row >> 12) : ((row - ML) >> 8);
    const bf16* P = c.P();
    const float qv = bf2f(P[(size_t)row * NP + PC_NAQ + h * 64 + lane]) * 0.125f;
    int krow[6]; float sc[6];
#pragma unroll
    for (int i = 0; i < 4; ++i) { krow[2 + i] = ML + b * CTX + lane + 64 * i; sc[2 + i] = 0.f; }
    if (lat) { const int t = row & (SEQ - 1), r = t >> 6, cq = t & 63; const int rs = min(max(r - 4, 0), 56), cs = min(max(cq - 8, 0), 48);
#pragma unroll
        for (int i = 0; i < 2; ++i) { const int lk = lane + 64 * i, j = lk >> 4, cc = lk & 15; krow[i] = b * SEQ + (rs + j) * 64 + cs + cc;
            sc[i] = c.na_rpb()[((size_t)(l * 16 + h) * 15 + (rs + j - r + 7)) * 31 + (cs + cc - cq + 15)]; } }
    else { krow[0] = krow[2]; krow[1] = krow[2]; sc[0] = -INFINITY; sc[1] = -INFINITY; }
#pragma unroll
    for (int i = 0; i < 6; ++i) {
        if (i >= 2 || lat) { const bf16* kp = P + (size_t)krow[i] * NP + PC_NAK + h * 64; float s = 0.f;
#pragma unroll
            for (int m = 0; m < 8; ++m) { const u4 w = *(const u4*)(kp + 8 * m);
                s += __int_as_float(__builtin_amdgcn_readlane(__float_as_int(qv), 8 * m + 0)) * bf2f(w.x & 0xffffu); s += __int_as_float(__builtin_amdgcn_readlane(__float_as_int(qv), 8 * m + 1)) * bf2f(w.x >> 16);
                s += __int_as_float(__builtin_amdgcn_readlane(__float_as_int(qv), 8 * m + 2)) * bf2f(w.y & 0xffffu); s += __int_as_float(__builtin_amdgcn_readlane(__float_as_int(qv), 8 * m + 3)) * bf2f(w.y >> 16);
                s += __int_as_float(__builtin_amdgcn_readlane(__float_as_int(qv), 8 * m + 4)) * bf2f(w.z & 0xffffu); s += __int_as_float(__builtin_amdgcn_readlane(__float_as_int(qv), 8 * m + 5)) * bf2f(w.z >> 16);
                s += __int_as_float(__builtin_amdgcn_readlane(__float_as_int(qv), 8 * m + 6)) * bf2f(w.w & 0xffffu); s += __int_as_float(__builtin_amdgcn_readlane(__float_as_int(qv), 8 * m + 7)) * bf2f(w.w >> 16); }
            sc[i] += s; } }
    float mx = sc[0];
#pragma unroll
    for (int i = 1; i < 6; ++i) mx = fmaxf(mx, sc[i]);
    mx = wave_max(mx);
    float sum = 0.f;
#pragma unroll
    for (int i = 0; i < 6; ++i) { sc[i] = expf(sc[i] - mx); sum += sc[i]; }
    sum = wave_sum(sum);
    const float inv = 1.0f / sum;
    float o = 0.f;
    const bf16* vp = P + PC_NAV + h * 64 + lane;
#pragma unroll
    for (int i = 0; i < 6; ++i) {
        if (i >= 2 || lat) {
#pragma unroll 8
            for (int sl = 0; sl < 64; ++sl) { const float p = __int_as_float(__builtin_amdgcn_readlane(__float_as_int(sc[i]), sl)); const int kr = __builtin_amdgcn_readlane(krow[i], sl);
                o += p * bf2f(vp[(size_t)kr * NP]); } } }
    c.CAT()[(size_t)row * D + h * 64 + lane] = (bf16)f2bf(o * inv);
}
__device__ __forceinline__ void ph_scan_na(const Ctx& c, int l) {
    for (int bt = blockIdx.x; bt < 32; bt += gridDim.x) { const int kind = bt >> 4, dir = (bt >> 3) & 1, b = (bt >> 2) & 1, h = bt & 3;
        if (kind == 0) gla_scan_task(c, b, h, dir); else gdn_scan_task(c, b, h, dir); }
    __syncthreads();
    const int ntask = ML * 16 + (l == 0 ? MC * 16 : 0), nchunk = ntask / 512;
    int* sh = (int*)(c.lds + MISC_OFF + 64);
    for (;;) {
        __syncthreads();
        if (c.tid == 0) *sh = (int)atomicAdd(c.ctl() + CW_NAQ + 64 * l, 1u);
        __syncthreads();
        const int ch = *sh;
        if (ch >= nchunk) break;
        for (int i = 0; i < 64; ++i) na_task(c, l, ch * 512 + c.wave * 64 + i, c.lane);
    }
}

__device__ __forceinline__ void ph_combine(const Ctx& c, int l) {
    const int lane = c.lane; const int nrows = l == 0 ? MROWS : ML;
    for (int row = c.gw; row < nrows; row += c.ngw) {
#pragma unroll
        for (int which = 0; which < 2; ++which) {
            const float* O = which == 0 ? c.OGLA() : c.OGDN(); const float* nwp = (which == 0 ? c.gla_norm_w() : c.gdn_norm_w()) + l * 128 + (lane & 15) * 8;
            const int gcol = (which == 0 ? PC_GLG : PC_GDZ) + lane * 8;
            const f4 a0 = *(const f4*)(O + (size_t)row * 512 + lane * 8), a1 = *(const f4*)(O + (size_t)row * 512 + lane * 8 + 4);
            const f4 b0 = *(const f4*)(O + ((size_t)MROWS + row) * 512 + lane * 8), b1 = *(const f4*)(O + ((size_t)MROWS + row) * 512 + lane * 8 + 4);
            float o[8] = {a0.x + b0.x, a0.y + b0.y, a0.z + b0.z, a0.w + b0.w, a1.x + b1.x, a1.y + b1.y, a1.z + b1.z, a1.w + b1.w};
            float ss = 0.f;
#pragma unroll
            for (int i = 0; i < 8; ++i) ss += o[i] * o[i];
            ss += __shfl_xor(ss, 1); ss += __shfl_xor(ss, 2); ss += __shfl_xor(ss, 4); ss += __shfl_xor(ss, 8);
            const float rstd = 1.0f / sqrtf(ss * (1.0f / 128.f) + 1e-6f);
            const u4 graw = *(const u4*)(c.P() + (size_t)row * NP + gcol);
            const float g[8] = {bf2f(graw.x & 0xffffu), bf2f(graw.x >> 16), bf2f(graw.y & 0xffffu), bf2f(graw.y >> 16), bf2f(graw.z & 0xffffu), bf2f(graw.z >> 16), bf2f(graw.w & 0xffffu), bf2f(graw.w >> 16)};
            float y[8];
#pragma unroll
            for (int i = 0; i < 8; ++i) y[i] = o[i] * rstd * nwp[i] * silu_f(g[i]);
            u4 w; w.x = pk2(y[0], y[1]); w.y = pk2(y[2], y[3]); w.z = pk2(y[4], y[5]); w.w = pk2(y[6], y[7]);
            *(u4*)(c.CAT() + (size_t)row * D + 1024 + which * 512 + lane * 8) = w;
        }
    }
}

__device__ __forceinline__ void ph_norm2_router(const Ctx& c, int l) {
    float* WR = (float*)c.lds;
    const float* wr = c.w_router() + (size_t)l * D * NE;
    __syncthreads();
    for (int idx = c.tid; idx < D * NE; idx += NTHREADS) WR[(idx & 15) * D + (idx >> 4)] = wr[idx];
    __syncthreads();
    const int lane = c.lane; const int nrows = l == 0 ? MROWS : ML;
    for (int row = c.gw; row < nrows; row += c.ngw) {
        const float* xr = c.HX() + (size_t)row * D;
        f4 v[8]; float ss = 0.f;
#pragma unroll
        for (int j = 0; j < 8; ++j) { v[j] = *(const f4*)(xr + 4 * lane + 256 * j); ss += v[j].x * v[j].x + v[j].y * v[j].y + v[j].z * v[j].z + v[j].w * v[j].w; }
        ss = wave_sum(ss);
        const float rstd = 1.0f / sqrtf(ss * (1.0f / D) + 1e-6f);
        const float* nw = c.norm_ffn_w() + (size_t)l * D; const float* md = c.MOD() + (size_t)(l * 3 + modrow(row)) * MODW;
        bf16* orow = c.NX() + (size_t)row * D;
#pragma unroll
        for (int j = 0; j < 8; ++j) { const int col = 4 * lane + 256 * j; const f4 w = *(const f4*)(nw + col), sh = *(const f4*)(md + 3 * D + col), sc = *(const f4*)(md + 4 * D + col);
            v[j] = v[j] * rstd * w * (1.0f + sc) + sh; u2 o; o.x = pk2(v[j].x, v[j].y); o.y = pk2(v[j].z, v[j].w); *(u2*)(orow + col) = o; }
        float lg[16];
#pragma unroll
        for (int e = 0; e < 16; ++e) { float s = 0.f;
            asm volatile("" ::: "memory");
#pragma unroll
            for (int j = 0; j < 8; ++j) { const f4 w = *(const f4*)(WR + e * D + 256 * j + 4 * lane); s += v[j].x * w.x + v[j].y * w.y + v[j].z * w.z + v[j].w * w.w; }
            lg[e] = wave_sum(s); }
        float mx = lg[0];
#pragma unroll
        for (int e = 1; e < 16; ++e) mx = fmaxf(mx, lg[e]);
        float sum = 0.f;
#pragma unroll
        for (int e = 0; e < 16; ++e) { lg[e] = expf(lg[e] - mx); sum += lg[e]; }
        float mine = 0.f;
#pragma unroll
        for (int e = 0; e < 16; ++e) mine = (lane == e) ? lg[e] : mine;
        if (lane < 16) c.AFF()[(size_t)row * 16 + lane] = mine / sum;
    }
}

__device__ __forceinline__ int block_excl_scan(int v, int* sc, int tid, int& total) {
    const int lane = tid & 63, w = tid >> 6; int x = v;
#pragma unroll
    for (int o = 1; o < 64; o <<= 1) { const int y = __shfl_up(x, o); if (lane >= o) x += y; }
    if (lane == 63) sc[w] = x;
    __syncthreads();
    int woff = 0, tot = 0;
#pragma unroll
    for (int i = 0; i < NWAVES; ++i) { const int t = sc[i]; woff += (i < w) ? t : 0; tot += t; }
    __syncthreads();
    total = tot; return woff + x - v;
}
__device__ __forceinline__ void ph_topk(const Ctx& c, int l) {
    unsigned* keys = (unsigned*)c.lds; unsigned* hist = keys + 4096; unsigned* misc = hist + 256; int* scs = (int*)(misc + 16);
    const int ntask = l == 0 ? 64 : 32, tid = c.tid;
    for (int task = blockIdx.x; task < ntask; task += gridDim.x) {
        const int s = task >> 5, b = (task >> 4) & 1, e = task & 15;
        const int n = s ? CTX : SEQ, cap = s ? 32 : 512, base_row = s ? ML + b * CTX : b * SEQ, slot_base = s ? 1024 + b * 32 : b * 512;
        __syncthreads();
        for (int i = tid; i < n; i += NTHREADS) keys[i] = __float_as_uint(c.AFF()[(size_t)(base_row + i) * 16 + e]);
        if (tid == 0) { misc[0] = 0u; misc[1] = (unsigned)cap; }
        unsigned prefix = 0u, mask = 0u;
        for (int shift = 24; shift >= 0; shift -= 8) {
            if (tid < 256) hist[tid] = 0u;
            __syncthreads();
            for (int i = tid; i < n; i += NTHREADS) { const unsigned k = keys[i]; if ((k & mask) == prefix) atomicAdd(&hist[(k >> shift) & 255u], 1u); }
            __syncthreads();
            if (tid == 0) { const unsigned kk = misc[1]; unsigned cum = 0u; int bin = 255; for (; bin > 0; --bin) { const unsigned hb = hist[bin]; if (cum + hb >= kk) break; cum += hb; }
                misc[0] = prefix | ((unsigned)bin << shift); misc[1] = kk - cum; }
            __syncthreads();
            prefix = misc[0]; mask |= 255u << shift;
        }
        const unsigned thr = prefix; const int need = (int)misc[1];
        const int ipt = n >= NTHREADS ? n / NTHREADS : 1, i0 = tid * ipt;
        int cg = 0, ce = 0;
        if (i0 < n) for (int i = 0; i < ipt; ++i) { const unsigned k = keys[i0 + i]; cg += k > thr; ce += k == thr; }
        int G, Etot;
        int og = block_excl_scan(cg, scs, tid, G);
        int oe = block_excl_scan(ce, scs, tid, Etot);
        if (i0 < n) for (int i = 0; i < ipt; ++i) { const unsigned k = keys[i0 + i]; int slot = -1;
            if (k > thr) slot = og++; else if (k == thr) { if (oe < need) slot = G + oe; ++oe; }
            if (slot >= 0) { c.IDX()[e * ESLOT + slot_base + slot] = base_row + i0 + i; c.GATEV()[e * ESLOT + slot_base + slot] = __uint_as_float(k); } }
    }
}

__device__ __forceinline__ void ph_gather(const Ctx& c, int l) {
    const int nsl = l == 0 ? 1088 : 1024, ntask = NE * nsl;
    for (int task = c.gw; task < ntask; task += c.ngw) { const int e = task / nsl, slot = task % nsl; const int tok = c.IDX()[e * ESLOT + slot];
        const u4* src = (const u4*)(c.NX() + (size_t)tok * D); u4* dst = (u4*)(c.AMOE() + ((size_t)e * ESLOT + slot) * D);
#pragma unroll
        for (int j = 0; j < 4; ++j) dst[c.lane + 64 * j] = src[c.lane + 64 * j]; }
}

__device__ __forceinline__ void ph_final(const Ctx& c) {
    const int lane = c.lane;
    for (int row = c.gw; row < ML; row += c.ngw) {
        const float* xr = c.HX() + (size_t)row * D;
        f4 v[8]; float ss = 0.f;
#pragma unroll
        for (int j = 0; j < 8; ++j) { v[j] = *(const f4*)(xr + 4 * lane + 256 * j); ss += v[j].x * v[j].x + v[j].y * v[j].y + v[j].z * v[j].z + v[j].w * v[j].w; }
        ss = wave_sum(ss);
        const float rstd = 1.0f / sqrtf(ss * (1.0f / D) + 1e-6f);
#pragma unroll
        for (int j = 0; j < 8; ++j) { const int col = 4 * lane + 256 * j; *(f4*)(c.out() + (size_t)row * D + col) = v[j] * rstd * *(const f4*)(c.final_norm_w() + col); }
    }
}

constexpr int NPH_LAYER = 11, NPHASES = 2 + 2 * NPH_LAYER;
__global__ void __launch_bounds__(NTHREADS, 2) fwd(Params p) {
    extern __shared__ __attribute__((aligned(16))) unsigned char lds[];
    Ctx cb;
    cb.lds = lds; cb.tid = threadIdx.x; cb.lane = cb.tid & 63; cb.wave = __builtin_amdgcn_readfirstlane(cb.tid >> 6);
    cb.gw = blockIdx.x * NWAVES + cb.wave; cb.ngw = gridDim.x * NWAVES;
    cb.kp = (KParams)__builtin_amdgcn_kernarg_segment_ptr(); cb.ws = p.ws;
    LAS unsigned char* ldsl = (LAS unsigned char*)lds;
    volatile LAS unsigned* MISC = (volatile LAS unsigned*)(ldsl + MISC_OFF);
    if (cb.tid < 64) MISC[cb.tid] = 0u;
    __syncthreads();
    const int lo = p.ph_lo, hi = p.ph_hi;
    XcdBarrier bar; bar.bar = cb.ctl() + CW_BAR; bar.x = 0; bar.st = MISC;
    if (hi - lo > 1) bar = xcd_barrier_post(cb.ctl() + CW_BAR, MISC);
#ifndef PHMASK
#define PHMASK 0xffff
#endif
#define RUN(ty, k, ...) do { if constexpr (((PHMASK) >> (ty)) & 1) { if (lo <= (k) && (k) < hi) { Ctx c = cb; asm volatile("" : "+s"(c.ws)); asm volatile("" : "+s"(c.kp)); asm volatile("" : "+v"(c.tid)); c.lane = c.tid & 63; c.wave = __builtin_amdgcn_readfirstlane(c.tid >> 6); c.gw = blockIdx.x * NWAVES + c.wave; __VA_ARGS__; if ((k) + 1 < hi) xcd_barrier(bar); } } } while (0)
    RUN(0, 0, ph_prologue(c));
    for (int l = 0; l < 2; ++l) {
        const int pb = 1 + NPH_LAYER * l;
        RUN(1, pb + 0, ph_norm1(c, l));
        RUN(2, pb + 1, { pg8::Gemm g{c.NX(), c.WIN() + (size_t)l * NP * D, MROWS, NP, D}; pg8::StaticOrder S; S.init(MROWS, NP, (int)gridDim.x, (int)blockIdx.x); EpiP E{c.P(), c.PS()};
                      pg8::gemm_phase<EpiP, pg8::StaticOrder>(ldsl, g, S, E, nullptr); });
        RUN(3, pb + 2, ph_prep(c, l));
        RUN(4, pb + 3, ph_scan_na(c, l));
        RUN(5, pb + 4, ph_combine(c, l));
        RUN(6, pb + 5, { pg8::Gemm g{c.CAT(), c.WOUT() + (size_t)l * D * D, MROWS, D, D}; RowOrder S{l == 0 ? 34 : 32, 8, (int)gridDim.x, (int)blockIdx.x}; EpiResid E{c.x(), c.ctxin(), c.MOD(), c.HX(), l};
                      pg8::gemm_phase<EpiResid, RowOrder>(ldsl, g, S, E, nullptr); });
        RUN(7, pb + 6, ph_norm2_router(c, l));
        RUN(8, pb + 7, ph_topk(c, l));
        RUN(9, pb + 8, ph_gather(c, l));
        RUN(10, pb + 9, { pg8::Gemm g{c.AMOE(), c.WGU() + (size_t)l * NE * 4096 * D, NE * ESLOT, NE * 4096, D}; MoeOrder S{l == 0 ? 5 : 4, 16, (int)gridDim.x, (int)blockIdx.x}; EpiSwiglu E{c.HID()};
                      pg8::gemm_phase<EpiSwiglu, MoeOrder>(ldsl, g, S, E, nullptr); });
        RUN(11, pb + 10, { pg8::Gemm g{c.HID(), c.WDN() + (size_t)l * NE * D * FF, NE * ESLOT, NE * D, FF}; MoeOrder S{l == 0 ? 5 : 4, 8, (int)gridDim.x, (int)blockIdx.x}; EpiDown E{c.IDX(), c.GATEV(), c.MOD(), c.HX(), l, l == 0 ? 1088 : 1024};
                      pg8::gemm_phase<EpiDown, MoeOrder>(ldsl, g, S, E, nullptr); });
    }
    RUN(12, NPHASES - 1, ph_final(c));
#undef RUN
}

extern "C" void kernel_launch(void* const* d_in, const int* in_sizes, int n_in, void* d_out, int out_size, void* d_ws, size_t ws_size, hipStream_t stream) {
    static int grid = 0;
    if (grid == 0) {
        if (n_in != 23 || ws_size < WS_END) { fprintf(stderr, "kernel_launch: need 23 inputs and %zu bytes of workspace (got %d, %zu)\n", (size_t)WS_END, n_in, ws_size); grid = -1; return; }
        int dev = 0, cus = 0, per_cu = 0;
        if (hipGetDevice(&dev) != hipSuccess || hipDeviceGetAttribute(&cus, hipDeviceAttributeMultiprocessorCount, dev) != hipSuccess) { grid = -1; return; }
        if (hipFuncSetAttribute((const void*)fwd, hipFuncAttributeMaxDynamicSharedMemorySize, LDS_BYTES) != hipSuccess) { fprintf(stderr, "kernel_launch: hipFuncSetAttribute failed\n"); grid = -1; return; }
        if (hipOccupancyMaxActiveBlocksPerMultiprocessor(&per_cu, (const void*)fwd, NTHREADS, LDS_BYTES) != hipSuccess || per_cu < 1) { fprintf(stderr, "kernel_launch: occupancy query says %d\n", per_cu); per_cu = 1; }
        grid = cus;
    }
    if (grid <= 0) return;
    hipMemsetAsync((char*)d_ws + WS_CTL, 0, CTL_BYTES, stream);
    Params p; memset(&p, 0, sizeof(p));
    for (int i = 0; i < 23; ++i) p.in[i] = (const float*)d_in[i];
    p.out = (float*)d_out; p.ws = (unsigned char*)d_ws;
#if ONE_LAUNCH
    p.ph_lo = 0; p.ph_hi = NPHASES;
    hipLaunchKernelGGL(fwd, dim3(grid), dim3(NTHREADS), LDS_BYTES, stream, p);
#else
    for (int k = 0; k < NPHASES; ++k) { p.ph_lo = k; p.ph_hi = k + 1; hipLaunchKernelGGL(fwd, dim3(grid), dim3(NTHREADS), LDS_BYTES, stream, p); }
#endif
}
```

```cpp
#include <hip/hip_runtime.h>
#include <cstdio>
#include <cstdint>
#include <cstring>

#ifndef F8MASK
#define F8MASK 3
#endif
#ifndef L2PROBE
#define L2PROBE 0
#endif
#ifndef SUBREP
#define SUBREP 0
#endif
#ifndef ONE_LAUNCH
#define ONE_LAUNCH 1
#endif

#define LAS __attribute__((address_space(3)))
typedef unsigned short bf16;
typedef float f4 __attribute__((ext_vector_type(4)));
typedef unsigned u4 __attribute__((ext_vector_type(4)));
typedef unsigned u2 __attribute__((ext_vector_type(2)));

constexpr int D = 2048, NB = 2, SEQ = 4096, CTX = 256;
constexpr int ML = NB * SEQ, MC = NB * CTX, MROWS = ML + MC;
constexpr int INW = 6704, NP = 6912;
constexpr int NE = 16, FF = 2048, ESLOT = 1280;
constexpr int MODW = 6 * D;
constexpr int PC_NAQ = 0, PC_NAK = 1024, PC_NAV = 2048, PC_GLQ = 3072, PC_GLK = 3328, PC_GLV = 3584, PC_GLG = 4096, PC_GDQ = 4608, PC_GDZ = 6144, PC_SMALL = 6656;
constexpr int NTHREADS = 512, NWAVES = 8;
constexpr int LDS_BYTES = 163840, MISC_OFF = LDS_BYTES - 256;

constexpr size_t al256(size_t x) { return (x + 255) & ~(size_t)255; }
constexpr size_t WS_CTL = 0, CTL_BYTES = 1u << 20;
constexpr size_t WS_MOD = WS_CTL + CTL_BYTES;
constexpr size_t WS_ROPE = al256(WS_MOD + (size_t)2 * 3 * MODW * 4);
constexpr size_t WS_WIN = al256(WS_ROPE + 64 * 16 * 2 * 4);
constexpr size_t WS_WOUT = al256(WS_WIN + (size_t)2 * NP * D * 2);
constexpr size_t WS_WGU = al256(WS_WOUT + (size_t)2 * D * D * 2);
constexpr size_t WS_WDN = al256(WS_WGU + (size_t)2 * NE * 2 * FF * D * 2);
constexpr size_t WS_HX = al256(WS_WDN + (size_t)2 * NE * D * FF * 2);
constexpr size_t WS_NX = al256(WS_HX + (size_t)MROWS * D * 4);
constexpr size_t WS_P = al256(WS_NX + (size_t)MROWS * D * 2);
constexpr size_t WS_PS = al256(WS_P + (size_t)MROWS * NP * 2);
constexpr size_t WS_GQKV = al256(WS_PS + (size_t)MROWS * 64 * 4);
constexpr size_t WS_GGB = al256(WS_GQKV + (size_t)MROWS * 1536 * 4);
constexpr size_t WS_LQ = al256(WS_GGB + (size_t)MROWS * 16 * 4);
constexpr size_t WS_LK = al256(WS_LQ + (size_t)MROWS * 256 * 4);
constexpr size_t WS_LA = al256(WS_LK + (size_t)MROWS * 256 * 4);
constexpr size_t WS_OGLA = al256(WS_LA + (size_t)2 * MROWS * 256 * 4);
constexpr size_t WS_OGDN = al256(WS_OGLA + (size_t)2 * MROWS * 512 * 4);
constexpr size_t WS_CAT = al256(WS_OGDN + (size_t)2 * MROWS * 512 * 4);
constexpr size_t WS_AFF = al256(WS_CAT + (size_t)MROWS * D * 2);
constexpr size_t WS_IDX = al256(WS_AFF + (size_t)MROWS * 16 * 4);
constexpr size_t WS_GATE = al256(WS_IDX + (size_t)NE * ESLOT * 4);
constexpr size_t WS_AMOE = al256(WS_GATE + (size_t)NE * ESLOT * 4);
constexpr size_t WS_HID = al256(WS_AMOE + (size_t)NE * ESLOT * D * 2);
constexpr int UDS = 69;
constexpr int NUD = 2 * 4 * UDS * 2;
constexpr size_t WS_GDQP = al256(WS_HID + (size_t)NE * ESLOT * FF * 2);
constexpr size_t WS_GDO0 = al256(WS_GDQP + (size_t)NUD * 64 * 128 * 2);
constexpr size_t WS_GDAP = al256(WS_GDO0 + (size_t)NUD * 64 * 128 * 4);
constexpr size_t WS_GDBM = al256(WS_GDAP + (size_t)NUD * 128 * 128 * 2);
constexpr size_t WS_GDGL = al256(WS_GDBM + (size_t)NUD * 128 * 128 * 4);
constexpr size_t WS_GLQT = al256(WS_GDGL + (size_t)NUD * 4);
constexpr size_t WS_GLKT = al256(WS_GLQT + (size_t)NUD * 4096 * 2);
constexpr size_t WS_GLKH = al256(WS_GLKT + (size_t)NUD * 4096 * 2);
constexpr size_t WS_GLVT = al256(WS_GLKH + (size_t)NUD * 4096 * 2);
constexpr size_t WS_GLDEC = al256(WS_GLVT + (size_t)NUD * 8192 * 2);
constexpr size_t WS_GDST = al256(WS_GLDEC + (size_t)NUD * 64 * 4);
constexpr size_t WS_GLST = al256(WS_GDST + (size_t)NUD * 16384 * 2);
constexpr size_t WS_SLOTOF = al256(WS_GLST + (size_t)NUD * 8192 * 2);
constexpr size_t WS_Y = al256(WS_SLOTOF + (size_t)NE * MROWS * 4);
constexpr size_t WS_END = al256(WS_Y + (size_t)NE * ESLOT * D * 2);
constexpr int CW_BAR = 1024;
constexpr int CW_PROQ = 7040;
constexpr int CW_TP = 9216;
constexpr int CW_CHQ = 7680;
constexpr int CW_NAQ = 8192;

__device__ __forceinline__ float bf2f(unsigned b) { return __uint_as_float(b << 16); }
__device__ __forceinline__ unsigned f2bf(float f) { unsigned u = __float_as_uint(f); return (u + 0x7fffu + ((u >> 16) & 1u)) >> 16; }
typedef __bf16 bf2_t __attribute__((ext_vector_type(2)));
typedef float f2_t __attribute__((ext_vector_type(2)));
__device__ __forceinline__ unsigned pk2(float lo, float hi) { const bf2_t r = __builtin_convertvector((f2_t){lo, hi}, bf2_t); return __builtin_bit_cast(unsigned, r); }
__device__ __forceinline__ float wave_sum(float v) {
#pragma unroll
    for (int o = 1; o < 64; o <<= 1) v += __shfl_xor(v, o);
    return v;
}
__device__ __forceinline__ float wave_max(float v) {
#pragma unroll
    for (int o = 1; o < 64; o <<= 1) v = fmaxf(v, __shfl_xor(v, o));
    return v;
}
__device__ __forceinline__ float silu_f(float x) { return x * __builtin_amdgcn_rcpf(1.f + __expf(-x)); }
__device__ __forceinline__ float softplus_f(float x) { return x > 20.f ? x : log1pf(__expf(x)); }
__device__ __forceinline__ float logsigmoid_f(float z) { return fminf(z, 0.f) - __logf(1.f + __expf(-fabsf(z))); }
#define LDS_WAIT() asm volatile("s_waitcnt lgkmcnt(0)" ::: "memory")
#define XB_TMO      128
#define XB_XCNT(j)  (256  + 64 * (j))
#define XB_XSUB(j)  (1280 + 64 * (j))
#define XB_XGEN(j)  (2304 + 64 * (j))
#define XB_TOP      3328
#define XB_TOPGEN   3392
#define XCD_BAR_WORDS 3456
#define XB_SPIN_CAP (1u << 20)

__device__ __forceinline__ unsigned xb_ld(unsigned* p)              { return __hip_atomic_load(p, __ATOMIC_RELAXED, __HIP_MEMORY_SCOPE_AGENT); }
__device__ __forceinline__ unsigned xb_add(unsigned* p, unsigned v) { return __hip_atomic_fetch_add(p, v, __ATOMIC_RELAXED, __HIP_MEMORY_SCOPE_AGENT); }
__device__ __forceinline__ unsigned xb_xcc_id() { return (unsigned)__builtin_amdgcn_s_getreg((3 << 11) | 20) & 0xFu; }
#define XB_SPIN(cond, bar) do { unsigned _sp = 0; while (cond) { __builtin_amdgcn_s_sleep(1); \
    if ((++_sp & 255u) == 0u) { if (xb_ld(&(bar)[XB_TMO])) break; if (_sp > XB_SPIN_CAP) { atomicAdd(&(bar)[XB_TMO], 1u); break; } } } } while (0)

struct XcdBarrier {
    unsigned* bar; unsigned x;
    volatile LAS unsigned* st;
};

__device__ __forceinline__ XcdBarrier xcd_barrier_post(unsigned* bar, volatile LAS unsigned* st) {
    XcdBarrier b; b.bar = bar; b.x = xb_xcc_id(); b.st = st;
    if (threadIdx.x == 0) (void)xb_add(&bar[XB_XCNT(b.x)], 1u);
    return b;
}
__device__ __forceinline__ void xcd_barrier_complete(unsigned* bar, unsigned x, unsigned& nloc, unsigned& nx) {
    const unsigned G = gridDim.x * gridDim.y * gridDim.z;
    unsigned sum, cnt, mine, sp = 0u;
    for (;;) {
        sum = 0u; cnt = 0u; mine = 0u;
#pragma unroll
        for (unsigned j = 0; j < 16; ++j) { const unsigned c = xb_ld(&bar[XB_XCNT(j)]); sum += c; cnt += (c > 0u) ? 1u : 0u; mine = (j == x) ? c : mine; }
        if (sum == G) break;
        __builtin_amdgcn_s_sleep(1);
        if ((++sp & 255u) == 0u) { if (xb_ld(&bar[XB_TMO])) break; if (sp > XB_SPIN_CAP) { atomicAdd(&bar[XB_TMO], 1u); break; } }
    }
    nloc = mine > 0u ? mine : 1u; nx = cnt > 0u ? cnt : 1u;
}

__device__ __forceinline__ void xcd_barrier(const XcdBarrier& b) {
    asm volatile("s_waitcnt vmcnt(0)" ::: "memory");
    __syncthreads();
    if (threadIdx.x == 0) {
        unsigned* bar = b.bar;
        __builtin_amdgcn_s_waitcnt(0);
        unsigned nloc = b.st[0], nx = b.st[1];
        if (nloc == 0u) { xcd_barrier_complete(bar, b.x, nloc, nx); b.st[0] = nloc; b.st[1] = nx; }
        const unsigned old = xb_add(&bar[XB_XSUB(b.x)], 1u);
        const unsigned gen = old / nloc;
        if (old + 1u == (gen + 1u) * nloc) {
            __builtin_amdgcn_fence(__ATOMIC_RELEASE, "agent");
            asm volatile("s_waitcnt vmcnt(0)" ::: "memory");
            const unsigned og = xb_add(&bar[XB_TOP], 1u);
            const unsigned tg = og / nx;
            if (og + 1u == (tg + 1u) * nx) xb_add(&bar[XB_TOPGEN], 1u);
            else XB_SPIN(xb_ld(&bar[XB_TOPGEN]) == tg, bar);
            __builtin_amdgcn_fence(__ATOMIC_ACQUIRE, "agent");
            xb_add(&bar[XB_XGEN(b.x)], 1u);
            asm volatile("s_waitcnt vmcnt(0)" ::: "memory");
        } else {
            XB_SPIN(xb_ld(&bar[XB_XGEN(b.x)]) == gen, bar);
            __builtin_amdgcn_fence(__ATOMIC_ACQUIRE, "agent");
            asm volatile("s_waitcnt vmcnt(0)" ::: "memory");
        }
    }
    __syncthreads();
}

namespace pg8 {
#define PG8_LAS __attribute__((address_space(3)))
typedef unsigned short bf16_t;
typedef short bf16x8 __attribute__((ext_vector_type(8)));
typedef float f32x4 __attribute__((ext_vector_type(4)));
typedef unsigned u32x4 __attribute__((ext_vector_type(4)));
constexpr int BM = 256, BK = 64, HALF = 128, HTB = HALF * BK * 2  , STAGE_BYTES = 8 * HTB, NXCD = 8, WGM = 8;

__host__ __device__ __forceinline__ int lds_byte(int r, int c) { const int st = (r >> 4) * 2 + (c >> 5), rr = r & 15, cc = c & 31, ob = rr * 64 + cc * 2; return st * 1024 + (ob ^ (((ob >> 9) & 1) << 5)); }
__host__ __device__ __forceinline__ void stage_rc(int b, int& R, int& C) { const int st = b / 1024, sb = b % 1024, swz = sb ^ (((sb >> 9) & 1) << 5); R = (st >> 1) * 16 + swz / 64; C = (st & 1) * 32 + (swz % 64) / 2; }
__host__ __device__ __forceinline__ int perm32(int rho) { const int n = rho >> 4, i = rho & 15; return 8 * (i >> 2) + 4 * n + (i & 3); }

struct Unit { int pm, pn; };
struct Gemm { const bf16_t* A; const bf16_t* Bt; int M, N, K; };
struct StaticOrder {
    int nM, nN, nwg, G, c;
    __host__ __device__ void init(int M, int N, int G_, int c_) { nM = M / BM; nN = N / BM; nwg = nM * nN; G = G_; c = c_; }
    __host__ __device__ bool next(int i, Unit& u) const {
        const long L = (long)i * G + c; if (L >= nwg) return false;
        int wgid = (int)L; { const int q = nwg / NXCD, r = nwg % NXCD, xcd = wgid % NXCD, off = wgid / NXCD; wgid = (xcd < r ? xcd * (q + 1) : r * (q + 1) + (xcd - r) * q) + off; }
        const int nig = WGM * nN, gid = wgid / nig, fm = gid * WGM, gsz = (nM - fm) < WGM ? (nM - fm) : WGM;
        u.pm = fm + ((wgid % nig) % gsz); u.pn = (wgid % nig) / gsz; return true;
    }
    __device__ __forceinline__ void a_ready(const Unit&) const {}
    __device__ __forceinline__ void done(const Unit&) const {}
};
__device__ __forceinline__ unsigned cvt_pk_bf16(float lo, float hi) { unsigned r; asm volatile("v_cvt_pk_bf16_f32 %0, %1, %2" : "=v"(r) : "v"(lo), "v"(hi)); return r; }

typedef int v8i32 __attribute__((ext_vector_type(8)));
typedef int v4i32 __attribute__((ext_vector_type(4)));
constexpr int F8_WSCALE_LOG2 = 6;
template <class Epi, class Sched, bool STAMP = false, bool F8 = false>
__device__ __forceinline__ void gemm_phase(PG8_LAS unsigned char* lds, const Gemm g, const Sched& S, const Epi& E, unsigned long long* stamps) {
    int tid_ = threadIdx.x; asm volatile("" : "+v"(tid_));
    const int tid = tid_, wid = __builtin_amdgcn_readfirstlane(tid >> 6), lane = tid & 63, wr = wid >> 2, wc = wid & 3, fr = lane & 15, fq = lane >> 4;
    const int K = g.K, nt = K / BK;
    const int f8_sw = 127 - F8_WSCALE_LOG2, f8_s1 = 127;
    int ts_lo = 0, ts_hi = 0, nts = 0; const unsigned long long rt_entry = STAMP ? (unsigned long long)wall_clock64() : 0ull;
#define PG8_STAMP() do { if (STAMP && wid == 0 && nts < 64) { const unsigned long long _c = (unsigned long long)clock64(); \
        ts_lo = (lane == nts) ? (int)(unsigned)_c : ts_lo; ts_hi = (lane == nts) ? (int)(unsigned)(_c >> 32) : ts_hi; ++nts; } } while (0)
    PG8_STAMP();
    unsigned voffA[2], voffB[2];
#pragma unroll
    for (int i = 0; i < 2; ++i) { int R, C; stage_rc(tid * 16 + i * 8192, R, C); const int Rb = Epi::PERM ? ((R & ~31) + perm32(R & 31)) : R;
        voffA[i] = (unsigned)(R * K + C) * 2u; voffB[i] = (unsigned)(Rb * K + C) * 2u; }
    const size_t kstep = (size_t)(BK * 2);
    const size_t hstep = (size_t)HALF * K * 2;
    const size_t tstep = 2 * hstep;
    const unsigned ldsw = (unsigned)wid * 1024u;
    const int aoff = lds_byte(wr * 64 + fr, fq * 8), boff = lds_byte(wc * 32 + fr, fq * 8);
#define PG8_SA(b, h) (((b) * 2 + (h)) * HTB)
#define PG8_SB(b, h) ((4 + (b) * 2 + (h)) * HTB)
#define PG8_STAGE(bufoff, gbase, voff) do { _Pragma("unroll") for (int _i = 0; _i < 2; ++_i) \
        __builtin_amdgcn_global_load_lds((const unsigned*)((const char*)(gbase) + (voff)[_i]), (PG8_LAS unsigned*)(lds + (bufoff) + ldsw + _i * 8192), 16, 0, 0); } while (0)
#define PG8_LDA(dst, b, h) do { _Pragma("unroll") for (int m = 0; m < 4; ++m) _Pragma("unroll") for (int k = 0; k < 2; ++k) dst[m][k] = *(const PG8_LAS bf16x8*)(lds + PG8_SA(b, h) + aoff + m * 2048 + k * 1024); } while (0)
#define PG8_LDB(dst, b, h) do { _Pragma("unroll") for (int n = 0; n < 2; ++n) _Pragma("unroll") for (int k = 0; k < 2; ++k) dst[n][k] = *(const PG8_LAS bf16x8*)(lds + PG8_SB(b, h) + boff + n * 2048 + k * 1024); } while (0)
#define PG8_MMA(ai, bj, At, Bt) do { __builtin_amdgcn_s_setprio(1); \
        if constexpr (!F8) { _Pragma("unroll") for (int m = 0; m < 4; ++m) _Pragma("unroll") for (int n = 0; n < 2; ++n) _Pragma("unroll") for (int k = 0; k < 2; ++k) \
            acc[ai][bj][m][n] = __builtin_amdgcn_mfma_f32_16x16x32_bf16(Bt[n][k], At[m][k], acc[ai][bj][m][n], 0, 0, 0); } \
        else { _Pragma("unroll") for (int m = 0; m < 4; ++m) _Pragma("unroll") for (int n = 0; n < 2; ++n) \
            asm volatile("v_mfma_scale_f32_16x16x128_f8f6f4 %0, %1, %2, %0, %3, %4 op_sel_hi:[0,0,0]" : "+v"(acc[ai][bj][m][n]) \
                : "v"(__builtin_shufflevector(__builtin_bit_cast(v4i32, Bt[n][0]), __builtin_bit_cast(v4i32, Bt[n][1]), 0, 1, 2, 3, 4, 5, 6, 7)), \
                  "v"(__builtin_shufflevector(__builtin_bit_cast(v4i32, At[m][0]), __builtin_bit_cast(v4i32, At[m][1]), 0, 1, 2, 3, 4, 5, 6, 7)), "v"(f8_sw), "v"(f8_s1)); } \
        __builtin_amdgcn_s_setprio(0); } while (0)
#define PG8_WAIT_V(n) asm volatile("s_waitcnt vmcnt(" #n ")" ::: "memory")
#define PG8_WAIT_L(n) asm volatile("s_waitcnt lgkmcnt(" #n ")" ::: "memory")
#define PG8_BAR __builtin_amdgcn_s_barrier()
#define PG8_SCHED __builtin_amdgcn_sched_barrier(0)
    Unit cur, nxt; int ui = 0;
    if (!S.next(0, cur)) return;
    f32x4 acc[2][2][4][2];
#pragma unroll
    for (int a = 0; a < 2; ++a)
#pragma unroll
        for (int b = 0; b < 2; ++b)
#pragma unroll
            for (int m = 0; m < 4; ++m)
#pragma unroll
                for (int n = 0; n < 2; ++n) acc[a][b][m][n] = (f32x4){0.f, 0.f, 0.f, 0.f};
    bf16x8 At[4][2], B0[2][2], B1[2][2];
    const char* cA = (const char*)g.A + (size_t)cur.pm * tstep; const char* cB = (const char*)g.Bt + (size_t)cur.pn * tstep;
    S.a_ready(cur);
    PG8_STAGE(PG8_SB(0, 0), cB, voffB); PG8_STAGE(PG8_SA(0, 0), cA, voffA); PG8_STAGE(PG8_SB(0, 1), cB + hstep, voffB); PG8_STAGE(PG8_SA(0, 1), cA + hstep, voffA);
    if (wr == 1) PG8_BAR;
    PG8_WAIT_V(4); PG8_BAR;
    PG8_STAGE(PG8_SB(1, 0), cB + kstep, voffB); PG8_STAGE(PG8_SA(1, 0), cA + kstep, voffA); PG8_STAGE(PG8_SB(1, 1), cB + hstep + kstep, voffB);
    PG8_WAIT_V(6); PG8_BAR;
    PG8_STAMP();
    for (;;) {
        const bool has_next = S.next(ui + 1, nxt);
        const char* nA = has_next ? (const char*)g.A + (size_t)nxt.pm * tstep : cA; const char* nB = has_next ? (const char*)g.Bt + (size_t)nxt.pn * tstep : cB;
        for (int t = 0; t < nt; t += 2) {
            const bool last = (t == nt - 2);
            const char* a1 = cA + (size_t)(t + 1) * kstep;
            const char* a2 = last ? nA : cA + (size_t)(t + 2) * kstep; const char* b2 = last ? nB : cB + (size_t)(t + 2) * kstep;
            const char* a3 = a2 + kstep; const char* b3 = b2 + kstep;
            if (last && has_next) S.a_ready(nxt);
            PG8_LDB(B0, 0, 0); PG8_SCHED; PG8_LDA(At, 0, 0); PG8_STAGE(PG8_SA(1, 1), a1 + hstep, voffA);
            PG8_WAIT_L(8); PG8_BAR; PG8_WAIT_L(0); PG8_MMA(0, 0, At, B0); PG8_BAR; PG8_SCHED;
            PG8_LDB(B1, 0, 1); PG8_STAGE(PG8_SB(0, 0), b2, voffB);
            PG8_BAR; PG8_WAIT_L(0); PG8_MMA(0, 1, At, B1); PG8_BAR;
            PG8_LDA(At, 0, 1); PG8_STAGE(PG8_SA(0, 0), a2, voffA);
            PG8_BAR; PG8_WAIT_L(0); PG8_MMA(1, 0, At, B0); PG8_BAR; PG8_SCHED;
            PG8_STAGE(PG8_SB(0, 1), b2 + hstep, voffB);
            PG8_WAIT_V(6); PG8_BAR; PG8_MMA(1, 1, At, B1); PG8_BAR;
            PG8_LDB(B0, 1, 0); PG8_SCHED; PG8_LDA(At, 1, 0); PG8_STAGE(PG8_SA(0, 1), a2 + hstep, voffA);
            PG8_WAIT_L(8); PG8_BAR; PG8_WAIT_L(0); PG8_MMA(0, 0, At, B0); PG8_BAR; PG8_SCHED;
            PG8_LDB(B1, 1, 1); PG8_STAGE(PG8_SB(1, 0), b3, voffB);
            PG8_BAR; PG8_WAIT_L(0); PG8_MMA(0, 1, At, B1); PG8_BAR;
            PG8_LDA(At, 1, 1); PG8_STAGE(PG8_SA(1, 0), a3, voffA);
            PG8_BAR; PG8_WAIT_L(0); PG8_MMA(1, 0, At, B0); PG8_BAR; PG8_SCHED;
            PG8_STAGE(PG8_SB(1, 1), b3 + hstep, voffB);
            PG8_WAIT_V(6); PG8_BAR; PG8_MMA(1, 1, At, B1); PG8_BAR;
        }
        PG8_STAMP();
        if constexpr (F8) asm volatile("s_nop 15\n\ts_nop 15" ::: "memory");
        if constexpr (!Epi::AFTER_DRAIN) { E(acc, cur, wr, wc, fr, fq); S.done(cur); }
        PG8_STAMP();
        if (!has_next) break;
#pragma unroll
        for (int a = 0; a < 2; ++a)
#pragma unroll
            for (int b = 0; b < 2; ++b)
#pragma unroll
                for (int m = 0; m < 4; ++m)
#pragma unroll
                    for (int n = 0; n < 2; ++n) acc[a][b][m][n] = (f32x4){0.f, 0.f, 0.f, 0.f};
        cur = nxt; cA = nA; cB = nB; ++ui;
    }
    PG8_WAIT_V(0);
    if (wr == 0) PG8_BAR;
    PG8_BAR;
    if constexpr (Epi::AFTER_DRAIN) { E.fused(acc, cur, wr, wc, fr, fq, lds, wid, lane); S.done(cur); }
    PG8_STAMP();
    if (STAMP && wid == 0) { stamps[lane] = lane < nts ? (((unsigned long long)(unsigned)ts_hi << 32) | (unsigned)ts_lo) : 0ull;
        if (lane == 62) stamps[62] = rt_entry; if (lane == 63) stamps[63] = (unsigned long long)wall_clock64(); }
#undef PG8_STAMP
#undef PG8_SA
#undef PG8_SB
#undef PG8_STAGE
#undef PG8_LDA
#undef PG8_LDB
#undef PG8_MMA
#undef PG8_WAIT_V
#undef PG8_WAIT_L
#undef PG8_BAR
#undef PG8_SCHED
}
}

#include <cstdio>
#include <ctime>

#define GASP __attribute__((address_space(1)))
struct Params { GASP const float* in[23]; GASP float* out; GASP unsigned char* ws; int ph_lo, ph_hi; };
typedef const __attribute__((address_space(4))) Params* KParams;
struct Ctx {
    unsigned char* lds; GASP unsigned char* ws; KParams kp;
    int tid, lane, wave, gw, ngw, rep;
    __device__ __forceinline__ const float* x() const { return (const float*)kp->in[0]; }
    __device__ __forceinline__ const float* cvec() const { return (const float*)kp->in[1]; }
    __device__ __forceinline__ const float* ctxin() const { return (const float*)kp->in[2]; }
    __device__ __forceinline__ const float* c_ctx() const { return (const float*)kp->in[3]; }
    __device__ __forceinline__ const float* w_ada() const { return (const float*)kp->in[4]; }
    __device__ __forceinline__ const float* b_ada() const { return (const float*)kp->in[5]; }
    __device__ __forceinline__ const float* norm_mix_w() const { return (const float*)kp->in[6]; }
    __device__ __forceinline__ const float* norm_ffn_w() const { return (const float*)kp->in[7]; }
    __device__ __forceinline__ const float* w_in() const { return (const float*)kp->in[8]; }
    __device__ __forceinline__ const float* w_out() const { return (const float*)kp->in[9]; }
    __device__ __forceinline__ const float* na_rpb() const { return (const float*)kp->in[10]; }
    __device__ __forceinline__ const float* gla_gate_w() const { return (const float*)kp->in[11]; }
    __device__ __forceinline__ const float* gla_gate_b() const { return (const float*)kp->in[12]; }
    __device__ __forceinline__ const float* gla_norm_w() const { return (const float*)kp->in[13]; }
    __device__ __forceinline__ const float* gdn_conv_w() const { return (const float*)kp->in[14]; }
    __device__ __forceinline__ const float* gdn_a_log() const { return (const float*)kp->in[15]; }
    __device__ __forceinline__ const float* gdn_dt_bias() const { return (const float*)kp->in[16]; }
    __device__ __forceinline__ const float* gdn_norm_w() const { return (const float*)kp->in[17]; }
    __device__ __forceinline__ const float* w_router() const { return (const float*)kp->in[18]; }
    __device__ __forceinline__ const float* w_exp_gate() const { return (const float*)kp->in[19]; }
    __device__ __forceinline__ const float* w_exp_up() const { return (const float*)kp->in[20]; }
    __device__ __forceinline__ const float* w_exp_down() const { return (const float*)kp->in[21]; }
    __device__ __forceinline__ const float* final_norm_w() const { return (const float*)kp->in[22]; }
    __device__ __forceinline__ float* out() const { return (float*)kp->out; }
    __device__ __forceinline__ float* MOD() const { return (float*)(ws + WS_MOD); }
    __device__ __forceinline__ float* ROPE() const { return (float*)(ws + WS_ROPE); }
    __device__ __forceinline__ float* HX() const { return (float*)(ws + WS_HX); }
    __device__ __forceinline__ float* PS() const { return (float*)(ws + WS_PS); }
    __device__ __forceinline__ float* GQKV() const { return (float*)(ws + WS_GQKV); }
    __device__ __forceinline__ float* GGB() const { return (float*)(ws + WS_GGB); }
    __device__ __forceinline__ float* LQ() const { return (float*)(ws + WS_LQ); }
    __device__ __forceinline__ float* LK() const { return (float*)(ws + WS_LK); }
    __device__ __forceinline__ float* LA() const { return (float*)(ws + WS_LA); }
    __device__ __forceinline__ float* OGLA() const { return (float*)(ws + WS_OGLA); }
    __device__ __forceinline__ float* OGDN() const { return (float*)(ws + WS_OGDN); }
    __device__ __forceinline__ float* AFF() const { return (float*)(ws + WS_AFF); }
    __device__ __forceinline__ float* GATEV() const { return (float*)(ws + WS_GATE); }
    __device__ __forceinline__ bf16* WIN() const { return (bf16*)(ws + WS_WIN); }
    __device__ __forceinline__ bf16* WOUT() const { return (bf16*)(ws + WS_WOUT); }
    __device__ __forceinline__ bf16* WGU() const { return (bf16*)(ws + WS_WGU); }
    __device__ __forceinline__ bf16* WDN() const { return (bf16*)(ws + WS_WDN); }
    __device__ __forceinline__ bf16* NX() const { return (bf16*)(ws + WS_NX); }
    __device__ __forceinline__ bf16* P() const { return (bf16*)(ws + WS_P); }
    __device__ __forceinline__ bf16* CAT() const { return (bf16*)(ws + WS_CAT); }
    __device__ __forceinline__ bf16* AMOE() const { return (bf16*)(ws + WS_AMOE); }
    __device__ __forceinline__ bf16* HID() const { return (bf16*)(ws + WS_HID); }
    __device__ __forceinline__ int* IDX() const { return (int*)(ws + WS_IDX); }
    __device__ __forceinline__ unsigned* ctl() const { return (unsigned*)(ws + WS_CTL); }
    __device__ __forceinline__ int* SLOTOF() const { return (int*)(ws + WS_SLOTOF); }
    __device__ __forceinline__ bf16* Y() const { return (bf16*)(ws + WS_Y); }
    __device__ __forceinline__ bf16* GLQT() const { return (bf16*)(ws + WS_GLQT); }
    __device__ __forceinline__ bf16* GLKT() const { return (bf16*)(ws + WS_GLKT); }
    __device__ __forceinline__ bf16* GLKH() const { return (bf16*)(ws + WS_GLKH); }
    __device__ __forceinline__ bf16* GLVT() const { return (bf16*)(ws + WS_GLVT); }
    __device__ __forceinline__ float* GLDEC() const { return (float*)(ws + WS_GLDEC); }
    __device__ __forceinline__ bf16* GDST() const { return (bf16*)(ws + WS_GDST); }
    __device__ __forceinline__ bf16* GLST() const { return (bf16*)(ws + WS_GLST); }
    __device__ __forceinline__ bf16* GDQP() const { return (bf16*)(ws + WS_GDQP); }
    __device__ __forceinline__ bf16* GDO0() const { return (bf16*)(ws + WS_GDO0); }
    __device__ __forceinline__ bf16* GDAP() const { return (bf16*)(ws + WS_GDAP); }
    __device__ __forceinline__ bf16* GDBM() const { return (bf16*)(ws + WS_GDBM); }
    __device__ __forceinline__ float* GDGL() const { return (float*)(ws + WS_GDGL); }
};
__device__ __forceinline__ int modrow(int row) { return row < ML ? (row >> 12) : 2; }
__device__ __forceinline__ const float* src_row_ptr(const Ctx& c, int l, int row) {
    if (l == 0) return row < ML ? c.x() + (size_t)row * D : c.ctxin() + (size_t)(row - ML) * D;
    return c.HX() + (size_t)row * D;
}

__device__ __forceinline__ void transpose_item(const float* W, int ldw, int k0, int sn0, int nvalid, bf16* dst, int K, float* scr, int lane) {
    { const int c4 = lane & 7, rr = lane >> 3; const float* wp = W + (size_t)(k0 + rr) * ldw + sn0 + 4 * c4; const bool ok = 4 * c4 < nvalid;
        f4 v[8];
#pragma unroll
        for (int i = 0; i < 8; ++i) v[i] = ok ? *(const f4*)(wp + (size_t)(8 * i) * ldw) : (f4){0.f, 0.f, 0.f, 0.f};
#pragma unroll
        for (int i = 0; i < 8; ++i) { float* sp = scr + (rr + 8 * i) * 33 + 4 * c4; sp[0] = v[i].x; sp[1] = v[i].y; sp[2] = v[i].z; sp[3] = v[i].w; } }
    LDS_WAIT();
    const int cc = lane & 7;
#pragma unroll
    for (int j = 0; j < 4; ++j) { const int n = (lane >> 3) + 8 * j; const float* s = scr + (8 * cc) * 33 + n;
        u4 o; o.x = pk2(s[0 * 33], s[1 * 33]); o.y = pk2(s[2 * 33], s[3 * 33]); o.z = pk2(s[4 * 33], s[5 * 33]); o.w = pk2(s[6 * 33], s[7 * 33]);
        *(u4*)(dst + (size_t)n * K + 8 * cc) = o; }
    LDS_WAIT();
}
__device__ __forceinline__ float sat_fp8(float x) { return __builtin_amdgcn_fmed3f(x, -448.0f, 448.0f); }
__device__ __forceinline__ unsigned pk4_fp8(float a, float b, float cc, float d) { unsigned w = 0u; w = __builtin_amdgcn_cvt_pk_fp8_f32(sat_fp8(a), sat_fp8(b), w, false); w = __builtin_amdgcn_cvt_pk_fp8_f32(sat_fp8(cc), sat_fp8(d), w, true); return w; }
__device__ __forceinline__ void transpose_item8(const float* W, int ldw, int k0, int sn0, unsigned char* dst, int K8, float* scr, int lane) {
    { const int c4 = lane & 7, rr = lane >> 3; const float* wp = W + (size_t)(k0 + rr) * ldw + sn0 + 4 * c4;
        f4 v[8];
#pragma unroll
        for (int i = 0; i < 8; ++i) v[i] = *(const f4*)(wp + (size_t)(8 * i) * ldw);
#pragma unroll
        for (int i = 0; i < 8; ++i) { float* sp = scr + (rr + 8 * i) * 33 + 4 * c4; sp[0] = v[i].x; sp[1] = v[i].y; sp[2] = v[i].z; sp[3] = v[i].w; } }
    LDS_WAIT();
    const int cc = lane & 7; constexpr float SC = (float)(1 << pg8::F8_WSCALE_LOG2);
#pragma unroll
    for (int j = 0; j < 4; ++j) { const int n = (lane >> 3) + 8 * j; const float* s = scr + (8 * cc) * 33 + n;
        u2 o; o.x = pk4_fp8(s[0 * 33] * SC, s[1 * 33] * SC, s[2 * 33] * SC, s[3 * 33] * SC); o.y = pk4_fp8(s[4 * 33] * SC, s[5 * 33] * SC, s[6 * 33] * SC, s[7 * 33] * SC);
        *(u2*)(dst + (size_t)n * K8 + 8 * cc) = o; }
    LDS_WAIT();
}
__device__ __forceinline__ void ph_prologue(const Ctx& c) {
    float* S3 = (float*)c.lds;
    float* scr = (float*)(c.lds + 32768 + c.wave * 8704);
    for (int i = c.tid; i < 3 * D; i += NTHREADS) { const int r = i / D, k = i % D; const float v = r < 2 ? c.cvec()[r * D + k] : c.c_ctx()[k]; S3[i] = silu_f(v); }
    __syncthreads();
    constexpr int N_MOD = 2 * (MODW / 32);
    constexpr int N_ROPE = 16;
    constexpr int N_WIN = 2 * 32 * 210, N_WOUT = 2 * 32 * 64, N_EXP = 96 * 2048;
    constexpr int NITEMS = N_MOD + N_ROPE + N_WIN + N_WOUT + N_EXP;
    const int lane = c.lane;
    constexpr int NGRABS = N_MOD + (NITEMS - N_MOD + 7) / 8;
    for (;;) {
      int g = 0; if (lane == 0) g = (int)atomicAdd(c.ctl() + CW_PROQ, 1u);
      g = __builtin_amdgcn_readfirstlane(g);
      if (g >= NGRABS) break;
      const int it0 = g < N_MOD ? g : N_MOD + (g - N_MOD) * 8, it1 = g < N_MOD ? g + 1 : (it0 + 8 < NITEMS ? it0 + 8 : NITEMS);
      for (int it = it0; it < it1; ++it) {
        int r = it;
        if (r < N_MOD) {
            const int l = r / (MODW / 32), cb = r % (MODW / 32), kg = lane >> 3, cl = lane & 7, col = cb * 32 + 4 * cl;
            const float* wp = c.w_ada() + (size_t)l * D * MODW + col;
            f4 a0 = {0.f, 0.f, 0.f, 0.f}, a1 = a0, a2 = a0;
#pragma unroll 8
            for (int i = 0; i < 256; ++i) { const int k = kg + 8 * i; const f4 w = *(const f4*)(wp + (size_t)k * MODW); a0 += S3[k] * w; a1 += S3[D + k] * w; a2 += S3[2 * D + k] * w; }
#pragma unroll
            for (int q = 0; q < 4; ++q) {
#pragma unroll
                for (int o = 8; o < 64; o <<= 1) { a0[q] += __shfl_xor(a0[q], o); a1[q] += __shfl_xor(a1[q], o); a2[q] += __shfl_xor(a2[q], o); } }
            if (kg == 0) { const f4 bb = *(const f4*)(c.b_ada() + (size_t)l * MODW + col);
                *(f4*)(c.MOD() + (size_t)(l * 3 + 0) * MODW + col) = a0 + bb; *(f4*)(c.MOD() + (size_t)(l * 3 + 1) * MODW + col) = a1 + bb; *(f4*)(c.MOD() + (size_t)(l * 3 + 2) * MODW + col) = a2 + bb; }
            continue; }
        r -= N_MOD;
        if (r < N_ROPE) { const int en = r * 64 + lane, pos = en >> 4, i = en & 15; const float f = powf(10000.f, -(float)i / 16.f), ang = (float)pos * f;
            c.ROPE()[en * 2] = cosf(ang); c.ROPE()[en * 2 + 1] = sinf(ang); continue; }
        r -= N_ROPE;
        if (r < N_WIN) { const int l = r / (32 * 210), q = r % (32 * 210), kb = q / 210, nb = q % 210, n0 = nb * 32;
            int sn0, nv = 32;
            if (n0 < 4608) sn0 = n0; else if (n0 < 6656) sn0 = n0 + 32; else if (n0 < 6688) sn0 = 4608 + (n0 - 6656); else { sn0 = 6688; nv = 16; }
            transpose_item(c.w_in() + (size_t)l * D * INW, INW, kb * 64, sn0, nv, c.WIN() + ((size_t)l * NP + n0) * D + kb * 64, D, scr, lane); continue; }
        r -= N_WIN;
        if (r < N_WOUT) { const int l = r / 2048, q = r % 2048, kb = q / 64, nb = q % 64;
            transpose_item(c.w_out() + (size_t)l * D * D, D, kb * 64, nb * 32, 32, c.WOUT() + ((size_t)l * D + nb * 32) * D + kb * 64, D, scr, lane); continue; }
        r -= N_WOUT;
        { const int mtx = r / 2048, q = r % 2048, gq = q >> 3, jq = q & 7, kb = 2 * (gq >> 4) + (jq & 1), nb = 4 * (gq & 15) + (jq >> 1);
            const int ty = mtx / 32, le = mtx % 32;
            const bool f8 = ((F8MASK) >> (le >> 4)) & 1;
            if (ty < 2) { const float* W = (ty == 0 ? c.w_exp_gate() : c.w_exp_up()) + (size_t)le * D * FF;
                const int drow = (nb >> 2) * 256 + ty * 128 + (nb & 3) * 32;
                if (!f8) transpose_item(W, FF, kb * 64, nb * 32, 32, c.WGU() + ((size_t)le * 4096 + drow) * D + kb * 64, D, scr, lane);
                else transpose_item8(W, FF, kb * 64, nb * 32, (unsigned char*)(c.WGU() + (size_t)(le >> 4) * NE * 4096 * D) + ((size_t)(le & 15) * 4096 + drow) * D + kb * 64, D, scr, lane); }
            else { const float* W = c.w_exp_down() + (size_t)le * FF * D;
                if (!f8) transpose_item(W, D, kb * 64, nb * 32, 32, c.WDN() + ((size_t)le * D + nb * 32) * FF + kb * 64, FF, scr, lane);
                else transpose_item8(W, D, kb * 64, nb * 32, (unsigned char*)(c.WDN() + (size_t)(le >> 4) * NE * D * FF) + ((size_t)(le & 15) * D + nb * 32) * FF + kb * 64, FF, scr, lane); } }
    }
    }
}


__device__ __forceinline__ void moe_combine_row(const Ctx& c, int lm, int row, int lane, f4 (&v)[8]) {
    f4 acc[8];
#pragma unroll
    for (int j = 0; j < 8; ++j) acc[j] = (f4){0.f, 0.f, 0.f, 0.f};
    const int* so = c.SLOTOF() + row;
    const int sl = lane < NE ? so[(size_t)lane * MROWS] : -1;
#pragma unroll
    for (int e = 0; e < NE; ++e) { const int s = __builtin_amdgcn_readlane(sl, e);
        if (s >= 0) { const float gate = c.GATEV()[e * ESLOT + s]; const bf16* yr = c.Y() + ((size_t)e * ESLOT + s) * D + 4 * lane;
#pragma unroll
            for (int j = 0; j < 8; ++j) { const u2 raw = *(const u2*)(yr + 256 * j);
                acc[j].x += gate * bf2f(raw.x & 0xffffu); acc[j].y += gate * bf2f(raw.x >> 16); acc[j].z += gate * bf2f(raw.y & 0xffffu); acc[j].w += gate * bf2f(raw.y >> 16); } } }
    const float* g2 = c.MOD() + (size_t)(lm * 3 + modrow(row)) * MODW + 5 * D + 4 * lane;
#pragma unroll
    for (int j = 0; j < 8; ++j) v[j] += *(const f4*)(g2 + 256 * j) * acc[j];
}

__device__ __forceinline__ void ph_norm1(const Ctx& c, int l) {
    const int lane = c.lane;
    for (int row = c.gw; row < MROWS; row += c.ngw) {
        const float* xr = src_row_ptr(c, l, row);
        f4 v[8]; float ss = 0.f;
#pragma unroll
        for (int j = 0; j < 8; ++j) v[j] = *(const f4*)(xr + 4 * lane + 256 * j);
        if (l > 0) { moe_combine_row(c, l - 1, row, lane, v); float* hw = c.HX() + (size_t)row * D;
#pragma unroll
            for (int j = 0; j < 8; ++j) *(f4*)(hw + 4 * lane + 256 * j) = v[j]; }
#pragma unroll
        for (int j = 0; j < 8; ++j) ss += v[j].x * v[j].x + v[j].y * v[j].y + v[j].z * v[j].z + v[j].w * v[j].w;
        ss = wave_sum(ss);
        const float rstd = 1.0f / sqrtf(ss * (1.0f / D) + 1e-6f);
        const float* nw = c.norm_mix_w() + (size_t)l * D; const float* md = c.MOD() + (size_t)(l * 3 + modrow(row)) * MODW;
        bf16* orow = c.NX() + (size_t)row * D;
#pragma unroll
        for (int j = 0; j < 8; ++j) { const int col = 4 * lane + 256 * j; const f4 w = *(const f4*)(nw + col), sh = *(const f4*)(md + col), sc = *(const f4*)(md + D + col);
            const f4 y = v[j] * rstd * w * (1.0f + sc) + sh; u2 o; o.x = pk2(y.x, y.y); o.y = pk2(y.z, y.w); *(u2*)(orow + col) = o; }
    }
}

using pg8::f32x4; using pg8::u32x4; using pg8::Unit;
struct EpiP {
    static constexpr bool PERM = true, AFTER_DRAIN = false;
    bf16* P; float* PS;
    __device__ __forceinline__ void operator()(const f32x4 (&acc)[2][2][4][2], const Unit& u, int wr, int wc, int fr, int fq) const {
        const int row0 = u.pm * 256 + wr * 64 + fr, col0 = u.pn * 256 + wc * 32 + 8 * fq;
#pragma unroll
        for (int ai = 0; ai < 2; ++ai)
#pragma unroll
            for (int m = 0; m < 4; ++m) { const int row = row0 + ai * 128 + m * 16; bf16* rowp = P + (size_t)row * NP + col0;
#pragma unroll
                for (int bj = 0; bj < 2; ++bj) { const f32x4 v0 = acc[ai][bj][m][0], v1 = acc[ai][bj][m][1];
                    u32x4 w; w.x = pg8::cvt_pk_bf16(v0[0], v0[1]); w.y = pg8::cvt_pk_bf16(v0[2], v0[3]); w.z = pg8::cvt_pk_bf16(v1[0], v1[1]); w.w = pg8::cvt_pk_bf16(v1[2], v1[3]);
                    *(u32x4*)(rowp + bj * 128) = w; }
                if (u.pn == 26 && wc < 2) { float* ps = PS + (size_t)row * 64 + wc * 32 + 8 * fq; *(f32x4*)ps = acc[ai][0][m][0]; *(f32x4*)(ps + 4) = acc[ai][0][m][1]; } }
    }
};
struct EpiResid {
    static constexpr bool PERM = false, AFTER_DRAIN = false;
    const float *x, *ctxin, *MOD; float* HX; int l;
    __device__ __forceinline__ void operator()(const f32x4 (&acc)[2][2][4][2], const Unit& u, int wr, int wc, int fr, int fq) const {
#pragma unroll
        for (int ai = 0; ai < 2; ++ai)
#pragma unroll
            for (int m = 0; m < 4; ++m) { const int row = u.pm * 256 + ai * 128 + wr * 64 + m * 16 + fr; float* dst = HX + (size_t)row * D;
                const float* src = (l == 0) ? (row < ML ? x + (size_t)row * D : ctxin + (size_t)(row - ML) * D) : dst;
                const float* g1 = MOD + (size_t)(l * 3 + modrow(row)) * MODW + 2 * D;
#pragma unroll
                for (int bj = 0; bj < 2; ++bj)
#pragma unroll
                    for (int n = 0; n < 2; ++n) { const int col = u.pn * 256 + bj * 128 + wc * 32 + n * 16 + 4 * fq;
                        *(f32x4*)(dst + col) = *(const f32x4*)(src + col) + *(const f32x4*)(g1 + col) * acc[ai][bj][m][n]; } }
    }
};
struct EpiSwiglu {
    static constexpr bool PERM = true, AFTER_DRAIN = false;
    bf16* HID;
    __device__ __forceinline__ void operator()(const f32x4 (&acc)[2][2][4][2], const Unit& u, int wr, int wc, int fr, int fq) const {
        const int row0 = u.pm * 256 + wr * 64 + fr, col0 = (u.pn & 15) * 128 + wc * 32 + 8 * fq;
#pragma unroll
        for (int ai = 0; ai < 2; ++ai)
#pragma unroll
            for (int m = 0; m < 4; ++m) { bf16* rowp = HID + (size_t)(row0 + ai * 128 + m * 16) * FF + col0;
                float h[8];
#pragma unroll
                for (int n = 0; n < 2; ++n)
#pragma unroll
                    for (int i = 0; i < 4; ++i) { const float g = acc[ai][0][m][n][i], up = acc[ai][1][m][n][i]; h[n * 4 + i] = silu_f(g) * up; }
                u32x4 w; w.x = pg8::cvt_pk_bf16(h[0], h[1]); w.y = pg8::cvt_pk_bf16(h[2], h[3]); w.z = pg8::cvt_pk_bf16(h[4], h[5]); w.w = pg8::cvt_pk_bf16(h[6], h[7]);
                *(u32x4*)rowp = w; }
    }
};
struct EpiSwiglu8 {
    static constexpr bool PERM = true, AFTER_DRAIN = false;
    unsigned char* HID8;
    __device__ __forceinline__ void operator()(const f32x4 (&acc)[2][2][4][2], const Unit& u, int wr, int wc, int fr, int fq) const {
        const int row0 = u.pm * 256 + wr * 64 + fr, col0 = (u.pn & 15) * 128 + wc * 32 + 8 * fq;
#pragma unroll
        for (int ai = 0; ai < 2; ++ai)
#pragma unroll
            for (int m = 0; m < 4; ++m) { unsigned char* rowp = HID8 + (size_t)(row0 + ai * 128 + m * 16) * FF + col0;
                float h[8];
#pragma unroll
                for (int n = 0; n < 2; ++n)
#pragma unroll
                    for (int i = 0; i < 4; ++i) { const float g = acc[ai][0][m][n][i], up = acc[ai][1][m][n][i]; h[n * 4 + i] = silu_f(g) * up; }
                u2 w; w.x = pk4_fp8(h[0], h[1], h[2], h[3]); w.y = pk4_fp8(h[4], h[5], h[6], h[7]);
                *(u2*)rowp = w; }
    }
};
struct EpiY {
    static constexpr bool PERM = true, AFTER_DRAIN = false;
    bf16* Yp;
    __device__ __forceinline__ void operator()(const f32x4 (&acc)[2][2][4][2], const Unit& u, int wr, int wc, int fr, int fq) const {
        const int row0 = u.pm * 256 + wr * 64 + fr, col0 = (u.pn & 7) * 256 + wc * 32 + 8 * fq;
#pragma unroll
        for (int ai = 0; ai < 2; ++ai)
#pragma unroll
            for (int m = 0; m < 4; ++m) { bf16* rowp = Yp + (size_t)(row0 + ai * 128 + m * 16) * D + col0;
#pragma unroll
                for (int bj = 0; bj < 2; ++bj) { const f32x4 v0 = acc[ai][bj][m][0], v1 = acc[ai][bj][m][1];
                    u32x4 w; w.x = pg8::cvt_pk_bf16(v0[0], v0[1]); w.y = pg8::cvt_pk_bf16(v0[2], v0[3]); w.z = pg8::cvt_pk_bf16(v1[0], v1[1]); w.w = pg8::cvt_pk_bf16(v1[2], v1[3]);
                    *(u32x4*)(rowp + bj * 128) = w; } }
    }
};
struct MoeOrder {
    int MT, NT, G, c;
    __device__ __forceinline__ bool next(int i, Unit& u) const { const int per = MT * NT; int e, r;
        if ((G & 7) == 0) { const int Lx = i * (G >> 3) + (c >> 3); if (Lx >= 2 * per) return false; e = 2 * (c & 7) + Lx / per; r = Lx % per; }
        else { const int L = i * G + c; if (L >= NE * per) return false; e = L / per; r = L % per; }
        u.pm = e * 5 + (r % MT); u.pn = e * NT + (r / MT); return true; }
    __device__ __forceinline__ void a_ready(const Unit&) const {}
    __device__ __forceinline__ void done(const Unit&) const {}
};
struct RowOrder {
    int nM, nN, G, c;
    __device__ __forceinline__ bool next(int i, Unit& u) const { const int L = i * G + c; if (L >= nM * nN) return false; u.pm = L % nM; u.pn = L / nM; return true; }
    __device__ __forceinline__ void a_ready(const Unit&) const {}
    __device__ __forceinline__ void done(const Unit&) const {}
};

__device__ __forceinline__ void ph_prep(const Ctx& c, int l) {
    const int lane = c.lane;
    const float* cw = c.gdn_conv_w() + (size_t)l * 5 * 1536;
    {
        for (int row = (blockIdx.x * 8 + c.wave) * 2; row < MROWS; row += gridDim.x * 16) {
            int t, T; if (row < ML) { t = row & (SEQ - 1); T = SEQ; } else { t = (row - ML) & (CTX - 1); T = CTX; }
#pragma unroll
            for (int j = 0; j < 3; ++j) {
                const int cb = j * 512 + lane * 8;
                u4 raw[6];
#pragma unroll
                for (int q = 0; q < 6; ++q) { const int tt = t + q - 2; raw[q] = (tt >= 0 && tt < T) ? *(const u4*)(c.P() + (size_t)(row + q - 2) * NP + PC_GDQ + cb) : (u4){0u, 0u, 0u, 0u}; }
                float a0[8], a1[8];
#pragma unroll
                for (int i = 0; i < 8; ++i) { a0[i] = 0.f; a1[i] = 0.f; }
#pragma unroll
                for (int tap = 0; tap < 5; ++tap) { const f4 w0 = *(const f4*)(cw + tap * 1536 + cb), w1 = *(const f4*)(cw + tap * 1536 + cb + 4);
                    const float wv[8] = {w0.x, w0.y, w0.z, w0.w, w1.x, w1.y, w1.z, w1.w};
                    const u4 r0 = raw[tap], r1 = raw[tap + 1];
                    const float x0[8] = {bf2f(r0.x & 0xffffu), bf2f(r0.x >> 16), bf2f(r0.y & 0xffffu), bf2f(r0.y >> 16), bf2f(r0.z & 0xffffu), bf2f(r0.z >> 16), bf2f(r0.w & 0xffffu), bf2f(r0.w >> 16)};
                    const float x1[8] = {bf2f(r1.x & 0xffffu), bf2f(r1.x >> 16), bf2f(r1.y & 0xffffu), bf2f(r1.y >> 16), bf2f(r1.z & 0xffffu), bf2f(r1.z >> 16), bf2f(r1.w & 0xffffu), bf2f(r1.w >> 16)};
#pragma unroll
                    for (int i = 0; i < 8; ++i) { a0[i] += wv[i] * x0[i]; a1[i] += wv[i] * x1[i]; } }
#pragma unroll
                for (int rr = 0; rr < 2; ++rr) { float* a = rr ? a1 : a0; float ss = 0.f;
#pragma unroll
                    for (int i = 0; i < 8; ++i) { a[i] = silu_f(a[i]); ss += a[i] * a[i]; }
                    if (j < 2) { ss += __shfl_xor(ss, 1); ss += __shfl_xor(ss, 2); ss += __shfl_xor(ss, 4); ss += __shfl_xor(ss, 8);
                        const float sc = (1.0f / sqrtf(ss + 1e-6f)) * (j == 0 ? 0.08838834764831845f : 1.0f);
#pragma unroll
                        for (int i = 0; i < 8; ++i) a[i] *= sc; }
                    float* o = c.GQKV() + (size_t)(row + rr) * 1536 + cb;
                    *(f4*)o = (f4){a[0], a[1], a[2], a[3]}; *(f4*)(o + 4) = (f4){a[4], a[5], a[6], a[7]}; }
            }
            if (lane < 16) { const int rr = lane >> 3, li = lane & 7; const float* ps = c.PS() + (size_t)(row + rr) * 64; const float av = ps[32 + li], bv = ps[40 + li];
                const float g = -expf(c.gdn_a_log()[l * 8 + li]) * softplus_f(av + c.gdn_dt_bias()[l * 8 + li]);
                c.GGB()[(size_t)(row + rr) * 16 + li] = g; c.GGB()[(size_t)(row + rr) * 16 + 8 + li] = 1.0f / (1.0f + expf(-bv)); }
        }
    }
}

__device__ __forceinline__ int scan_row(int s, int b, int dir) { if (s < CTX) return ML + b * CTX + (dir ? CTX - 1 - s : s); const int u = s - CTX; return b * SEQ + (dir ? SEQ - 1 - u : u); }
__device__ __forceinline__ void gla_scan_task(const Ctx& c, int b, int h, int dir) {
    float* sq = (float*)c.lds; float* sk = sq + 2048; float* sa = sk + 2048; float* sv = sa + 2048;
    const int e = c.wave * 16 + (c.lane & 15), dg = c.lane >> 4, d0 = dg * 16;
    float S[16];
#pragma unroll
    for (int i = 0; i < 16; ++i) S[i] = 0.f;
    for (int cs = 0; cs < (CTX + SEQ) / 32; ++cs) {
        __syncthreads();
        for (int idx = c.tid; idx < 2048; idx += NTHREADS) { const int tk = idx >> 6, d = idx & 63, row = scan_row(cs * 32 + tk, b, dir);
            sq[idx] = c.LQ()[(size_t)row * 256 + h * 64 + d]; sk[idx] = c.LK()[(size_t)row * 256 + h * 64 + d]; sa[idx] = expf(c.LA()[((size_t)dir * MROWS + row) * 256 + h * 64 + d]); }
        for (int idx = c.tid; idx < 4096; idx += NTHREADS) { const int tk = idx >> 7, e2 = idx & 127, row = scan_row(cs * 32 + tk, b, dir);
            sv[idx] = bf2f(c.P()[(size_t)row * NP + PC_GLV + h * 128 + e2]); }
        __syncthreads();
        for (int tk = 0; tk < 32; ++tk) {
            const float ve = sv[tk * 128 + e]; float o = 0.f;
#pragma unroll
            for (int i = 0; i < 16; ++i) { const int d = tk * 64 + d0 + i; S[i] = sa[d] * S[i] + sk[d] * ve; o += sq[d] * S[i]; }
            o += __shfl_xor(o, 16); o += __shfl_xor(o, 32);
            if (dg == 0) c.OGLA()[((size_t)dir * MROWS + scan_row(cs * 32 + tk, b, dir)) * 512 + h * 128 + e] = o;
        }
    }
}
__device__ __forceinline__ void gdn_scan_task(const Ctx& c, int b, int h, int dir) {
    float* sq = (float*)c.lds; float* sk = sq + 4096; float* sv = sk + 4096; float* sg = sv + 4096; float* sb = sg + 32;
    const int e = c.wave * 16 + (c.lane & 15), dg = c.lane >> 4, d0 = dg * 32;
    float S[32];
#pragma unroll
    for (int i = 0; i < 32; ++i) S[i] = 0.f;
    for (int cs = 0; cs < (CTX + SEQ) / 32; ++cs) {
        __syncthreads();
        for (int idx = c.tid; idx < 4096; idx += NTHREADS) { const int tk = idx >> 7, d = idx & 127, row = scan_row(cs * 32 + tk, b, dir); const float* g = c.GQKV() + (size_t)row * 1536 + h * 128 + d;
            sq[idx] = g[0]; sk[idx] = g[512]; sv[idx] = g[1024]; }
        if (c.tid < 32) { const int row = scan_row(cs * 32 + c.tid, b, dir); sg[c.tid] = expf(c.GGB()[(size_t)row * 16 + dir * 4 + h]); sb[c.tid] = c.GGB()[(size_t)row * 16 + 8 + dir * 4 + h]; }
        __syncthreads();
        for (int tk = 0; tk < 32; ++tk) {
            float ks = 0.f;
#pragma unroll
            for (int i = 0; i < 32; ++i) ks += sk[tk * 128 + d0 + i] * S[i];
            ks += __shfl_xor(ks, 16); ks += __shfl_xor(ks, 32);
            const float eg = sg[tk], delta = sb[tk] * (sv[tk * 128 + e] - eg * ks);
            float o = 0.f;
#pragma unroll
            for (int i = 0; i < 32; ++i) { const int d = tk * 128 + d0 + i; S[i] = eg * S[i] + sk[d] * delta; o += sq[d] * S[i]; }
            o += __shfl_xor(o, 16); o += __shfl_xor(o, 32);
            if (dg == 0) c.OGDN()[((size_t)dir * MROWS + scan_row(cs * 32 + tk, b, dir)) * 512 + h * 128 + e] = o;
        }
    }
}
__device__ __forceinline__ void na_task(const Ctx& c, int l, int task, int lane) {
    const bool lat = task < ML * 16;
    const int tq = lat ? task : task - ML * 16;
    const int h = tq & 15, row = (tq >> 4) + (lat ? 0 : ML);
    const int b = lat ? (row >> 12) : ((row - ML) >> 8);
    const bf16* P = c.P();
    const float qv = bf2f(P[(size_t)row * NP + PC_NAQ + h * 64 + lane]) * 0.125f;
    int krow[6]; float sc[6];
#pragma unroll
    for (int i = 0; i < 4; ++i) { krow[2 + i] = ML + b * CTX + lane + 64 * i; sc[2 + i] = 0.f; }
    if (lat) { const int t = row & (SEQ - 1), r = t >> 6, cq = t & 63; const int rs = min(max(r - 4, 0), 56), cs = min(max(cq - 8, 0), 48);
#pragma unroll
        for (int i = 0; i < 2; ++i) { const int lk = lane + 64 * i, j = lk >> 4, cc = lk & 15; krow[i] = b * SEQ + (rs + j) * 64 + cs + cc;
            sc[i] = c.na_rpb()[((size_t)(l * 16 + h) * 15 + (rs + j - r + 7)) * 31 + (cs + cc - cq + 15)]; } }
    else { krow[0] = krow[2]; krow[1] = krow[2]; sc[0] = -INFINITY; sc[1] = -INFINITY; }
#pragma unroll
    for (int i = 0; i < 6; ++i) {
        if (i >= 2 || lat) { const bf16* kp = P + (size_t)krow[i] * NP + PC_NAK + h * 64; float s = 0.f;
#pragma unroll
            for (int m = 0; m < 8; ++m) { const u4 w = *(const u4*)(kp + 8 * m);
                s += __int_as_float(__builtin_amdgcn_readlane(__float_as_int(qv), 8 * m + 0)) * bf2f(w.x & 0xffffu); s += __int_as_float(__builtin_amdgcn_readlane(__float_as_int(qv), 8 * m + 1)) * bf2f(w.x >> 16);
                s += __int_as_float(__builtin_amdgcn_readlane(__float_as_int(qv), 8 * m + 2)) * bf2f(w.y & 0xffffu); s += __int_as_float(__builtin_amdgcn_readlane(__float_as_int(qv), 8 * m + 3)) * bf2f(w.y >> 16);
                s += __int_as_float(__builtin_amdgcn_readlane(__float_as_int(qv), 8 * m + 4)) * bf2f(w.z & 0xffffu); s += __int_as_float(__builtin_amdgcn_readlane(__float_as_int(qv), 8 * m + 5)) * bf2f(w.z >> 16);
                s += __int_as_float(__builtin_amdgcn_readlane(__float_as_int(qv), 8 * m + 6)) * bf2f(w.w & 0xffffu); s += __int_as_float(__builtin_amdgcn_readlane(__float_as_int(qv), 8 * m + 7)) * bf2f(w.w >> 16); }
            sc[i] += s; } }
    float mx = sc[0];
#pragma unroll
    for (int i = 1; i < 6; ++i) mx = fmaxf(mx, sc[i]);
    mx = wave_max(mx);
    float sum = 0.f;
#pragma unroll
    for (int i = 0; i < 6; ++i) { sc[i] = expf(sc[i] - mx); sum += sc[i]; }
    sum = wave_sum(sum);
    const float inv = 1.0f / sum;
    float o = 0.f;
    const bf16* vp = P + PC_NAV + h * 64 + lane;
#pragma unroll
    for (int i = 0; i < 6; ++i) {
        if (i >= 2 || lat) {
#pragma unroll 8
            for (int sl = 0; sl < 64; ++sl) { const float p = __int_as_float(__builtin_amdgcn_readlane(__float_as_int(sc[i]), sl)); const int kr = __builtin_amdgcn_readlane(krow[i], sl);
                o += p * bf2f(vp[(size_t)kr * NP]); } } }
    c.CAT()[(size_t)row * D + h * 64 + lane] = (bf16)f2bf(o * inv);
}
__device__ __forceinline__ void ph_scan_na(const Ctx& c, int l) {
    for (int bt = blockIdx.x; bt < 32; bt += gridDim.x) { const int kind = bt >> 4, dir = (bt >> 3) & 1, b = (bt >> 2) & 1, h = bt & 3;
        if (kind == 0) gla_scan_task(c, b, h, dir); else gdn_scan_task(c, b, h, dir); }
    __syncthreads();
    const int ntask = ML * 16 + (l == 0 ? MC * 16 : 0), nchunk = ntask / 512;
    int* sh = (int*)(c.lds + MISC_OFF + 64);
    for (;;) {
        __syncthreads();
        if (c.tid == 0) *sh = (int)atomicAdd(c.ctl() + CW_NAQ + 64 * (l + 2 * c.rep), 1u);
        __syncthreads();
        const int ch = *sh;
        if (ch >= nchunk) break;
        for (int i = 0; i < 64; ++i) na_task(c, l, ch * 512 + c.wave * 64 + i, c.lane);
    }
}

__device__ __forceinline__ void ph_combine(const Ctx& c, int l) {
    const int lane = c.lane; const int nrows = l == 0 ? MROWS : ML;
    for (int row = c.gw; row < nrows; row += c.ngw) {
#pragma unroll
        for (int which = 0; which < 1; ++which) {
            const float* O = which == 0 ? c.OGLA() : c.OGDN(); const float* nwp = (which == 0 ? c.gla_norm_w() : c.gdn_norm_w()) + l * 128 + (lane & 15) * 8;
            const int gcol = (which == 0 ? PC_GLG : PC_GDZ) + lane * 8;
            const f4 a0 = *(const f4*)(O + (size_t)row * 512 + lane * 8), a1 = *(const f4*)(O + (size_t)row * 512 + lane * 8 + 4);
            const f4 b0 = *(const f4*)(O + ((size_t)MROWS + row) * 512 + lane * 8), b1 = *(const f4*)(O + ((size_t)MROWS + row) * 512 + lane * 8 + 4);
            float o[8] = {a0.x + b0.x, a0.y + b0.y, a0.z + b0.z, a0.w + b0.w, a1.x + b1.x, a1.y + b1.y, a1.z + b1.z, a1.w + b1.w};
            float ss = 0.f;
#pragma unroll
            for (int i = 0; i < 8; ++i) ss += o[i] * o[i];
            ss += __shfl_xor(ss, 1); ss += __shfl_xor(ss, 2); ss += __shfl_xor(ss, 4); ss += __shfl_xor(ss, 8);
            const float rstd = 1.0f / sqrtf(ss * (1.0f / 128.f) + 1e-6f);
            const u4 graw = *(const u4*)(c.P() + (size_t)row * NP + gcol);
            const float g[8] = {bf2f(graw.x & 0xffffu), bf2f(graw.x >> 16), bf2f(graw.y & 0xffffu), bf2f(graw.y >> 16), bf2f(graw.z & 0xffffu), bf2f(graw.z >> 16), bf2f(graw.w & 0xffffu), bf2f(graw.w >> 16)};
            float y[8];
#pragma unroll
            for (int i = 0; i < 8; ++i) y[i] = o[i] * rstd * nwp[i] * silu_f(g[i]);
            u4 w; w.x = pk2(y[0], y[1]); w.y = pk2(y[2], y[3]); w.z = pk2(y[4], y[5]); w.w = pk2(y[6], y[7]);
            *(u4*)(c.CAT() + (size_t)row * D + 1024 + which * 512 + lane * 8) = w;
        }
    }
}

__device__ __forceinline__ void ph_norm2_router(const Ctx& c, int l) {
    float* WR = (float*)c.lds;
    const float* wr = c.w_router() + (size_t)l * D * NE;
    __syncthreads();
    for (int idx = c.tid; idx < D * NE; idx += NTHREADS) WR[(idx & 15) * D + (idx >> 4)] = wr[idx];
    __syncthreads();
    const int lane = c.lane; const int nrows = l == 0 ? MROWS : ML;
    const int eid = ((lane >> 5) & 1) * 8 + ((lane >> 4) & 1) * 4 + ((lane >> 3) & 1) * 2 + ((lane >> 2) & 1);
    for (int row = c.gw; row < nrows; row += c.ngw) {
        const float* xr = c.HX() + (size_t)row * D;
        f4 v[8]; float ss = 0.f;
#pragma unroll
        for (int j = 0; j < 8; ++j) { v[j] = *(const f4*)(xr + 4 * lane + 256 * j); ss += v[j].x * v[j].x + v[j].y * v[j].y + v[j].z * v[j].z + v[j].w * v[j].w; }
        ss = wave_sum(ss);
        const float rstd = 1.0f / sqrtf(ss * (1.0f / D) + 1e-6f);
        const float* nw = c.norm_ffn_w() + (size_t)l * D; const float* md = c.MOD() + (size_t)(l * 3 + modrow(row)) * MODW;
        bf16* orow = c.NX() + (size_t)row * D;
#pragma unroll
        for (int j = 0; j < 8; ++j) { const int col = 4 * lane + 256 * j; const f4 w = *(const f4*)(nw + col), sh = *(const f4*)(md + 3 * D + col), sc = *(const f4*)(md + 4 * D + col);
            v[j] = v[j] * rstd * w * (1.0f + sc) + sh; u2 o; o.x = pk2(v[j].x, v[j].y); o.y = pk2(v[j].z, v[j].w); *(u2*)(orow + col) = o; }
        float acc[16];
#pragma unroll
        for (int e = 0; e < 16; ++e) acc[e] = 0.f;
#pragma unroll
        for (int j = 0; j < 8; ++j) {
            asm volatile("" ::: "memory");
#pragma unroll
            for (int e = 0; e < 16; ++e) { const f4 w = *(const f4*)(WR + e * D + 256 * j + 4 * lane); acc[e] += v[j].x * w.x + v[j].y * w.y + v[j].z * w.z + v[j].w * w.w; } }
        float a8[8], a4[4], a2[2];
        { const bool hi = (lane & 32) != 0;
#pragma unroll
            for (int e = 0; e < 8; ++e) { const float send = hi ? acc[e] : acc[e + 8], keep = hi ? acc[e + 8] : acc[e]; a8[e] = keep + __shfl_xor(send, 32); } }
        { const bool hi = (lane & 16) != 0;
#pragma unroll
            for (int e = 0; e < 4; ++e) { const float send = hi ? a8[e] : a8[e + 4], keep = hi ? a8[e + 4] : a8[e]; a4[e] = keep + __shfl_xor(send, 16); } }
        { const bool hi = (lane & 8) != 0;
#pragma unroll
            for (int e = 0; e < 2; ++e) { const float send = hi ? a4[e] : a4[e + 2], keep = hi ? a4[e + 2] : a4[e]; a2[e] = keep + __shfl_xor(send, 8); } }
        float lg; { const bool hi = (lane & 4) != 0; const float send = hi ? a2[0] : a2[1], keep = hi ? a2[1] : a2[0]; lg = keep + __shfl_xor(send, 4); }
        lg += __shfl_xor(lg, 1); lg += __shfl_xor(lg, 2);
        float mx = lg;
        mx = fmaxf(mx, __shfl_xor(mx, 4)); mx = fmaxf(mx, __shfl_xor(mx, 8)); mx = fmaxf(mx, __shfl_xor(mx, 16)); mx = fmaxf(mx, __shfl_xor(mx, 32));
        const float ex = expf(lg - mx); float sum = ex;
        sum += __shfl_xor(sum, 4); sum += __shfl_xor(sum, 8); sum += __shfl_xor(sum, 16); sum += __shfl_xor(sum, 32);
        if ((lane & 3) == 0) c.AFF()[(size_t)row * 16 + eid] = ex / sum;
    }
}

__device__ __forceinline__ int block_excl_scan(int v, int* sc, int tid, int& total) {
    const int lane = tid & 63, w = tid >> 6; int x = v;
#pragma unroll
    for (int o = 1; o < 64; o <<= 1) { const int y = __shfl_up(x, o); if (lane >= o) x += y; }
    if (lane == 63) sc[w] = x;
    __syncthreads();
    int woff = 0, tot = 0;
#pragma unroll
    for (int i = 0; i < NWAVES; ++i) { const int t = sc[i]; woff += (i < w) ? t : 0; tot += t; }
    __syncthreads();
    total = tot; return woff + x - v;
}
__device__ __forceinline__ void ph_topk(const Ctx& c, int l) {
    unsigned* keys = (unsigned*)c.lds; unsigned* hist = keys + 4096; unsigned* misc = hist + 256; int* scs = (int*)(misc + 16);
    const int ntask = l == 0 ? 64 : 32, tid = c.tid;
    for (int task = blockIdx.x; task < ntask; task += gridDim.x) {
        const int s = task >> 5, b = (task >> 4) & 1, e = task & 15;
        const int n = s ? CTX : SEQ, cap = s ? 32 : 512, base_row = s ? ML + b * CTX : b * SEQ, slot_base = s ? 1024 + b * 32 : b * 512;
        __syncthreads();
        for (int i = tid; i < n; i += NTHREADS) keys[i] = __float_as_uint(c.AFF()[(size_t)(base_row + i) * 16 + e]);
        if (tid == 0) { misc[0] = 0u; misc[1] = (unsigned)cap; }
        unsigned prefix = 0u, mask = 0u;
        for (int shift = 24; shift >= 0; shift -= 8) {
            if (tid < 256) hist[tid] = 0u;
            __syncthreads();
            for (int i = tid; i < n; i += NTHREADS) { const unsigned k = keys[i]; if ((k & mask) == prefix) atomicAdd(&hist[(k >> shift) & 255u], 1u); }
            __syncthreads();
            if (tid < 64) { const unsigned kk = misc[1]; const unsigned h0 = hist[4 * tid], h1 = hist[4 * tid + 1], h2 = hist[4 * tid + 2], h3 = hist[4 * tid + 3];
                const unsigned s4 = h0 + h1 + h2 + h3; unsigned suf = s4;
#pragma unroll
                for (int o = 1; o < 64; o <<= 1) { const unsigned y = __shfl_down(suf, o); if (tid + o < 64) suf += y; }
                const unsigned above = suf - s4;
                if (above < kk && kk <= suf) { unsigned cum = above; int bin;
                    if (cum + h3 >= kk) bin = 3; else { cum += h3; if (cum + h2 >= kk) bin = 2; else { cum += h2; if (cum + h1 >= kk) bin = 1; else { cum += h1; bin = 0; } } }
                    misc[0] = prefix | ((unsigned)(4 * tid + bin) << shift); misc[1] = kk - cum; } }
            __syncthreads();
            prefix = misc[0]; mask |= 255u << shift;
        }
        const unsigned thr = prefix; const int need = (int)misc[1];
        const int ipt = n >= NTHREADS ? n / NTHREADS : 1, i0 = tid * ipt;
        int cg = 0, ce = 0;
        if (i0 < n) for (int i = 0; i < ipt; ++i) { const unsigned k = keys[i0 + i]; cg += k > thr; ce += k == thr; }
        int G, Etot;
        int og = block_excl_scan(cg, scs, tid, G);
        int oe = block_excl_scan(ce, scs, tid, Etot);
        if (i0 < n) for (int i = 0; i < ipt; ++i) { const unsigned k = keys[i0 + i]; int slot = -1;
            if (k > thr) slot = og++; else if (k == thr) { if (oe < need) slot = G + oe; ++oe; }
            c.SLOTOF()[(size_t)e * MROWS + base_row + i0 + i] = slot >= 0 ? slot_base + slot : -1;
            if (slot >= 0) { c.IDX()[e * ESLOT + slot_base + slot] = base_row + i0 + i; c.GATEV()[e * ESLOT + slot_base + slot] = __uint_as_float(k); } }
    }
}

__device__ __forceinline__ void ph_gather(const Ctx& c, int l) {
    const int nsl = l == 0 ? 1088 : 1024, ntask = NE * nsl;
    const bool f8 = ((F8MASK) >> l) & 1;
    for (int task = c.gw; task < ntask; task += c.ngw) { const int e = task / nsl, slot = task % nsl; const int tok = c.IDX()[e * ESLOT + slot];
        if (!f8) { const u4* src = (const u4*)(c.NX() + (size_t)tok * D); u4* dst = (u4*)(c.AMOE() + ((size_t)e * ESLOT + slot) * D);
#pragma unroll
            for (int j = 0; j < 4; ++j) dst[c.lane + 64 * j] = src[c.lane + 64 * j]; }
        else { const u4* src = (const u4*)(c.NX() + (size_t)tok * D) + 4 * c.lane;
            const u4 r0 = src[0], r1 = src[1], r2 = src[2], r3 = src[3];
            u4 o0, o1;
            o0.x = pk4_fp8(bf2f(r0.x & 0xffffu), bf2f(r0.x >> 16), bf2f(r0.y & 0xffffu), bf2f(r0.y >> 16)); o0.y = pk4_fp8(bf2f(r0.z & 0xffffu), bf2f(r0.z >> 16), bf2f(r0.w & 0xffffu), bf2f(r0.w >> 16));
            o0.z = pk4_fp8(bf2f(r1.x & 0xffffu), bf2f(r1.x >> 16), bf2f(r1.y & 0xffffu), bf2f(r1.y >> 16)); o0.w = pk4_fp8(bf2f(r1.z & 0xffffu), bf2f(r1.z >> 16), bf2f(r1.w & 0xffffu), bf2f(r1.w >> 16));
            o1.x = pk4_fp8(bf2f(r2.x & 0xffffu), bf2f(r2.x >> 16), bf2f(r2.y & 0xffffu), bf2f(r2.y >> 16)); o1.y = pk4_fp8(bf2f(r2.z & 0xffffu), bf2f(r2.z >> 16), bf2f(r2.w & 0xffffu), bf2f(r2.w >> 16));
            o1.z = pk4_fp8(bf2f(r3.x & 0xffffu), bf2f(r3.x >> 16), bf2f(r3.y & 0xffffu), bf2f(r3.y >> 16)); o1.w = pk4_fp8(bf2f(r3.z & 0xffffu), bf2f(r3.z >> 16), bf2f(r3.w & 0xffffu), bf2f(r3.w >> 16));
            u4* dst = (u4*)((unsigned char*)c.AMOE() + ((size_t)e * ESLOT + slot) * D) + 2 * c.lane;
            dst[0] = o0; dst[1] = o1; } }
}

__device__ __forceinline__ void ph_final(const Ctx& c) {
    const int lane = c.lane;
    for (int row = c.gw; row < ML; row += c.ngw) {
        const float* xr = c.HX() + (size_t)row * D;
        f4 v[8]; float ss = 0.f;
#pragma unroll
        for (int j = 0; j < 8; ++j) v[j] = *(const f4*)(xr + 4 * lane + 256 * j);
        moe_combine_row(c, 1, row, lane, v);
#pragma unroll
        for (int j = 0; j < 8; ++j) ss += v[j].x * v[j].x + v[j].y * v[j].y + v[j].z * v[j].z + v[j].w * v[j].w;
        ss = wave_sum(ss);
        const float rstd = 1.0f / sqrtf(ss * (1.0f / D) + 1e-6f);
#pragma unroll
        for (int j = 0; j < 8; ++j) { const int col = 4 * lane + 256 * j; *(f4*)(c.out() + (size_t)row * D + col) = v[j] * rstd * *(const f4*)(c.final_norm_w() + col); }
    }
#if defined(TPROBE)
    if (TPROBE >= 0) { __syncthreads(); if (blockIdx.x == 0 && c.tid == 0) { asm volatile("s_waitcnt vmcnt(0)" ::: "memory"); c.out()[0] = 20480.0f * (float)(c.ctl()[CW_TP + 64 * TPROBE] >> 11); } }
#endif
}

typedef short bf16x8 __attribute__((ext_vector_type(8)));
#define RAW_BAR() do { asm volatile("s_waitcnt lgkmcnt(0)" ::: "memory"); __builtin_amdgcn_s_barrier(); asm volatile("" ::: "memory"); } while (0)
#define MFMA16(a, b, c) __builtin_amdgcn_mfma_f32_16x16x32_bf16((a), (b), (c), 0, 0, 0)
__device__ __forceinline__ bf16x8 ldfrag(const LAS unsigned char* base, int stride, int row0, int ks, int lane) {
    return *(const LAS bf16x8*)(base + (row0 + (lane & 15)) * stride + ks * 64 + (lane >> 4) * 16);
}
__device__ __forceinline__ int blk_row0(int b, int blk) { return blk < 4 ? ML + b * CTX + blk * 64 : b * SEQ + (blk - 4) * 64; }
__device__ __forceinline__ int scan_blk(int s, int dir) { return s < 4 ? (dir ? 3 - s : s) : (dir ? 71 - s : s); }

__device__ __forceinline__ void gla_tiles_unit(const Ctx& c, int lsel, int ud);
__device__ __forceinline__ void ph_gdn_chunk(const Ctx& c, int l) {
    LAS unsigned char* L = (LAS unsigned char*)c.lds;
    constexpr int O_D = 0, O_MO = 8192, O_A = 26624, O_G = 45056, O_R1 = 47104, O_SOL = 83968;
    const float* GQ = c.GQKV(); const float* GG = c.GGB();
    LAS float* gcf = (LAS float*)(L + O_G); LAS float* gcb = gcf + 64; LAS float* btf = gcf + 128; LAS float* btb = gcf + 192; LAS float* egf = gcf + 256; LAS float* egb = gcf + 320;
    __syncthreads();
    { const int tid = c.tid;
    for (int i = tid; i < 73728 / 16; i += NTHREADS) *(LAS u4*)(L + O_SOL + i * 16) = (u4){0u, 0u, 0u, 0u}; }
    int* qsh = (int*)(c.lds + MISC_OFF + 64);
    for (;;) {
        __syncthreads();
        if (c.tid == 0) *qsh = (int)atomicAdd(c.ctl() + CW_CHQ + 64 * (l + 2 * c.rep), 1u);
        __syncthreads();
        const int unit = *qsh;
        if (unit >= 544 + 1088) break;
        if (unit >= 544) { const int uu = unit - 544, bhq = (uu >> 1) / 68, blq = (uu >> 1) % 68; gla_tiles_unit(c, l, (bhq * UDS + blq) * 2 + (uu & 1)); continue; }
        const int bh = unit / 68, blk = unit % 68, b = bh >> 2, h = bh & 3, row0 = blk_row0(b, blk);
        int tid = c.tid; asm volatile("" : "+v"(tid));
        const int lane = tid & 63, w = __builtin_amdgcn_readfirstlane(tid >> 6);
        __syncthreads();
        for (int idx = tid; idx < 2048; idx += NTHREADS) { const int t = idx >> 5, d4 = (idx & 31) * 4; const float* src = GQ + (size_t)(row0 + t) * 1536 + h * 128 + d4;
            const f4 qv = *(const f4*)src, kv = *(const f4*)(src + 512);
            u2 qo, ko; qo.x = pk2(qv.x, qv.y); qo.y = pk2(qv.z, qv.w); ko.x = pk2(kv.x, kv.y); ko.y = pk2(kv.z, kv.w);
            *(LAS u2*)(L + O_R1 + t * 272 + d4 * 2) = ko; *(LAS u2*)(L + O_R1 + 17408 + t * 272 + d4 * 2) = qo; }
        if (w == 0) { const float* gp = GG + (size_t)(row0 + lane) * 16; float a = gp[h], bq = gp[4 + h];
#pragma unroll
            for (int o = 1; o < 64; o <<= 1) { const float y = __shfl_up(a, o); if (lane >= o) a += y; const float z = __shfl_down(bq, o); if (lane + o < 64) bq += z; }
            gcf[lane] = a; gcb[lane] = bq; btf[lane] = gp[8 + h]; btb[lane] = gp[12 + h]; egf[lane] = __expf(a); egb[lane] = __expf(bq); }
        const int sdir = tid >> 8, scol = tid & 255;
        const float* rp = GQ + (size_t)row0 * 1536 + (scol < 128 ? 1024 + h * 128 + scol : 512 + h * 128 + (scol - 128));
        __syncthreads();
        {
            const int which = w >> 2, tt = w & 3;
            const LAS unsigned char* Ab = L + O_R1 + (which ? 17408 : 0);
            const int t = tt * 16 + (lane & 15); const float gft = gcf[t], gbt = gcb[t], bft = btf[t], bbt = btb[t];
            bf16x8 ga[4], gb[4][4];
#pragma unroll
            for (int ks = 0; ks < 4; ++ks) { ga[ks] = ldfrag(Ab, 272, tt * 16, ks, lane);
#pragma unroll
                for (int st = 0; st < 4; ++st) gb[st][ks] = ldfrag(L + O_R1, 272, st * 16, ks, lane); }
            __builtin_amdgcn_sched_barrier(0);
#pragma unroll
            for (int st = 0; st < 4; ++st) {
                f32x4 acc = {0.f, 0.f, 0.f, 0.f};
#pragma unroll
                for (int ks = 0; ks < 4; ++ks) acc = MFMA16(gb[st][ks], ga[ks], acc);
                const int s0 = st * 16 + (lane >> 4) * 4;
                if (which == 0) { float mf[4], mb[4];
#pragma unroll
                    for (int j = 0; j < 4; ++j) { const int s = s0 + j; mf[j] = s < t ? bft * acc[j] * __expf(gft - gcf[s]) : 0.f; mb[j] = s > t ? bbt * acc[j] * __expf(gbt - gcb[s]) : 0.f; }
                    if (st == tt) { *(LAS f4*)(L + O_D + ((tt * 16 + (lane & 15)) * 16 + (lane >> 4) * 4) * 4) = (f4){mf[0], mf[1], mf[2], mf[3]};
                                    *(LAS f4*)(L + O_D + 4096 + ((tt * 16 + (lane & 15)) * 16 + (lane >> 4) * 4) * 4) = (f4){mb[0], mb[1], mb[2], mb[3]};
#pragma unroll
                                    for (int j = 0; j < 4; ++j) { mf[j] = 0.f; mb[j] = 0.f; } }
                    u2 of, ob; of.x = pk2(mf[0], mf[1]); of.y = pk2(mf[2], mf[3]); ob.x = pk2(mb[0], mb[1]); ob.y = pk2(mb[2], mb[3]);
                    *(LAS u2*)(L + O_MO + t * 144 + s0 * 2) = of; *(LAS u2*)(L + O_MO + 9216 + t * 144 + s0 * 2) = ob; }
                else { float vf[4], vb[4];
#pragma unroll
                    for (int j = 0; j < 4; ++j) { const int s = s0 + j; vf[j] = s <= t ? acc[j] * __expf(gft - gcf[s]) : 0.f; vb[j] = s >= t ? acc[j] * __expf(gbt - gcb[s]) : 0.f; }
                    u2 of, ob; of.x = pk2(vf[0], vf[1]); of.y = pk2(vf[2], vf[3]); ob.x = pk2(vb[0], vb[1]); ob.y = pk2(vb[2], vb[3]);
                    *(LAS u2*)(L + O_A + t * 144 + s0 * 2) = of; *(LAS u2*)(L + O_A + 9216 + t * 144 + s0 * 2) = ob; }
            }
        }
        __syncthreads();
        {
            const LAS float* btx = sdir ? btb : btf; const LAS float* egx = sdir ? egb : egf;
            LAS unsigned char* sp = L + O_SOL + (sdir * 256 + scol) * 144;
            const int mdir = w >> 2, mq = w & 3;
float rhn[16];
            { const int q0 = sdir ? 3 : 0;
#pragma unroll
                for (int ii = 0; ii < 16; ++ii) rhn[ii] = rp[(size_t)(16 * q0 + ii) * 1536]; }
#define GDN_ROUND(RR) { constexpr int R = RR; \
                constexpr int qf = R, qb = 3 - R; \
                if constexpr (R > 0) { \
                    const int q = mdir ? qb : qf; \
                    const LAS unsigned char* Mo = L + O_MO + mdir * 9216; const LAS unsigned char* So = L + O_SOL + mdir * 36864; \
                    const bf16x8 m0 = ldfrag(Mo, 144, q * 16, 0, lane), m1 = ldfrag(Mo, 144, q * 16, 1, lane); \
                    _Pragma("unroll") for (int ct = 0; ct < 4; ++ct) { const int ctile = mq * 4 + ct; f32x4 acc = {0.f, 0.f, 0.f, 0.f}; \
                        acc = MFMA16(m0, ldfrag(So, 144, ctile * 16, 0, lane), acc); acc = MFMA16(m1, ldfrag(So, 144, ctile * 16, 1, lane), acc); \
                        *(LAS f32x4*)(L + O_R1 + ((mdir * 256 + ctile * 16 + (lane & 15)) * 16 + (lane >> 4) * 4) * 4) = acc; } \
                    __syncthreads(); \
                } \
                const int q = sdir ? qb : qf; \
                float x[16]; \
                _Pragma("unroll") for (int ii = 0; ii < 16; ++ii) { const int t = 16 * q + ii; float v = rhn[ii] * btx[t]; if (scol >= 128) v *= egx[t]; x[ii] = v; } \
                if constexpr (R < 3) { const int qn = sdir ? qb - 1 : qf + 1; _Pragma("unroll") for (int ii = 0; ii < 16; ++ii) rhn[ii] = rp[(size_t)(16 * qn + ii) * 1536]; } \
                if constexpr (R > 0) { const LAS f4* cb = (const LAS f4*)(L + O_R1 + (sdir * 256 + scol) * 64); \
                    _Pragma("unroll") for (int i4 = 0; i4 < 4; ++i4) { const f4 cv = cb[i4]; x[4 * i4] -= cv.x; x[4 * i4 + 1] -= cv.y; x[4 * i4 + 2] -= cv.z; x[4 * i4 + 3] -= cv.w; } } \
                const LAS float* Dp = (const LAS float*)(L + O_D + sdir * 4096) + q * 256; \
                if (sdir == 0) { \
                    _Pragma("unroll") for (int ii = 1; ii < 16; ++ii) { float a = x[ii]; \
                        _Pragma("unroll") for (int j4 = 0; j4 < 16; j4 += 4) if (j4 < ii) { const f4 m = *(const LAS f4*)(Dp + ii * 16 + j4); \
                            _Pragma("unroll") for (int jj = 0; jj < 4; ++jj) if (j4 + jj < ii) a -= m[jj] * x[j4 + jj]; } \
                        x[ii] = a; } \
                } else { \
                    _Pragma("unroll") for (int ii = 14; ii >= 0; --ii) { float a = x[ii]; \
                        _Pragma("unroll") for (int j4 = 0; j4 < 16; j4 += 4) if (j4 + 3 > ii) { const f4 m = *(const LAS f4*)(Dp + ii * 16 + j4); \
                            _Pragma("unroll") for (int jj = 0; jj < 4; ++jj) if (j4 + jj > ii) a -= m[jj] * x[j4 + jj]; } \
                        x[ii] = a; } \
                } \
                u4 o0, o1; o0.x = pk2(x[0], x[1]); o0.y = pk2(x[2], x[3]); o0.z = pk2(x[4], x[5]); o0.w = pk2(x[6], x[7]); o1.x = pk2(x[8], x[9]); o1.y = pk2(x[10], x[11]); o1.z = pk2(x[12], x[13]); o1.w = pk2(x[14], x[15]); \
                *(LAS u4*)(sp + q * 32) = o0; *(LAS u4*)(sp + q * 32 + 16) = o1; \
                __syncthreads(); \
            }
            GDN_ROUND(0) GDN_ROUND(1) GDN_ROUND(2) GDN_ROUND(3)
#undef GDN_ROUND
        }
        for (int idx = tid; idx < 4096; idx += NTHREADS) { const int dir = idx >> 11, t = (idx >> 5) & 63, d4 = (idx & 31) * 4;
            const f4 kv = *(const f4*)(GQ + (size_t)(row0 + t) * 1536 + 512 + h * 128 + d4);
            const float sc = dir ? __expf(gcb[0] - gcb[t]) : __expf(gcf[63] - gcf[t]);
            LAS bf16* dst = (LAS bf16*)(L + O_R1 + dir * 18432) + t;
            dst[(d4 + 0) * 72] = (bf16)f2bf(kv.x * sc); dst[(d4 + 1) * 72] = (bf16)f2bf(kv.y * sc); dst[(d4 + 2) * 72] = (bf16)f2bf(kv.z * sc); dst[(d4 + 3) * 72] = (bf16)f2bf(kv.w * sc); }
        __syncthreads();
        {
            const int dir = w >> 2, wq = w & 3, ud = (bh * UDS + blk) * 2 + dir;
            const LAS unsigned char* Aa = L + O_A + dir * 9216; const LAS unsigned char* SolU = L + O_SOL + dir * 256 * 144; const LAS unsigned char* SolW = SolU + 128 * 144;
            const LAS unsigned char* Kd = L + O_R1 + dir * 18432;
            const LAS float* egx = dir ? egb : egf;
            const bf16x8 a0 = ldfrag(Aa, 144, wq * 16, 0, lane), a1 = ldfrag(Aa, 144, wq * 16, 1, lane);
            const int t = wq * 16 + (lane & 15); const float eg = egx[t];
            bf16* qp = c.GDQP() + (size_t)ud * 8192 + ((size_t)(wq * 4) * 64 + (lane & 15) + 16 * (lane >> 5)) * 8 + ((lane >> 4) & 1) * 4; bf16* o0 = c.GDO0() + ((size_t)ud * 64 + t) * 128 + (lane >> 4) * 4;
            const float* qsrc = GQ + (size_t)(row0 + t) * 1536 + h * 128 + (lane >> 4) * 4;
            const bf16x8 kd[2][2] = {{ldfrag(Kd, 144, (2 * wq) * 16, 0, lane), ldfrag(Kd, 144, (2 * wq) * 16, 1, lane)}, {ldfrag(Kd, 144, (2 * wq + 1) * 16, 0, lane), ldfrag(Kd, 144, (2 * wq + 1) * 16, 1, lane)}};
            {
                bf16x8 fw[8][2];
#pragma unroll
                for (int nt = 0; nt < 8; ++nt) { fw[nt][0] = ldfrag(SolW, 144, nt * 16, 0, lane); fw[nt][1] = ldfrag(SolW, 144, nt * 16, 1, lane); }
                __builtin_amdgcn_sched_barrier(0);
#pragma unroll
                for (int nt = 0; nt < 8; ++nt) { f32x4 acc = {0.f, 0.f, 0.f, 0.f};
                    acc = MFMA16(fw[nt][0], a0, acc); acc = MFMA16(fw[nt][1], a1, acc);
                    const f4 qv = *(const f4*)(qsrc + nt * 16);
                    u2 o; o.x = pk2(qv.x * eg - acc[0], qv.y * eg - acc[1]); o.y = pk2(qv.z * eg - acc[2], qv.w * eg - acc[3]);
                    *(u2*)(qp + ((nt >> 1) * 64 + 32 * (nt & 1)) * 8) = o; }
#pragma unroll
                for (int dt2 = 0; dt2 < 2; ++dt2) { const int dtile = 2 * wq + dt2;
                    bf16* ap = c.GDAP() + (size_t)ud * 16384 + ((size_t)(dtile * 4) * 64 + (lane & 15) + 16 * (lane >> 5)) * 8 + ((lane >> 4) & 1) * 4;
#pragma unroll
                    for (int nt = 0; nt < 8; ++nt) { f32x4 acc = {0.f, 0.f, 0.f, 0.f};
                        acc = MFMA16(fw[nt][0], kd[dt2][0], acc); acc = MFMA16(fw[nt][1], kd[dt2][1], acc);
                        u2 o; o.x = pk2(-acc[0], -acc[1]); o.y = pk2(-acc[2], -acc[3]); *(u2*)(ap + ((nt >> 1) * 64 + 32 * (nt & 1)) * 8) = o; } }
            }
            {
                bf16x8 fu[8][2];
                __builtin_amdgcn_sched_barrier(0);
#pragma unroll
                for (int nt = 0; nt < 8; ++nt) { fu[nt][0] = ldfrag(SolU, 144, nt * 16, 0, lane); fu[nt][1] = ldfrag(SolU, 144, nt * 16, 1, lane); }
                __builtin_amdgcn_sched_barrier(0);
#pragma unroll
                for (int nt = 0; nt < 8; ++nt) { f32x4 acc = {0.f, 0.f, 0.f, 0.f};
                    acc = MFMA16(fu[nt][0], a0, acc); acc = MFMA16(fu[nt][1], a1, acc);
                    u2 ob; ob.x = pk2(acc[0], acc[1]); ob.y = pk2(acc[2], acc[3]); *(u2*)(o0 + nt * 16) = ob; }
#pragma unroll
                for (int dt2 = 0; dt2 < 2; ++dt2) { const int dtile = 2 * wq + dt2;
                    bf16* bm = c.GDBM() + ((size_t)ud * 128 + (lane & 15)) * 128 + dtile * 16 + (lane >> 4) * 4;
#pragma unroll
                    for (int nt = 0; nt < 8; ++nt) { f32x4 acc = {0.f, 0.f, 0.f, 0.f};
                        acc = MFMA16(kd[dt2][0], fu[nt][0], acc); acc = MFMA16(kd[dt2][1], fu[nt][1], acc);
                        u2 bb; bb.x = pk2(acc[0], acc[1]); bb.y = pk2(acc[2], acc[3]); *(u2*)(bm + (size_t)nt * 16 * 128) = bb; } }
            }
            if ((tid & 255) == 0) c.GDGL()[ud] = dir ? egb[0] : egf[63];
        }
    }
}

struct GdnSet { bf16x8 fa[4]; u2 bm[2]; float gl; };
__device__ __forceinline__ f32x4 bf4_to_f32(u2 v) { return (f32x4){bf2f(v.x & 0xffffu), bf2f(v.x >> 16), bf2f(v.y & 0xffffu), bf2f(v.y >> 16)}; }
template <int MODE> __device__ __forceinline__ void gdn_scan2(const Ctx& c, int b, int h, int dir, int eq) {
    LAS unsigned char* L = (LAS unsigned char*)c.lds;
    constexpr int O_ST = 0, STB = 32 * 272;
    int tid = c.tid; asm volatile("" : "+v"(tid));
    const int lane = tid & 63, w = __builtin_amdgcn_readfirstlane(tid >> 6);
    f32x4 S[2];
    S[0] = (f32x4){0.f, 0.f, 0.f, 0.f}; S[1] = S[0];
    __syncthreads();
    for (int i = tid; i < 2 * STB / 16; i += NTHREADS) *(LAS u4*)(L + O_ST + i * 16) = (u4){0u, 0u, 0u, 0u};
    const int udb = (b * 4 + h) * UDS;
    const int gst_off = ((eq * 2 * 4 + (w >> 1)) * 64 + (lane & 15) + 16 * ((w & 1) * 2 + (lane >> 5))) * 8 + ((lane >> 4) & 1) * 4;
    { bf16* g0 = c.GDST() + (size_t)((udb + scan_blk(0, dir)) * 2 + dir) * 16384 + gst_off; *(u2*)g0 = (u2){0u, 0u}; *(u2*)(g0 + 4 * 64 * 8) = (u2){0u, 0u}; }
    GdnSet s0, s1, s2, s3, s4;
    int vzero = 0; asm volatile("" : "+v"(vzero));
#define GDN_LOAD(SET, sn) { const int udn = (udb + scan_blk((sn), dir)) * 2 + dir; \
        const bf16* ga = c.GDAP() + (size_t)udn * 16384 + ((size_t)(w * 4) * 64 + lane) * 8; \
        _Pragma("unroll") for (int ks = 0; ks < 4; ++ks) SET.fa[ks] = *(const bf16x8*)(ga + ks * 512); \
        const bf16* bmn = c.GDBM() + ((size_t)udn * 128 + eq * 32 + (lane & 15)) * 128 + w * 16 + (lane >> 4) * 4; \
        SET.bm[0] = *(const u2*)bmn; SET.bm[1] = *(const u2*)(bmn + 16 * 128); \
        SET.gl = c.GDGL()[udn + vzero]; }
#define GDN_STEP(s, SET) { const int buf = (s) & 1; \
        S[0] = S[0] * SET.gl + bf4_to_f32(SET.bm[0]); S[1] = S[1] * SET.gl + bf4_to_f32(SET.bm[1]); \
        RAW_BAR(); \
        const LAS unsigned char* ST = L + O_ST + buf * STB; \
        bf16x8 fs[2][4]; \
        _Pragma("unroll") for (int ks = 0; ks < 4; ++ks) { fs[0][ks] = ldfrag(ST, 272, 0, ks, lane); fs[1][ks] = ldfrag(ST, 272, 16, ks, lane); } \
        __builtin_amdgcn_sched_barrier(0); asm volatile("s_waitcnt lgkmcnt(0)" ::: "memory"); __builtin_amdgcn_sched_barrier(0); \
        _Pragma("unroll") for (int ks = 0; ks < 4; ++ks) { S[0] = MFMA16(SET.fa[ks], fs[0][ks], S[0]); S[1] = MFMA16(SET.fa[ks], fs[1][ks], S[1]); } \
        if (MODE == 0 || MODE == 2) GDN_LOAD(SET, ((s) + 5 < 68 ? (s) + 5 : 67)) \
        { bf16* gn = c.GDST() + (size_t)((udb + scan_blk(((s) + 1 < 68 ? (s) + 1 : 67), dir)) * 2 + dir) * 16384 + gst_off; \
          _Pragma("unroll") for (int et = 0; et < 2; ++et) { u2 o; o.x = pk2(S[et][0], S[et][1]); o.y = pk2(S[et][2], S[et][3]); \
            *(LAS u2*)(L + O_ST + (buf ^ 1) * STB + (et * 16 + (lane & 15)) * 272 + (w * 16 + (lane >> 4) * 4) * 2) = o; \
            if ((MODE == 0 || MODE == 3) && (s) + 1 < 68) *(u2*)(gn + et * 4 * 64 * 8) = o; } } }
    GDN_LOAD(s0, 0) GDN_LOAD(s1, 1) GDN_LOAD(s2, 2) GDN_LOAD(s3, 3) GDN_LOAD(s4, 4)
    for (int s = 0; s < 65; s += 5) { GDN_STEP(s, s0) GDN_STEP(s + 1, s1) GDN_STEP(s + 2, s2) GDN_STEP(s + 3, s3) GDN_STEP(s + 4, s4) }
    GDN_STEP(65, s0) GDN_STEP(66, s1) GDN_STEP(67, s2)
#undef GDN_LOAD
#undef GDN_STEP
}

__device__ __forceinline__ void gdn_out_unit(const Ctx& c, int l, int b, int h, int blk) {
    int tid = c.tid; asm volatile("" : "+v"(tid));
    const int lane = tid & 63, w = __builtin_amdgcn_readfirstlane(tid >> 6);
    const int tt = w & 3, ehh = w >> 2, t = tt * 16 + (lane & 15), row = blk_row0(b, blk) + t;
    float* red = (float*)c.lds;
    f32x4 acc[4];
#pragma unroll
    for (int i = 0; i < 4; ++i) acc[i] = (f32x4){0.f, 0.f, 0.f, 0.f};
#pragma unroll
    for (int dir = 0; dir < 2; ++dir) { const size_t ud = (size_t)(((b * 4 + h) * UDS + blk) * 2 + dir);
        const bf16* gq = c.GDQP() + ud * 8192 + ((size_t)(tt * 4) * 64 + lane) * 8;
        bf16x8 qf[4], sf[4][4]; u2 o0v[4];
#pragma unroll
        for (int ks = 0; ks < 4; ++ks) qf[ks] = *(const bf16x8*)(gq + ks * 512);
#pragma unroll
        for (int e4 = 0; e4 < 4; ++e4) { const int etile = ehh * 4 + e4; const bf16* gs = c.GDST() + ud * 16384 + ((size_t)(etile * 4) * 64 + lane) * 8;
            o0v[e4] = *(const u2*)(c.GDO0() + (ud * 64 + t) * 128 + etile * 16 + (lane >> 4) * 4);
#pragma unroll
            for (int ks = 0; ks < 4; ++ks) sf[e4][ks] = *(const bf16x8*)(gs + ks * 512); }
        __builtin_amdgcn_sched_barrier(0);
#pragma unroll
        for (int e4 = 0; e4 < 4; ++e4) { acc[e4] += bf4_to_f32(o0v[e4]);
#pragma unroll
            for (int ks = 0; ks < 4; ++ks) acc[e4] = MFMA16(sf[e4][ks], qf[ks], acc[e4]); }
        __builtin_amdgcn_sched_barrier(0); }
    float ss = 0.f;
#pragma unroll
    for (int e4 = 0; e4 < 4; ++e4) ss += acc[e4][0] * acc[e4][0] + acc[e4][1] * acc[e4][1] + acc[e4][2] * acc[e4][2] + acc[e4][3] * acc[e4][3];
    ss += __shfl_xor(ss, 16); ss += __shfl_xor(ss, 32);
    __syncthreads();
    if (lane < 16) red[ehh * 64 + t] = ss;
    __syncthreads();
    const float rstd = 1.0f / sqrtf((red[t] + red[64 + t]) * (1.0f / 128.f) + 1e-6f);
    const float* nw = c.gdn_norm_w() + l * 128;
#pragma unroll
    for (int e4 = 0; e4 < 4; ++e4) { const int e0 = (ehh * 4 + e4) * 16 + (lane >> 4) * 4;
        const u2 zr = *(const u2*)(c.P() + (size_t)row * NP + PC_GDZ + h * 128 + e0); const f32x4 z = bf4_to_f32(zr); const f4 nv = *(const f4*)(nw + e0);
        u2 o; o.x = pk2(acc[e4][0] * rstd * nv.x * silu_f(z[0]), acc[e4][1] * rstd * nv.y * silu_f(z[1])); o.y = pk2(acc[e4][2] * rstd * nv.z * silu_f(z[2]), acc[e4][3] * rstd * nv.w * silu_f(z[3]));
        *(u2*)(c.CAT() + (size_t)row * D + 1536 + h * 128 + e0) = o; }
}
__device__ __forceinline__ void gla_out_unit(const Ctx& c, int l, int b, int h, int blk);
__device__ __forceinline__ void ph_combine2(const Ctx& c, int l) {
    const int nb = l == 0 ? 68 : 64, nunit = 8 * nb;
    for (int u = blockIdx.x; u < 2 * nunit; u += gridDim.x) { const int kind = u >= nunit, uu = kind ? u - nunit : u, bh = uu / nb, blk = (uu % nb) + (68 - nb);
        if (kind == 0) gdn_out_unit(c, l, bh >> 2, bh & 3, blk); else gla_out_unit(c, l, bh >> 2, bh & 3, blk); }
}

__device__ __forceinline__ void gla_scan2(const Ctx& c, int b, int h, int dir, int eh) {
    LAS unsigned char* L = (LAS unsigned char*)c.lds;
    constexpr int O_QT = 0, O_KT = 9216, O_KH = 18432, O_VT = 27648, O_ATT = 36864, O_ST = 46080, O_CP = 64512, O_DEC = O_CP + 2048;
    const int tid = c.tid, lane = c.lane, w = c.wave, d = tid & 63, part = tid >> 6;
    LAS float* CP = (LAS float*)(L + O_CP); LAS float* DEC = (LAS float*)(L + O_DEC);
    const float* LQp = c.LQ(); const float* LKp = c.LK(); const float* LAp = c.LA() + (size_t)dir * MROWS * 256; const bf16* Pp = c.P();
    f32x4 S[2];
    S[0] = (f32x4){0.f, 0.f, 0.f, 0.f}; S[1] = S[0];
    __syncthreads();
    for (int i = tid; i < 9216 / 16; i += NTHREADS) *(LAS u4*)(L + O_ST + i * 16) = (u4){0u, 0u, 0u, 0u};
    float la[8], qv[8], kv[8]; unsigned vv[8];
    { const int row0 = blk_row0(b, scan_blk(0, dir));
#pragma unroll
        for (int ii = 0; ii < 8; ++ii) { const int i = part * 8 + ii, row = row0 + (dir ? 63 - i : i);
            la[ii] = LAp[(size_t)row * 256 + h * 64 + d]; qv[ii] = LQp[(size_t)row * 256 + h * 64 + d]; kv[ii] = LKp[(size_t)row * 256 + h * 64 + d]; vv[ii] = Pp[(size_t)row * NP + PC_GLV + h * 128 + eh * 64 + d]; } }
    for (int s = 0; s < 68; ++s) {
        const int blk = scan_blk(s, dir), row0 = blk_row0(b, blk), buf = s & 1;
        float p[8]; float run = 0.f;
#pragma unroll
        for (int ii = 0; ii < 8; ++ii) { run += la[ii]; p[ii] = run; }
        CP[part * 64 + d] = run;
        RAW_BAR();
        float off = 0.f, tot = 0.f;
#pragma unroll
        for (int pp = 0; pp < 8; ++pp) { const float xx = CP[pp * 64 + d]; tot += xx; off += (pp < part) ? xx : 0.f; }
        unsigned kh[8];
#pragma unroll
        for (int ii = 0; ii < 8; ++ii) { const float cum = off + p[ii]; const int i = part * 8 + ii;
            *(LAS bf16*)(L + O_QT + i * 144 + d * 2) = (bf16)f2bf(qv[ii] * __expf(cum)); *(LAS bf16*)(L + O_KT + i * 144 + d * 2) = (bf16)f2bf(kv[ii] * __expf(-cum)); kh[ii] = f2bf(kv[ii] * __expf(tot - cum)); }
        { u4 o; o.x = kh[0] | (kh[1] << 16); o.y = kh[2] | (kh[3] << 16); o.z = kh[4] | (kh[5] << 16); o.w = kh[6] | (kh[7] << 16); *(LAS u4*)(L + O_KH + d * 144 + part * 16) = o;
          u4 v; v.x = vv[0] | (vv[1] << 16); v.y = vv[2] | (vv[3] << 16); v.z = vv[4] | (vv[5] << 16); v.w = vv[6] | (vv[7] << 16); *(LAS u4*)(L + O_VT + d * 144 + part * 16) = v; }
        if (part == 0) DEC[d] = __expf(tot);
        if (s + 1 < 68) { const int rown = blk_row0(b, scan_blk(s + 1, dir));
#pragma unroll
            for (int ii = 0; ii < 8; ++ii) { const int i = part * 8 + ii, row = rown + (dir ? 63 - i : i);
                la[ii] = LAp[(size_t)row * 256 + h * 64 + d]; qv[ii] = LQp[(size_t)row * 256 + h * 64 + d]; kv[ii] = LKp[(size_t)row * 256 + h * 64 + d]; vv[ii] = Pp[(size_t)row * NP + PC_GLV + h * 128 + eh * 64 + d]; } }
        RAW_BAR();
        const int tt = w & 3, wh = w >> 2, ti = tt * 16 + (lane & 15);
#pragma unroll
        for (int i2 = 0; i2 < 2; ++i2) { const int st = 2 * wh + i2; f32x4 acc = {0.f, 0.f, 0.f, 0.f};
#pragma unroll
            for (int ks = 0; ks < 2; ++ks) acc = MFMA16(ldfrag(L + O_KT, 144, st * 16, ks, lane), ldfrag(L + O_QT, 144, tt * 16, ks, lane), acc);
            const int s0 = st * 16 + (lane >> 4) * 4;
            u2 o; o.x = pk2(s0 + 0 <= ti ? acc[0] : 0.f, s0 + 1 <= ti ? acc[1] : 0.f); o.y = pk2(s0 + 2 <= ti ? acc[2] : 0.f, s0 + 3 <= ti ? acc[3] : 0.f);
            *(LAS u2*)(L + O_ATT + ti * 144 + s0 * 2) = o; }
        RAW_BAR();
        { const int trow = row0 + (dir ? 63 - ti : ti); float* og = c.OGLA() + ((size_t)dir * MROWS + trow) * 512 + h * 128 + eh * 64 + (lane >> 4) * 4;
            const LAS unsigned char* ST = L + O_ST + buf * 9216;
#pragma unroll
            for (int i2 = 0; i2 < 2; ++i2) { const int et = 2 * wh + i2; f32x4 acc = {0.f, 0.f, 0.f, 0.f};
#pragma unroll
                for (int ks = 0; ks < 2; ++ks) acc = MFMA16(ldfrag(L + O_VT, 144, et * 16, ks, lane), ldfrag(L + O_ATT, 144, tt * 16, ks, lane), acc);
#pragma unroll
                for (int ks = 0; ks < 2; ++ks) acc = MFMA16(ldfrag(ST, 144, et * 16, ks, lane), ldfrag(L + O_QT, 144, tt * 16, ks, lane), acc);
                *(f32x4*)(og + et * 16) = acc; }
            const f4 dec = *(const LAS f4*)(DEC + tt * 16 + (lane >> 4) * 4);
#pragma unroll
            for (int i2 = 0; i2 < 2; ++i2) { const int et = 2 * wh + i2; S[i2] = S[i2] * dec;
#pragma unroll
                for (int ks = 0; ks < 2; ++ks) S[i2] = MFMA16(ldfrag(L + O_KH, 144, tt * 16, ks, lane), ldfrag(L + O_VT, 144, et * 16, ks, lane), S[i2]);
                u2 o; o.x = pk2(S[i2][0], S[i2][1]); o.y = pk2(S[i2][2], S[i2][3]);
                *(LAS u2*)(L + O_ST + (buf ^ 1) * 9216 + (et * 16 + (lane & 15)) * 144 + (tt * 16 + (lane >> 4) * 4) * 2) = o; } }
    }
}

__device__ __forceinline__ void gla_tiles_unit(const Ctx& c, int lsel, int ud) {
    LAS unsigned char* L = (LAS unsigned char*)c.lds;
    constexpr int O_QT = 0, O_KT = 9216, O_KH = 18432, O_VT = 27648, O_CP = 46080;
    int tid = c.tid; asm volatile("" : "+v"(tid));
    const int d = tid & 63, part = tid >> 6;
    const int dir = ud & 1, blk = (ud >> 1) % UDS, bh = (ud >> 1) / UDS, b = bh >> 2, h = bh & 3, row0 = blk_row0(b, blk);
    LAS float* CP = (LAS float*)(L + O_CP);
    const bf16* Pp = c.P();
    float la[8], qv[8], kv[8];
    { const float* gwp = c.gla_gate_w() + ((size_t)(lsel * 2 + dir) * 16) * 256 + h * 64 + d; const float gbias = c.gla_gate_b()[(size_t)(lsel * 2 + dir) * 256 + h * 64 + d];
        float gwv[16];
#pragma unroll
        for (int r = 0; r < 16; ++r) gwv[r] = gwp[(size_t)r * 256];
        const bool latent = blk >= 4; const int half = d >> 5, fi = d & 15; const bool lo = (d & 16) == 0;
        unsigned qraw[8], kraw[8];
#pragma unroll
        for (int ii = 0; ii < 8; ++ii) { const int i = part * 8 + ii, row = row0 + (dir ? 63 - i : i);
            qraw[ii] = Pp[(size_t)row * NP + PC_GLQ + h * 64 + d]; kraw[ii] = Pp[(size_t)row * NP + PC_GLK + h * 64 + d]; }
#pragma unroll
        for (int ii = 0; ii < 8; ++ii) { const int i = part * 8 + ii, tk = dir ? 63 - i : i, row = row0 + tk;
            float q = bf2f(qraw[ii]), k = bf2f(kraw[ii]);
            const float qo = __shfl_xor(q, 16), ko = __shfl_xor(k, 16);
            if (latent) { const int t = (blk - 4) * 64 + tk, pos = half ? (t & 63) : (t >> 6); const float cs = c.ROPE()[(pos * 16 + fi) * 2], sn = c.ROPE()[(pos * 16 + fi) * 2 + 1];
                q = lo ? q * cs - qo * sn : q * cs + qo * sn; k = lo ? k * cs - ko * sn : k * cs + ko * sn; }
            qv[ii] = q * 0.125f; kv[ii] = k;
            const float* ps = c.PS() + (size_t)row * 64 + dir * 16; float z = gbias;
#pragma unroll
            for (int r = 0; r < 16; ++r) z += ps[r] * gwv[r];
            la[ii] = logsigmoid_f(z) * 0.0625f; } }
    unsigned vv[16];
    { const int e = tid & 127, qtr = tid >> 7;
#pragma unroll
        for (int ii = 0; ii < 16; ++ii) { const int i = qtr * 16 + ii, row = row0 + (dir ? 63 - i : i); vv[ii] = Pp[(size_t)row * NP + PC_GLV + h * 128 + e]; } }
    float p[8]; float run = 0.f;
#pragma unroll
    for (int ii = 0; ii < 8; ++ii) { run += la[ii]; p[ii] = run; }
    __syncthreads();
    CP[part * 64 + d] = run;
    __syncthreads();
    float off = 0.f, tot = 0.f;
#pragma unroll
    for (int pp = 0; pp < 8; ++pp) { const float xx = CP[pp * 64 + d]; tot += xx; off += (pp < part) ? xx : 0.f; }
    unsigned kh[8];
#pragma unroll
    for (int ii = 0; ii < 8; ++ii) { const float cum = off + p[ii]; const int i = part * 8 + ii;
        *(LAS bf16*)(L + O_QT + i * 144 + d * 2) = (bf16)f2bf(qv[ii] * __expf(cum)); *(LAS bf16*)(L + O_KT + i * 144 + d * 2) = (bf16)f2bf(kv[ii] * __expf(-cum)); kh[ii] = f2bf(kv[ii] * __expf(tot - cum)); }
    { u4 o; o.x = kh[0] | (kh[1] << 16); o.y = kh[2] | (kh[3] << 16); o.z = kh[4] | (kh[5] << 16); o.w = kh[6] | (kh[7] << 16); *(LAS u4*)(L + O_KH + d * 144 + part * 16) = o; }
    { const int e = tid & 127, qtr = tid >> 7; u4 v0, v1;
        v0.x = vv[0] | (vv[1] << 16); v0.y = vv[2] | (vv[3] << 16); v0.z = vv[4] | (vv[5] << 16); v0.w = vv[6] | (vv[7] << 16);
        v1.x = vv[8] | (vv[9] << 16); v1.y = vv[10] | (vv[11] << 16); v1.z = vv[12] | (vv[13] << 16); v1.w = vv[14] | (vv[15] << 16);
        *(LAS u4*)(L + O_VT + e * 144 + qtr * 32) = v0; *(LAS u4*)(L + O_VT + e * 144 + qtr * 32 + 16) = v1; }
    if (part == 0) c.GLDEC()[(size_t)ud * 64 + d] = __expf(tot);
    __syncthreads();
    { const int f = tid >> 6, lp = tid & 63, r = (f >> 1) * 16 + (lp & 15), kc = (f & 1) * 4 + (lp >> 4);
        *(u4*)(c.GLQT() + (size_t)ud * 4096 + tid * 8) = *(const LAS u4*)(L + O_QT + r * 144 + kc * 16);
        *(u4*)(c.GLKT() + (size_t)ud * 4096 + tid * 8) = *(const LAS u4*)(L + O_KT + r * 144 + kc * 16);
        *(u4*)(c.GLKH() + (size_t)ud * 4096 + tid * 8) = *(const LAS u4*)(L + O_KH + r * 144 + kc * 16);
#pragma unroll
        for (int hh = 0; hh < 2; ++hh) { const int j = tid + 512 * hh, f2 = j >> 6, r2 = (f2 >> 1) * 16 + (lp & 15), kc2 = (f2 & 1) * 4 + (lp >> 4);
            *(u4*)(c.GLVT() + (size_t)ud * 8192 + j * 8) = *(const LAS u4*)(L + O_VT + r2 * 144 + kc2 * 16); } }
}

struct GlaSet { bf16x8 vt[2][2], kh[2]; f4 dec; };
__device__ __forceinline__ void gla_scan3(const Ctx& c, int b, int h, int dir, int eh) {
    int tid = c.tid; asm volatile("" : "+v"(tid));
    const int lane = tid & 63, w = __builtin_amdgcn_readfirstlane(tid >> 6);
    const int tt = w & 3, wh = w >> 2;
    f32x4 S[2];
    S[0] = (f32x4){0.f, 0.f, 0.f, 0.f}; S[1] = S[0];
    const int udb = (b * 4 + h) * UDS;
    const int gst_off = (((eh * 4 + 2 * wh) * 2 + (tt >> 1)) * 64 + (lane & 15) + 16 * ((tt & 1) * 2 + (lane >> 5))) * 8 + ((lane >> 4) & 1) * 4;
    { bf16* g0 = c.GLST() + (size_t)((udb + scan_blk(0, dir)) * 2 + dir) * 8192 + gst_off; *(u2*)g0 = (u2){0u, 0u}; *(u2*)(g0 + 2 * 64 * 8) = (u2){0u, 0u}; }
    GlaSet s0, s1, s2, s3, s4;
#define GLA_LOAD(SET, sn) { const size_t udn = (size_t)((udb + scan_blk((sn), dir)) * 2 + dir); \
        _Pragma("unroll") for (int ks = 0; ks < 2; ++ks) { \
            SET.kh[ks] = *(const bf16x8*)(c.GLKH() + udn * 4096 + ((tt * 2 + ks) * 64 + lane) * 8); \
            _Pragma("unroll") for (int i2 = 0; i2 < 2; ++i2) SET.vt[i2][ks] = *(const bf16x8*)(c.GLVT() + udn * 8192 + (((eh * 4 + 2 * wh + i2) * 2 + ks) * 64 + lane) * 8); } \
        SET.dec = *(const f4*)(c.GLDEC() + udn * 64 + tt * 16 + (lane >> 4) * 4); }
#define GLA_STEP(s, SET) { \
        _Pragma("unroll") for (int i2 = 0; i2 < 2; ++i2) { S[i2] = S[i2] * SET.dec; S[i2] = MFMA16(SET.kh[0], SET.vt[i2][0], S[i2]); S[i2] = MFMA16(SET.kh[1], SET.vt[i2][1], S[i2]); } \
        GLA_LOAD(SET, ((s) + 5 < 68 ? (s) + 5 : 67)) \
        if ((s) + 1 < 68) { bf16* gn = c.GLST() + (size_t)((udb + scan_blk((s) + 1, dir)) * 2 + dir) * 8192 + gst_off; \
            _Pragma("unroll") for (int i2 = 0; i2 < 2; ++i2) { u2 o; o.x = pk2(S[i2][0], S[i2][1]); o.y = pk2(S[i2][2], S[i2][3]); *(u2*)(gn + i2 * 2 * 64 * 8) = o; } } }
    GLA_LOAD(s0, 0) GLA_LOAD(s1, 1) GLA_LOAD(s2, 2) GLA_LOAD(s3, 3) GLA_LOAD(s4, 4)
    for (int s = 0; s < 65; s += 5) { GLA_STEP(s, s0) GLA_STEP(s + 1, s1) GLA_STEP(s + 2, s2) GLA_STEP(s + 3, s3) GLA_STEP(s + 4, s4) }
    GLA_STEP(65, s0) GLA_STEP(66, s1) GLA_STEP(67, s2)
#undef GLA_LOAD
#undef GLA_STEP
}

__device__ __forceinline__ void gla_out_unit(const Ctx& c, int l, int b, int h, int blk) {
    LAS unsigned char* L = (LAS unsigned char*)c.lds;
    constexpr int O_ATT = 0, O_O = 9216, OST = 132;
    int tid = c.tid; asm volatile("" : "+v"(tid));
    const int lane = tid & 63, w = __builtin_amdgcn_readfirstlane(tid >> 6);
    const int tt = w & 3, ehh = w >> 2, ti = tt * 16 + (lane & 15), row0 = blk_row0(b, blk);
    LAS float* Ob = (LAS float*)(L + O_O);
#pragma unroll 1
    for (int dir = 0; dir < 2; ++dir) { const size_t ud = (size_t)(((b * 4 + h) * UDS + blk) * 2 + dir);
        const bf16x8 q0 = *(const bf16x8*)(c.GLQT() + ud * 4096 + ((tt * 2 + 0) * 64 + lane) * 8), q1 = *(const bf16x8*)(c.GLQT() + ud * 4096 + ((tt * 2 + 1) * 64 + lane) * 8);
        __syncthreads();
        bf16x8 vf[4][2], sf[4][2];
#pragma unroll
        for (int e4 = 0; e4 < 4; ++e4) { const int etile = ehh * 4 + e4;
            const bf16* gv = c.GLVT() + ud * 8192 + ((size_t)(etile * 2) * 64 + lane) * 8; const bf16* gs = c.GLST() + ud * 8192 + ((size_t)(etile * 2) * 64 + lane) * 8;
            vf[e4][0] = *(const bf16x8*)gv; vf[e4][1] = *(const bf16x8*)(gv + 512); sf[e4][0] = *(const bf16x8*)gs; sf[e4][1] = *(const bf16x8*)(gs + 512); }
        if (ehh == 0) {
            bf16x8 kf[4][2];
#pragma unroll
            for (int st = 0; st < 4; ++st) { kf[st][0] = *(const bf16x8*)(c.GLKT() + ud * 4096 + ((st * 2 + 0) * 64 + lane) * 8); kf[st][1] = *(const bf16x8*)(c.GLKT() + ud * 4096 + ((st * 2 + 1) * 64 + lane) * 8); }
#pragma unroll
            for (int st = 0; st < 4; ++st) { f32x4 acc = {0.f, 0.f, 0.f, 0.f};
                acc = MFMA16(kf[st][0], q0, acc); acc = MFMA16(kf[st][1], q1, acc);
                const int s0i = st * 16 + (lane >> 4) * 4;
                u2 o; o.x = pk2(s0i + 0 <= ti ? acc[0] : 0.f, s0i + 1 <= ti ? acc[1] : 0.f); o.y = pk2(s0i + 2 <= ti ? acc[2] : 0.f, s0i + 3 <= ti ? acc[3] : 0.f);
                *(LAS u2*)(L + O_ATT + ti * 144 + s0i * 2) = o; } }
        __syncthreads();
        const bf16x8 at0 = ldfrag(L + O_ATT, 144, tt * 16, 0, lane), at1 = ldfrag(L + O_ATT, 144, tt * 16, 1, lane);
        const int tok = dir ? 63 - ti : ti;
#pragma unroll
        for (int e4 = 0; e4 < 4; ++e4) { const int etile = ehh * 4 + e4; f32x4 acc = {0.f, 0.f, 0.f, 0.f};
            acc = MFMA16(vf[e4][0], at0, acc); acc = MFMA16(vf[e4][1], at1, acc);
            acc = MFMA16(sf[e4][0], q0, acc); acc = MFMA16(sf[e4][1], q1, acc);
            LAS float* op = Ob + tok * OST + etile * 16 + (lane >> 4) * 4;
            if (dir == 0) *(LAS f32x4*)op = acc; else { const f32x4 prev = *(LAS f32x4*)op; *(LAS f32x4*)op = prev + acc; } }
    }
    __syncthreads();
    const float* nw = c.gla_norm_w() + l * 128;
    unsigned grv[8];
#pragma unroll
    for (int i = 0; i < 8; ++i) grv[i] = *(const unsigned*)(c.P() + (size_t)(row0 + w * 8 + i) * NP + PC_GLG + h * 128 + 2 * lane);
    const float nw0 = nw[2 * lane], nw1 = nw[2 * lane + 1];
#pragma unroll
    for (int i = 0; i < 8; ++i) { const int tok = w * 8 + i, row = row0 + tok;
        const float o0 = Ob[tok * OST + 2 * lane], o1 = Ob[tok * OST + 2 * lane + 1];
        const float ss = wave_sum(o0 * o0 + o1 * o1);
        const float rstd = 1.0f / sqrtf(ss * (1.0f / 128.f) + 1e-6f);
        const unsigned gr = grv[i];
        *(unsigned*)(c.CAT() + (size_t)row * D + 1024 + h * 128 + 2 * lane) = pk2(o0 * rstd * nw0 * silu_f(bf2f(gr & 0xffffu)), o1 * rstd * nw1 * silu_f(bf2f(gr >> 16))); }
}

__device__ __forceinline__ void ph_scan_na2(const Ctx& c, int l) {
    for (int bt = blockIdx.x; bt < 64; bt += gridDim.x) { const int kind = bt >> 5, dir = (bt >> 4) & 1, b = (bt >> 3) & 1, h = (bt >> 1) & 3, eh = bt & 1;
        if (kind == 0) gla_scan2(c, b, h, dir, eh); else gdn_scan2<0>(c, b, h, dir, eh); }
    __syncthreads();
    const int ntask = ML * 16 + (l == 0 ? MC * 16 : 0), nchunk = ntask / 512;
    int* sh = (int*)(c.lds + MISC_OFF + 64);
    for (;;) {
        __syncthreads();
        if (c.tid == 0) *sh = (int)atomicAdd(c.ctl() + CW_NAQ + 64 * (l + 2 * c.rep), 1u);
        __syncthreads();
        const int ch = *sh;
        if (ch >= nchunk) break;
        for (int i = 0; i < 64; ++i) na_task(c, l, ch * 512 + c.wave * 64 + i, c.lane);
    }
}

__device__ __forceinline__ void na_unit(const Ctx& c, int l, int unit) {
    LAS unsigned char* L = (LAS unsigned char*)c.lds;
    constexpr int VST = 1936, O_VT = 0, O_RPB = 64 * VST + 64, O_KC = O_RPB + 1984, KST = 144, CTXC = 704;
    static_assert(O_KC + 256 * KST <= MISC_OFF, "NA LDS map");
    int tid = c.tid; asm volatile("" : "+v"(tid));
    const int lane = tid & 63, w = __builtin_amdgcn_readfirstlane(tid >> 6);
    const int ql = lane & 15, kg = lane >> 4;
    const bool lat = unit < 512;
    int b, h, r0 = 0, rs0 = 0, nlr = 0, half = 0;
    if (lat) { b = unit >> 8; h = (unit >> 4) & 15; r0 = (unit & 15) * 4; rs0 = min(max(r0 - 4, 0), 56); nlr = min(max(r0 - 1, 0), 56) + 8 - rs0; }
    else { const int u = unit - 512; b = u >> 5; h = (u >> 1) & 15; half = u & 1; }
    const bf16* P = c.P();
    LAS float* RPB = (LAS float*)(L + O_RPB);
    const int g = w & 3;
    int r = lat ? r0 + (w >> 2) : 0;
    int qrow0 = lat ? b * SEQ + r * 64 + 16 * g : ML + b * CTX + half * 128 + w * 16;
    bf16x8 qf0, qf1;
    { const bf16* qp = P + (size_t)(qrow0 + ql) * NP + PC_NAQ + h * 64 + kg * 8; qf0 = *(const bf16x8*)qp; qf1 = *(const bf16x8*)(qp + 32); }
    __syncthreads();
    { const int npl = nlr * 32, npairs = npl + 128;
        u4 va[8], vb[8], kc[4];
#pragma unroll
        for (int it = 0; it < 8; ++it) { const int id = tid + NTHREADS * it, dc = id & 7, pi = id >> 3;
            if (pi < npairs) { const int row = pi < npl ? b * SEQ + rs0 * 64 + 2 * pi : ML + b * CTX + 2 * (pi - npl);
                const bf16* vp = P + (size_t)row * NP + PC_NAV + h * 64 + dc * 8; va[it] = *(const u4*)vp; vb[it] = *(const u4*)(vp + NP); } }
#pragma unroll
        for (int it = 0; it < 4; ++it) { const int id = tid + NTHREADS * it; kc[it] = *(const u4*)(P + (size_t)(ML + b * CTX + (id >> 3)) * NP + PC_NAK + h * 64 + (id & 7) * 8); }
#pragma unroll
        for (int it = 0; it < 8; ++it) { const int id = tid + NTHREADS * it, dc = id & 7, pi = id >> 3;
            if (pi < npairs) { const int col = pi < npl ? 2 * pi : CTXC + 2 * (pi - npl); const u4 a = va[it], bb = vb[it];
                LAS unsigned char* dst = L + O_VT + (dc * 8) * VST + col * 2;
                *(LAS unsigned*)(dst + 0 * VST) = (a.x & 0xffffu) | (bb.x << 16); *(LAS unsigned*)(dst + 1 * VST) = (a.x >> 16) | (bb.x & 0xffff0000u);
                *(LAS unsigned*)(dst + 2 * VST) = (a.y & 0xffffu) | (bb.y << 16); *(LAS unsigned*)(dst + 3 * VST) = (a.y >> 16) | (bb.y & 0xffff0000u);
                *(LAS unsigned*)(dst + 4 * VST) = (a.z & 0xffffu) | (bb.z << 16); *(LAS unsigned*)(dst + 5 * VST) = (a.z >> 16) | (bb.z & 0xffff0000u);
                *(LAS unsigned*)(dst + 6 * VST) = (a.w & 0xffffu) | (bb.w << 16); *(LAS unsigned*)(dst + 7 * VST) = (a.w >> 16) | (bb.w & 0xffff0000u); } }
#pragma unroll
        for (int it = 0; it < 4; ++it) { const int id = tid + NTHREADS * it; *(LAS u4*)(L + O_KC + (id >> 3) * KST + (id & 7) * 16) = kc[it]; }
        if (lat) for (int i = tid; i < 465; i += NTHREADS) RPB[i] = c.na_rpb()[(size_t)(l * 16 + h) * 465 + i] * 1.44269504f; }
    __syncthreads();
#define NA_LOADK(CH, RS) { _Pragma("unroll") for (int tl = 0; tl < 8; ++tl) { const int krow = b * SEQ + ((RS) + 4 * (CH) + (tl >> 1)) * 64 + c0 + 16 * (tl & 1); \
        const unsigned char* kb = (const unsigned char*)(P + (size_t)krow * NP + PC_NAK + h * 64);     \
        kf[tl][0] = *(const bf16x8*)(kb + loff); kf[tl][1] = *(const bf16x8*)(kb + loff + 64); } }
#define NA_QK_G() { _Pragma("unroll") for (int tl = 0; tl < 8; ++tl) { f32x4 acc = {0.f, 0.f, 0.f, 0.f}; acc = MFMA16(kf[tl][0], qf0, acc); acc = MFMA16(kf[tl][1], qf1, acc); S[tl] = acc; } }
#define NA_QK_L(CH) { _Pragma("unroll") for (int hb = 0; hb < 4; ++hb) { bf16x8 kl[2][2]; \
        __builtin_amdgcn_sched_barrier(0); \
        _Pragma("unroll") for (int t4 = 0; t4 < 2; ++t4) { const LAS unsigned char* kp = L + O_KC + (((CH) - 2) * 128 + (hb * 2 + t4) * 16 + ql) * KST + kg * 16; \
            kl[t4][0] = *(const LAS bf16x8*)kp; kl[t4][1] = *(const LAS bf16x8*)(kp + 64); } \
        __builtin_amdgcn_sched_barrier(0); \
        _Pragma("unroll") for (int t4 = 0; t4 < 2; ++t4) { f32x4 acc = {0.f, 0.f, 0.f, 0.f}; acc = MFMA16(kl[t4][0], qf0, acc); acc = MFMA16(kl[t4][1], qf1, acc); S[hb * 2 + t4] = acc; } } }
#define NA_CHUNK(CH, AFTER_QK) { f32x4 S[8]; \
        if ((CH) < 2) NA_QK_G() else NA_QK_L(CH) \
        __builtin_amdgcn_sched_barrier(0); \
        AFTER_QK \
        __builtin_amdgcn_sched_barrier(0); \
        float cm = -INFINITY; \
        _Pragma("unroll") for (int tl = 0; tl < 8; ++tl) _Pragma("unroll") for (int jj = 0; jj < 4; ++jj) { float sv; \
            if ((CH) < 2) { const float bv = rpl[(4 * (CH) + (tl >> 1)) * 31 + 16 * (tl & 1) + jj]; sv = __builtin_fmaf(S[tl][jj], 0.18033688f, vld[(tl & 1) * 4 + jj] ? bv : -INFINITY); } \
            else sv = S[tl][jj] * 0.18033688f; \
            S[tl][jj] = sv; cm = fmaxf(cm, sv); } \
        cm = fmaxf(cm, __shfl_xor(cm, 16)); cm = fmaxf(cm, __shfl_xor(cm, 32)); \
        const float mn = fmaxf(m, cm), alpha = __builtin_amdgcn_exp2f(m - mn); m = mn; \
        lsum *= alpha; \
        _Pragma("unroll") for (int dt = 0; dt < 4; ++dt) O[dt] = O[dt] * alpha; \
        bf16x8 pfr[4]; \
        _Pragma("unroll") for (int s4 = 0; s4 < 4; ++s4) { float p[8]; \
            _Pragma("unroll") for (int jj = 0; jj < 4; ++jj) { p[jj] = __builtin_amdgcn_exp2f(S[2 * s4][jj] - m); p[4 + jj] = __builtin_amdgcn_exp2f(S[2 * s4 + 1][jj] - m); lsum += p[jj] + p[4 + jj]; } \
            u4 pw; pw.x = pk2(p[0], p[1]); pw.y = pk2(p[2], p[3]); pw.z = pk2(p[4], p[5]); pw.w = pk2(p[6], p[7]); \
            pfr[s4] = __builtin_bit_cast(bf16x8, pw); } \
        _Pragma("unroll") for (int sh = 0; sh < 2; ++sh) { bf16x8 vfr[2][4]; \
            __builtin_amdgcn_sched_barrier(0); \
            _Pragma("unroll") for (int s2 = 0; s2 < 2; ++s2) { const int s4 = 2 * sh + s2; \
                const int colA = ((CH) < 2) ? (rs - rs0 + 4 * (CH) + s4) * 64 + c0 + 4 * kg : CTXC + ((CH) - 2) * 128 + 32 * s4 + 4 * kg; \
                _Pragma("unroll") for (int dt = 0; dt < 4; ++dt) { const LAS unsigned char* vp = L + O_VT + (dt * 16 + ql) * VST + colA * 2; \
                    const u2 va = *(const LAS u2*)vp, vb = *(const LAS u2*)(vp + 32); \
                    u4 vw; vw.x = va.x; vw.y = va.y; vw.z = vb.x; vw.w = vb.y; vfr[s2][dt] = __builtin_bit_cast(bf16x8, vw); } } \
            __builtin_amdgcn_sched_barrier(0); \
            _Pragma("unroll") for (int s2 = 0; s2 < 2; ++s2) _Pragma("unroll") for (int dt = 0; dt < 4; ++dt) O[dt] = MFMA16(vfr[s2][dt], pfr[2 * sh + s2], O[dt]); } \
        __builtin_amdgcn_sched_barrier(0); }
#define NA_FINISH() { lsum += __shfl_xor(lsum, 16); lsum += __shfl_xor(lsum, 32); const float inv = 1.0f / lsum; \
        bf16* op = c.CAT() + (size_t)(qrow0 + ql) * D + h * 64 + 4 * kg; \
        _Pragma("unroll") for (int dt = 0; dt < 4; ++dt) { u2 o; o.x = pk2(O[dt][0] * inv, O[dt][1] * inv); o.y = pk2(O[dt][2] * inv, O[dt][3] * inv); *(u2*)(op + dt * 16) = o; } }
    if (lat) {
        const int c0 = min(max(16 * g - 8, 0), 32), cq = 16 * g + ql, cs = min(max(cq - 8, 0), 48);
        bool vld[8];
#pragma unroll
        for (int i = 0; i < 8; ++i) vld[i] = (unsigned)(c0 + 16 * (i >> 2) + 4 * kg + (i & 3) - cs) < 16u;
        bf16x8 kf[8][2];
        int rs = min(max(r - 4, 0), 56);
        const unsigned loff = (unsigned)(ql * NP + kg * 8) * 2u;
        NA_LOADK(0, rs)
#define NA_TASK(FIRST) { \
            const LAS float* rpl = RPB + ((rs - r + 7) * 31 + (c0 + 4 * kg - cq + 15)); \
            const int rsn = min(max(r - 2, 0), 56); \
            float m = -INFINITY, lsum = 0.f; \
            f32x4 O[4]; \
            _Pragma("unroll") for (int dt = 0; dt < 4; ++dt) O[dt] = (f32x4){0.f, 0.f, 0.f, 0.f}; \
            NA_CHUNK(2, ) \
            NA_CHUNK(0, NA_LOADK(1, rs)) \
            NA_CHUNK(3, ) \
            NA_CHUNK(1, if (FIRST) { NA_LOADK(0, rsn) const bf16* qp = P + (size_t)(qrow0 + 128 + ql) * NP + PC_NAQ + h * 64 + kg * 8; qf0 = *(const bf16x8*)qp; qf1 = *(const bf16x8*)(qp + 32); }) \
            NA_FINISH() \
            r += 2; rs = rsn; qrow0 += 128; }
        NA_TASK(1)
        NA_TASK(0)
#undef NA_TASK
    } else {
        const int rs = 0, c0 = 0; const LAS float* rpl = RPB; const bool vld[8] = {true, true, true, true, true, true, true, true};
        float m = -INFINITY, lsum = 0.f;
        f32x4 O[4];
#pragma unroll
        for (int dt = 0; dt < 4; ++dt) O[dt] = (f32x4){0.f, 0.f, 0.f, 0.f};
        bf16x8 kf[8][2];
        NA_CHUNK(2, ) NA_CHUNK(3, )
        NA_FINISH()
    }
#undef NA_LOADK
#undef NA_QK_G
#undef NA_QK_L
#undef NA_CHUNK
#undef NA_FINISH
}
#ifndef TPROBE
#define TPROBE -1
#endif
#define TP_MARK(k) do { if (TPROBE >= 0 && l == 0 && c.tid == 0) atomicMax(c.ctl() + CW_TP + 64 * (k), (unsigned)(wall_clock64() - tp0)); } while (0)
__device__ __forceinline__ void ph_scan_na3(const Ctx& c, int l) {
    const unsigned long long tp0 = TPROBE >= 0 ? wall_clock64() : 0ull;
    for (int bt = blockIdx.x; bt < 96; bt += gridDim.x) { const int kind = bt >= 32, bq = kind ? bt - 32 : bt;
        const int dir = kind ? (bq >> 5) & 1 : (bq >> 4) & 1, b = kind ? (bq >> 4) & 1 : (bq >> 3) & 1, h = kind ? (bq >> 2) & 3 : (bq >> 1) & 3, eh = kind ? bq & 3 : bq & 1;
        if (kind == 0) { gla_scan3(c, b, h, dir, eh); __syncthreads(); TP_MARK(0); }
        else { gdn_scan2<0>(c, b, h, dir, eh); __syncthreads(); TP_MARK(1); } }
    const int nunit = 512 + (l == 0 ? 64 : 0);
    int* sh = (int*)(c.lds + MISC_OFF + 64);
    for (;;) {
        __syncthreads();
        if (c.tid == 0) *sh = (int)atomicAdd(c.ctl() + CW_NAQ + 64 * (l + 2 * c.rep), 1u);
        __syncthreads();
        const int u = __builtin_amdgcn_readfirstlane(*sh);
        if (u >= nunit) break;
        if (TPROBE == 3 && l == 0 && u == 0) { const unsigned long long t1 = wall_clock64(); na_unit(c, l, u); __syncthreads(); if (c.tid == 0) atomicMax(c.ctl() + CW_TP + 64 * 3, (unsigned)(wall_clock64() - t1)); }
#ifndef NO_NA
        else na_unit(c, l, u);
#endif
    }
    TP_MARK(2);
}
constexpr int NPH_LAYER = 12, NPHASES = 2 + 2 * NPH_LAYER;
__global__ void __launch_bounds__(NTHREADS, 2) fwd(Params p) {
    extern __shared__ __attribute__((aligned(16))) unsigned char lds[];
    Ctx cb;
    cb.lds = lds; cb.tid = threadIdx.x; cb.lane = cb.tid & 63; cb.wave = __builtin_amdgcn_readfirstlane(cb.tid >> 6);
    cb.gw = blockIdx.x * NWAVES + cb.wave; cb.ngw = gridDim.x * NWAVES;
    cb.kp = (KParams)__builtin_amdgcn_kernarg_segment_ptr(); cb.ws = p.ws;
    LAS unsigned char* ldsl = (LAS unsigned char*)lds;
    volatile LAS unsigned* MISC = (volatile LAS unsigned*)(ldsl + MISC_OFF);
    if (cb.tid < 64) MISC[cb.tid] = 0u;
    __syncthreads();
    const int lo = p.ph_lo, hi = p.ph_hi;
    XcdBarrier bar; bar.bar = cb.ctl() + CW_BAR; bar.x = 0; bar.st = MISC;
    if (hi - lo > 1) bar = xcd_barrier_post(cb.ctl() + CW_BAR, MISC);
#ifndef REPMASK
#define REPMASK 0
#endif
#ifndef PHMASK
#define PHMASK 0xffff
#endif
#define RUN(ty, k, ...) do { if constexpr (((PHMASK) >> (ty)) & 1) { if (lo <= (k) && (k) < hi) for (int rep_ = 0; rep_ < ((((REPMASK) >> (ty)) & 1) ? 2 : 1); ++rep_) { Ctx c = cb; c.rep = rep_; asm volatile("" : "+s"(c.ws)); asm volatile("" : "+s"(c.kp)); asm volatile("" : "+v"(c.tid)); c.lane = c.tid & 63; c.wave = __builtin_amdgcn_readfirstlane(c.tid >> 6); c.gw = blockIdx.x * NWAVES + c.wave; __VA_ARGS__; if ((k) + 1 < hi || rep_ == 0 && ((((REPMASK) >> (ty)) & 1))) xcd_barrier(bar); } } } while (0)
    RUN(0, 0, ph_prologue(c));
    for (int l = 0; l < 2; ++l) {
        const int pb = 1 + NPH_LAYER * l;
        RUN(1, pb + 0, ph_norm1(c, l));
        RUN(2, pb + 1, { pg8::Gemm g{c.NX(), c.WIN() + (size_t)l * NP * D, MROWS, NP, D}; pg8::StaticOrder S; S.init(MROWS, NP, (int)gridDim.x, (int)blockIdx.x); EpiP E{c.P(), c.PS()};
                      pg8::gemm_phase<EpiP, pg8::StaticOrder>(ldsl, g, S, E, nullptr); });
        RUN(3, pb + 2, ph_prep(c, l));
        RUN(4, pb + 3, ph_gdn_chunk(c, l));
        RUN(5, pb + 4, ph_scan_na3(c, l));
        RUN(6, pb + 5, ph_combine2(c, l));
        RUN(7, pb + 6, { pg8::Gemm g{c.CAT(), c.WOUT() + (size_t)l * D * D, MROWS, D, D}; pg8::StaticOrder S; S.init(l == 0 ? MROWS : ML, D, (int)gridDim.x, (int)blockIdx.x); EpiResid E{c.x(), c.ctxin(), c.MOD(), c.HX(), l};
                      pg8::gemm_phase<EpiResid, pg8::StaticOrder>(ldsl, g, S, E, nullptr); });
        RUN(8, pb + 7, ph_norm2_router(c, l));
        RUN(9, pb + 8, ph_topk(c, l));
        RUN(10, pb + 9, ph_gather(c, l));
        RUN(11, pb + 10, { MoeOrder S{l == 0 ? 5 : 4, 16, (int)gridDim.x, (int)blockIdx.x};
                      if (!(((F8MASK) >> l) & 1)) { pg8::Gemm g{c.AMOE(), c.WGU() + (size_t)l * NE * 4096 * D, NE * ESLOT, NE * 4096, D}; EpiSwiglu E{c.HID()};
                          pg8::gemm_phase<EpiSwiglu, MoeOrder>(ldsl, g, S, E, nullptr); }
                      else { pg8::Gemm g{c.AMOE(), c.WGU() + (size_t)l * NE * 4096 * D, NE * ESLOT, NE * 4096, D / 2}; EpiSwiglu8 E{(unsigned char*)c.HID()};
                          pg8::gemm_phase<EpiSwiglu8, MoeOrder, false, true>(ldsl, g, S, E, nullptr); } });
        RUN(12, pb + 11, { MoeOrder S{l == 0 ? 5 : 4, 8, (int)gridDim.x, (int)blockIdx.x}; EpiY E{c.Y()};
                      if (!(((F8MASK) >> l) & 1)) { pg8::Gemm g{c.HID(), c.WDN() + (size_t)l * NE * D * FF, NE * ESLOT, NE * D, FF};
                          pg8::gemm_phase<EpiY, MoeOrder>(ldsl, g, S, E, nullptr); }
                      else { pg8::Gemm g{c.HID(), c.WDN() + (size_t)l * NE * D * FF, NE * ESLOT, NE * D, FF / 2};
                          pg8::gemm_phase<EpiY, MoeOrder, false, true>(ldsl, g, S, E, nullptr); } });
    }
    RUN(13, NPHASES - 1, ph_final(c));
#undef RUN
}

extern "C" void kernel_launch(void* const* d_in, const int* in_sizes, int n_in, void* d_out, int out_size, void* d_ws, size_t ws_size, hipStream_t stream) {
    static int grid = 0;
    if (grid == 0) {
        if (n_in != 23 || ws_size < WS_END) { fprintf(stderr, "kernel_launch: need 23 inputs and %zu bytes of workspace (got %d, %zu)\n", (size_t)WS_END, n_in, ws_size); grid = -1; return; }
        int dev = 0, cus = 0, per_cu = 0;
        if (hipGetDevice(&dev) != hipSuccess || hipDeviceGetAttribute(&cus, hipDeviceAttributeMultiprocessorCount, dev) != hipSuccess) { grid = -1; return; }
        if (hipFuncSetAttribute((const void*)fwd, hipFuncAttributeMaxDynamicSharedMemorySize, LDS_BYTES) != hipSuccess) { fprintf(stderr, "kernel_launch: hipFuncSetAttribute failed\n"); grid = -1; return; }
        if (hipOccupancyMaxActiveBlocksPerMultiprocessor(&per_cu, (const void*)fwd, NTHREADS, LDS_BYTES) != hipSuccess || per_cu < 1) { fprintf(stderr, "kernel_launch: occupancy query says %d\n", per_cu); per_cu = 1; }
        grid = cus;
    }
    if (grid <= 0) return;
    hipMemsetAsync((char*)d_ws + WS_CTL, 0, CTL_BYTES, stream);
    Params p; memset(&p, 0, sizeof(p));
    for (int i = 0; i < 23; ++i) p.in[i] = (GASP const float*)d_in[i];
    p.out = (GASP float*)d_out; p.ws = (GASP unsigned char*)d_ws;
#if ONE_LAUNCH
    p.ph_lo = 0; p.ph_hi = NPHASES;
    hipLaunchKernelGGL(fwd, dim3(grid), dim3(NTHREADS), LDS_BYTES, stream, p);
#else
    for (int k = 0; k < NPHASES; ++k) { p.ph_lo = k; p.ph_hi = k + 1; hipLaunchKernelGGL(fwd, dim3(grid), dim3(NTHREADS), LDS_BYTES, stream, p); }
#endif
}
```

```cpp
#include <hip/hip_runtime.h>
#include <cstdio>
#include <cstdint>
#include <cstring>

#ifndef F8MASK
#define F8MASK 3
#endif
#ifndef L2PROBE
#define L2PROBE 0
#endif
#ifndef SUBREP
#define SUBREP 0
#endif
#ifndef ONE_LAUNCH
#define ONE_LAUNCH 1
#endif

#define LAS __attribute__((address_space(3)))
typedef unsigned short bf16;
typedef float f4 __attribute__((ext_vector_type(4)));
typedef unsigned u4 __attribute__((ext_vector_type(4)));
typedef unsigned u2 __attribute__((ext_vector_type(2)));

constexpr int D = 2048, NB = 2, SEQ = 4096, CTX = 256;
constexpr int ML = NB * SEQ, MC = NB * CTX, MROWS = ML + MC;
constexpr int INW = 6704, NP = 6912;
constexpr int NE = 16, FF = 2048, ESLOT = 1280;
constexpr int MODW = 6 * D;
constexpr int PC_NAQ = 0, PC_NAK = 1024, PC_NAV = 2048, PC_GLQ = 3072, PC_GLK = 3328, PC_GLV = 3584, PC_GLG = 4096, PC_GDQ = 4608, PC_GDZ = 6144, PC_SMALL = 6656;
constexpr int NTHREADS = 512, NWAVES = 8;
constexpr int LDS_BYTES = 163840, MISC_OFF = LDS_BYTES - 256;

constexpr size_t al256(size_t x) { return (x + 255) & ~(size_t)255; }
constexpr size_t WS_CTL = 0, CTL_BYTES = 1u << 20;
constexpr size_t WS_MOD = WS_CTL + CTL_BYTES;
constexpr size_t WS_ROPE = al256(WS_MOD + (size_t)2 * 3 * MODW * 4);
constexpr size_t WS_WIN = al256(WS_ROPE + 64 * 16 * 2 * 4);
constexpr size_t WS_WOUT = al256(WS_WIN + (size_t)2 * NP * D * 2);
constexpr size_t WS_WGU = al256(WS_WOUT + (size_t)2 * D * D * 2);
constexpr size_t WS_WDN = al256(WS_WGU + (size_t)2 * NE * 2 * FF * D * 2);
constexpr size_t WS_HX = al256(WS_WDN + (size_t)2 * NE * D * FF * 2);
constexpr size_t WS_NX = al256(WS_HX + (size_t)MROWS * D * 4);
constexpr size_t WS_P = al256(WS_NX + (size_t)MROWS * D * 2);
constexpr size_t WS_PS = al256(WS_P + (size_t)MROWS * NP * 2);
constexpr size_t WS_GQKV = al256(WS_PS + (size_t)MROWS * 64 * 4);
constexpr size_t WS_GGB = al256(WS_GQKV + (size_t)MROWS * 1536 * 4);
constexpr size_t WS_LQ = al256(WS_GGB + (size_t)MROWS * 16 * 4);
constexpr size_t WS_LK = al256(WS_LQ + (size_t)MROWS * 256 * 4);
constexpr size_t WS_LA = al256(WS_LK + (size_t)MROWS * 256 * 4);
constexpr size_t WS_OGLA = al256(WS_LA + (size_t)2 * MROWS * 256 * 4);
constexpr size_t WS_OGDN = al256(WS_OGLA + (size_t)2 * MROWS * 512 * 4);
constexpr size_t WS_CAT = al256(WS_OGDN + (size_t)2 * MROWS * 512 * 4);
constexpr size_t WS_AFF = al256(WS_CAT + (size_t)MROWS * D * 2);
constexpr size_t WS_IDX = al256(WS_AFF + (size_t)MROWS * 16 * 4);
constexpr size_t WS_GATE = al256(WS_IDX + (size_t)NE * ESLOT * 4);
constexpr size_t WS_AMOE = al256(WS_GATE + (size_t)NE * ESLOT * 4);
constexpr size_t WS_HID = al256(WS_AMOE + (size_t)NE * ESLOT * D * 2);
constexpr int UDS = 69;
constexpr int NUD = 2 * 4 * UDS * 2;
constexpr size_t WS_GDQP = al256(WS_HID + (size_t)NE * ESLOT * FF * 2);
constexpr size_t WS_GDO0 = al256(WS_GDQP + (size_t)NUD * 64 * 128 * 2);
constexpr size_t WS_GDAP = al256(WS_GDO0 + (size_t)NUD * 64 * 128 * 4);
constexpr size_t WS_GDBM = al256(WS_GDAP + (size_t)NUD * 128 * 128 * 2);
constexpr size_t WS_GDGL = al256(WS_GDBM + (size_t)NUD * 128 * 128 * 4);
constexpr size_t WS_GLQT = al256(WS_GDGL + (size_t)NUD * 4);
constexpr size_t WS_GLKT = al256(WS_GLQT + (size_t)NUD * 4096 * 2);
constexpr size_t WS_GLKH = al256(WS_GLKT + (size_t)NUD * 4096 * 2);
constexpr size_t WS_GLVT = al256(WS_GLKH + (size_t)NUD * 4096 * 2);
constexpr size_t WS_GLDEC = al256(WS_GLVT + (size_t)NUD * 8192 * 2);
constexpr size_t WS_GDST = al256(WS_GLDEC + (size_t)NUD * 64 * 4);
constexpr size_t WS_GLST = al256(WS_GDST + (size_t)NUD * 16384 * 2);
constexpr size_t WS_SLOTOF = al256(WS_GLST + (size_t)NUD * 8192 * 2);
constexpr size_t WS_Y = al256(WS_SLOTOF + (size_t)NE * MROWS * 4);
constexpr size_t WS_END = al256(WS_Y + (size_t)NE * ESLOT * D * 2);
constexpr int CW_BAR = 1024;
constexpr int CW_PROQ = 7040;
constexpr int CW_TP = 9216;
constexpr int CW_CHQ = 7680;
constexpr int CW_NAQ = 8192;

__device__ __forceinline__ float bf2f(unsigned b) { return __uint_as_float(b << 16); }
__device__ __forceinline__ unsigned f2bf(float f) { unsigned u = __float_as_uint(f); return (u + 0x7fffu + ((u >> 16) & 1u)) >> 16; }
typedef __bf16 bf2_t __attribute__((ext_vector_type(2)));
typedef float f2_t __attribute__((ext_vector_type(2)));
__device__ __forceinline__ unsigned pk2(float lo, float hi) { const bf2_t r = __builtin_convertvector((f2_t){lo, hi}, bf2_t); return __builtin_bit_cast(unsigned, r); }
__device__ __forceinline__ float wave_sum(float v) {
#pragma unroll
    for (int o = 1; o < 64; o <<= 1) v += __shfl_xor(v, o);
    return v;
}
__device__ __forceinline__ float wave_max(float v) {
#pragma unroll
    for (int o = 1; o < 64; o <<= 1) v = fmaxf(v, __shfl_xor(v, o));
    return v;
}
__device__ __forceinline__ float silu_f(float x) { return x * __builtin_amdgcn_rcpf(1.f + __expf(-x)); }
__device__ __forceinline__ float softplus_f(float x) { return x > 20.f ? x : log1pf(__expf(x)); }
__device__ __forceinline__ float logsigmoid_f(float z) { return fminf(z, 0.f) - __logf(1.f + __expf(-fabsf(z))); }
#define LDS_WAIT() asm volatile("s_waitcnt lgkmcnt(0)" ::: "memory")
#define XB_TMO      128
#define XB_XCNT(j)  (256  + 64 * (j))
#define XB_XSUB(j)  (1280 + 64 * (j))
#define XB_XGEN(j)  (2304 + 64 * (j))
#define XB_TOP      3328
#define XB_TOPGEN   3392
#define XCD_BAR_WORDS 3456
#define XB_SPIN_CAP (1u << 20)

__device__ __forceinline__ unsigned xb_ld(unsigned* p)              { return __hip_atomic_load(p, __ATOMIC_RELAXED, __HIP_MEMORY_SCOPE_AGENT); }
__device__ __forceinline__ unsigned xb_add(unsigned* p, unsigned v) { return __hip_atomic_fetch_add(p, v, __ATOMIC_RELAXED, __HIP_MEMORY_SCOPE_AGENT); }
__device__ __forceinline__ unsigned xb_xcc_id() { return (unsigned)__builtin_amdgcn_s_getreg((3 << 11) | 20) & 0xFu; }
#define XB_SPIN(cond, bar) do { unsigned _sp = 0; while (cond) { __builtin_amdgcn_s_sleep(1); \
    if ((++_sp & 255u) == 0u) { if (xb_ld(&(bar)[XB_TMO])) break; if (_sp > XB_SPIN_CAP) { atomicAdd(&(bar)[XB_TMO], 1u); break; } } } } while (0)

struct XcdBarrier {
    unsigned* bar; unsigned x;
    volatile LAS unsigned* st;
};

__device__ __forceinline__ XcdBarrier xcd_barrier_post(unsigned* bar, volatile LAS unsigned* st) {
    XcdBarrier b; b.bar = bar; b.x = xb_xcc_id(); b.st = st;
    if (threadIdx.x == 0) (void)xb_add(&bar[XB_XCNT(b.x)], 1u);
    return b;
}
__device__ __forceinline__ void xcd_barrier_complete(unsigned* bar, unsigned x, unsigned& nloc, unsigned& nx) {
    const unsigned G = gridDim.x * gridDim.y * gridDim.z;
    unsigned sum, cnt, mine, sp = 0u;
    for (;;) {
        sum = 0u; cnt = 0u; mine = 0u;
#pragma unroll
        for (unsigned j = 0; j < 16; ++j) { const unsigned c = xb_ld(&bar[XB_XCNT(j)]); sum += c; cnt += (c > 0u) ? 1u : 0u; mine = (j == x) ? c : mine; }
        if (sum == G) break;
        __builtin_amdgcn_s_sleep(1);
        if ((++sp & 255u) == 0u) { if (xb_ld(&bar[XB_TMO])) break; if (sp > XB_SPIN_CAP) { atomicAdd(&bar[XB_TMO], 1u); break; } }
    }
    nloc = mine > 0u ? mine : 1u; nx = cnt > 0u ? cnt : 1u;
}

__device__ __forceinline__ void xcd_barrier(const XcdBarrier& b) {
    asm volatile("s_waitcnt vmcnt(0)" ::: "memory");
    __syncthreads();
    if (threadIdx.x == 0) {
        unsigned* bar = b.bar;
        __builtin_amdgcn_s_waitcnt(0);
        unsigned nloc = b.st[0], nx = b.st[1];
        if (nloc == 0u) { xcd_barrier_complete(bar, b.x, nloc, nx); b.st[0] = nloc; b.st[1] = nx; }
        const unsigned old = xb_add(&bar[XB_XSUB(b.x)], 1u);
        const unsigned gen = old / nloc;
        if (old + 1u == (gen + 1u) * nloc) {
            __builtin_amdgcn_fence(__ATOMIC_RELEASE, "agent");
            asm volatile("s_waitcnt vmcnt(0)" ::: "memory");
            const unsigned og = xb_add(&bar[XB_TOP], 1u);
            const unsigned tg = og / nx;
            if (og + 1u == (tg + 1u) * nx) xb_add(&bar[XB_TOPGEN], 1u);
            else XB_SPIN(xb_ld(&bar[XB_TOPGEN]) == tg, bar);
            __builtin_amdgcn_fence(__ATOMIC_ACQUIRE, "agent");
            xb_add(&bar[XB_XGEN(b.x)], 1u);
            asm volatile("s_waitcnt vmcnt(0)" ::: "memory");
        } else {
            XB_SPIN(xb_ld(&bar[XB_XGEN(b.x)]) == gen, bar);
            __builtin_amdgcn_fence(__ATOMIC_ACQUIRE, "agent");
            asm volatile("s_waitcnt vmcnt(0)" ::: "memory");
        }
    }
    __syncthreads();
}

namespace pg8 {
#define PG8_LAS __attribute__((address_space(3)))
typedef unsigned short bf16_t;
typedef short bf16x8 __attribute__((ext_vector_type(8)));
typedef float f32x4 __attribute__((ext_vector_type(4)));
typedef unsigned u32x4 __attribute__((ext_vector_type(4)));
constexpr int BM = 256, BK = 64, HALF = 128, HTB = HALF * BK * 2  , STAGE_BYTES = 8 * HTB, NXCD = 8, WGM = 8;

__host__ __device__ __forceinline__ int lds_byte(int r, int c) { const int st = (r >> 4) * 2 + (c >> 5), rr = r & 15, cc = c & 31, ob = rr * 64 + cc * 2; return st * 1024 + (ob ^ (((ob >> 9) & 1) << 5)); }
__host__ __device__ __forceinline__ void stage_rc(int b, int& R, int& C) { const int st = b / 1024, sb = b % 1024, swz = sb ^ (((sb >> 9) & 1) << 5); R = (st >> 1) * 16 + swz / 64; C = (st & 1) * 32 + (swz % 64) / 2; }
__host__ __device__ __forceinline__ int perm32(int rho) { const int n = rho >> 4, i = rho & 15; return 8 * (i >> 2) + 4 * n + (i & 3); }

struct Unit { int pm, pn; };
struct Gemm { const bf16_t* A; const bf16_t* Bt; int M, N, K; };
struct StaticOrder {
    int nM, nN, nwg, G, c;
    __host__ __device__ void init(int M, int N, int G_, int c_) { nM = M / BM; nN = N / BM; nwg = nM * nN; G = G_; c = c_; }
    __host__ __device__ bool next(int i, Unit& u) const {
        const long L = (long)i * G + c; if (L >= nwg) return false;
        int wgid = (int)L; { const int q = nwg / NXCD, r = nwg % NXCD, xcd = wgid % NXCD, off = wgid / NXCD; wgid = (xcd < r ? xcd * (q + 1) : r * (q + 1) + (xcd - r) * q) + off; }
        const int nig = WGM * nN, gid = wgid / nig, fm = gid * WGM, gsz = (nM - fm) < WGM ? (nM - fm) : WGM;
        u.pm = fm + ((wgid % nig) % gsz); u.pn = (wgid % nig) / gsz; return true;
    }
    __device__ __forceinline__ void a_ready(const Unit&) const {}
    __device__ __forceinline__ void done(const Unit&) const {}
};
__device__ __forceinline__ unsigned cvt_pk_bf16(float lo, float hi) { unsigned r; asm volatile("v_cvt_pk_bf16_f32 %0, %1, %2" : "=v"(r) : "v"(lo), "v"(hi)); return r; }

typedef int v8i32 __attribute__((ext_vector_type(8)));
typedef int v4i32 __attribute__((ext_vector_type(4)));
constexpr int F8_WSCALE_LOG2 = 6;
template <class Epi, class Sched, bool STAMP = false, bool F8 = false>
__device__ __forceinline__ void gemm_phase(PG8_LAS unsigned char* lds, const Gemm g, const Sched& S, const Epi& E, unsigned long long* stamps) {
    int tid_ = threadIdx.x; asm volatile("" : "+v"(tid_));
    const int tid = tid_, wid = __builtin_amdgcn_readfirstlane(tid >> 6), lane = tid & 63, wr = wid >> 2, wc = wid & 3, fr = lane & 15, fq = lane >> 4;
    const int K = g.K, nt = K / BK;
    const int f8_sw = 127 - F8_WSCALE_LOG2, f8_s1 = 127;
    int ts_lo = 0, ts_hi = 0, nts = 0; const unsigned long long rt_entry = STAMP ? (unsigned long long)wall_clock64() : 0ull;
#define PG8_STAMP() do { if (STAMP && wid == 0 && nts < 64) { const unsigned long long _c = (unsigned long long)clock64(); \
        ts_lo = (lane == nts) ? (int)(unsigned)_c : ts_lo; ts_hi = (lane == nts) ? (int)(unsigned)(_c >> 32) : ts_hi; ++nts; } } while (0)
    PG8_STAMP();
    unsigned voffA[2], voffB[2];
#pragma unroll
    for (int i = 0; i < 2; ++i) { int R, C; stage_rc(tid * 16 + i * 8192, R, C); const int Rb = Epi::PERM ? ((R & ~31) + perm32(R & 31)) : R;
        voffA[i] = (unsigned)(R * K + C) * 2u; voffB[i] = (unsigned)(Rb * K + C) * 2u; }
    const size_t kstep = (size_t)(BK * 2);
    const size_t hstep = (size_t)HALF * K * 2;
    const size_t tstep = 2 * hstep;
    const unsigned ldsw = (unsigned)wid * 1024u;
    const int aoff = lds_byte(wr * 64 + fr, fq * 8), boff = lds_byte(wc * 32 + fr, fq * 8);
#define PG8_SA(b, h) (((b) * 2 + (h)) * HTB)
#define PG8_SB(b, h) ((4 + (b) * 2 + (h)) * HTB)
#define PG8_STAGE(bufoff, gbase, voff) do { _Pragma("unroll") for (int _i = 0; _i < 2; ++_i) \
        __builtin_amdgcn_global_load_lds((const unsigned*)((const char*)(gbase) + (voff)[_i]), (PG8_LAS unsigned*)(lds + (bufoff) + ldsw + _i * 8192), 16, 0, 0); } while (0)
#define PG8_LDA(dst, b, h) do { _Pragma("unroll") for (int m = 0; m < 4; ++m) _Pragma("unroll") for (int k = 0; k < 2; ++k) dst[m][k] = *(const PG8_LAS bf16x8*)(lds + PG8_SA(b, h) + aoff + m * 2048 + k * 1024); } while (0)
#define PG8_LDB(dst, b, h) do { _Pragma("unroll") for (int n = 0; n < 2; ++n) _Pragma("unroll") for (int k = 0; k < 2; ++k) dst[n][k] = *(const PG8_LAS bf16x8*)(lds + PG8_SB(b, h) + boff + n * 2048 + k * 1024); } while (0)
#define PG8_MMA(ai, bj, At, Bt) do { __builtin_amdgcn_s_setprio(1); \
        if constexpr (!F8) { _Pragma("unroll") for (int m = 0; m < 4; ++m) _Pragma("unroll") for (int n = 0; n < 2; ++n) _Pragma("unroll") for (int k = 0; k < 2; ++k) \
            acc[ai][bj][m][n] = __builtin_amdgcn_mfma_f32_16x16x32_bf16(Bt[n][k], At[m][k], acc[ai][bj][m][n], 0, 0, 0); } \
        else { _Pragma("unroll") for (int m = 0; m < 4; ++m) _Pragma("unroll") for (int n = 0; n < 2; ++n) \
            asm volatile("v_mfma_scale_f32_16x16x128_f8f6f4 %0, %1, %2, %0, %3, %4 op_sel_hi:[0,0,0]" : "+v"(acc[ai][bj][m][n]) \
                : "v"(__builtin_shufflevector(__builtin_bit_cast(v4i32, Bt[n][0]), __builtin_bit_cast(v4i32, Bt[n][1]), 0, 1, 2, 3, 4, 5, 6, 7)), \
                  "v"(__builtin_shufflevector(__builtin_bit_cast(v4i32, At[m][0]), __builtin_bit_cast(v4i32, At[m][1]), 0, 1, 2, 3, 4, 5, 6, 7)), "v"(f8_sw), "v"(f8_s1)); } \
        __builtin_amdgcn_s_setprio(0); } while (0)
#define PG8_WAIT_V(n) asm volatile("s_waitcnt vmcnt(" #n ")" ::: "memory")
#define PG8_WAIT_L(n) asm volatile("s_waitcnt lgkmcnt(" #n ")" ::: "memory")
#define PG8_BAR __builtin_amdgcn_s_barrier()
#define PG8_SCHED __builtin_amdgcn_sched_barrier(0)
    Unit cur, nxt; int ui = 0;
    if (!S.next(0, cur)) return;
    f32x4 acc[2][2][4][2];
#pragma unroll
    for (int a = 0; a < 2; ++a)
#pragma unroll
        for (int b = 0; b < 2; ++b)
#pragma unroll
            for (int m = 0; m < 4; ++m)
#pragma unroll
                for (int n = 0; n < 2; ++n) acc[a][b][m][n] = (f32x4){0.f, 0.f, 0.f, 0.f};
    bf16x8 At[4][2], B0[2][2], B1[2][2];
    const char* cA = (const char*)g.A + (size_t)cur.pm * tstep; const char* cB = (const char*)g.Bt + (size_t)cur.pn * tstep;
    S.a_ready(cur);
    PG8_STAGE(PG8_SB(0, 0), cB, voffB); PG8_STAGE(PG8_SA(0, 0), cA, voffA); PG8_STAGE(PG8_SB(0, 1), cB + hstep, voffB); PG8_STAGE(PG8_SA(0, 1), cA + hstep, voffA);
    if (wr == 1) PG8_BAR;
    PG8_WAIT_V(4); PG8_BAR;
    PG8_STAGE(PG8_SB(1, 0), cB + kstep, voffB); PG8_STAGE(PG8_SA(1, 0), cA + kstep, voffA); PG8_STAGE(PG8_SB(1, 1), cB + hstep + kstep, voffB);
    PG8_WAIT_V(6); PG8_BAR;
    PG8_STAMP();
    for (;;) {
        const bool has_next = S.next(ui + 1, nxt);
        const char* nA = has_next ? (const char*)g.A + (size_t)nxt.pm * tstep : cA; const char* nB = has_next ? (const char*)g.Bt + (size_t)nxt.pn * tstep : cB;
        for (int t = 0; t < nt; t += 2) {
            const bool last = (t == nt - 2);
            const char* a1 = cA + (size_t)(t + 1) * kstep;
            const char* a2 = last ? nA : cA + (size_t)(t + 2) * kstep; const char* b2 = last ? nB : cB + (size_t)(t + 2) * kstep;
            const char* a3 = a2 + kstep; const char* b3 = b2 + kstep;
            if (last && has_next) S.a_ready(nxt);
            PG8_LDB(B0, 0, 0); PG8_SCHED; PG8_LDA(At, 0, 0); PG8_STAGE(PG8_SA(1, 1), a1 + hstep, voffA);
            PG8_WAIT_L(8); PG8_BAR; PG8_WAIT_L(0); PG8_MMA(0, 0, At, B0); PG8_BAR; PG8_SCHED;
            PG8_LDB(B1, 0, 1); PG8_STAGE(PG8_SB(0, 0), b2, voffB);
            PG8_BAR; PG8_WAIT_L(0); PG8_MMA(0, 1, At, B1); PG8_BAR;
            PG8_LDA(At, 0, 1); PG8_STAGE(PG8_SA(0, 0), a2, voffA);
            PG8_BAR; PG8_WAIT_L(0); PG8_MMA(1, 0, At, B0); PG8_BAR; PG8_SCHED;
            PG8_STAGE(PG8_SB(0, 1), b2 + hstep, voffB);
            PG8_WAIT_V(6); PG8_BAR; PG8_MMA(1, 1, At, B1); PG8_BAR;
            PG8_LDB(B0, 1, 0); PG8_SCHED; PG8_LDA(At, 1, 0); PG8_STAGE(PG8_SA(0, 1), a2 + hstep, voffA);
            PG8_WAIT_L(8); PG8_BAR; PG8_WAIT_L(0); PG8_MMA(0, 0, At, B0); PG8_BAR; PG8_SCHED;
            PG8_LDB(B1, 1, 1); PG8_STAGE(PG8_SB(1, 0), b3, voffB);
            PG8_BAR; PG8_WAIT_L(0); PG8_MMA(0, 1, At, B1); PG8_BAR;
            PG8_LDA(At, 1, 1); PG8_STAGE(PG8_SA(1, 0), a3, voffA);
            PG8_BAR; PG8_WAIT_L(0); PG8_MMA(1, 0, At, B0); PG8_BAR; PG8_SCHED;
            PG8_STAGE(PG8_SB(1, 1), b3 + hstep, voffB);
            PG8_WAIT_V(6); PG8_BAR; PG8_MMA(1, 1, At, B1); PG8_BAR;
        }
        PG8_STAMP();
        if constexpr (F8) asm volatile("s_nop 15\n\ts_nop 15" ::: "memory");
        if constexpr (!Epi::AFTER_DRAIN) { E(acc, cur, wr, wc, fr, fq); S.done(cur); }
        PG8_STAMP();
        if (!has_next) break;
#pragma unroll
        for (int a = 0; a < 2; ++a)
#pragma unroll
            for (int b = 0; b < 2; ++b)
#pragma unroll
                for (int m = 0; m < 4; ++m)
#pragma unroll
                    for (int n = 0; n < 2; ++n) acc[a][b][m][n] = (f32x4){0.f, 0.f, 0.f, 0.f};
        cur = nxt; cA = nA; cB = nB; ++ui;
    }
    PG8_WAIT_V(0);
    if (wr == 0) PG8_BAR;
    PG8_BAR;
    if constexpr (Epi::AFTER_DRAIN) { E.fused(acc, cur, wr, wc, fr, fq, lds, wid, lane); S.done(cur); }
    PG8_STAMP();
    if (STAMP && wid == 0) { stamps[lane] = lane < nts ? (((unsigned long long)(unsigned)ts_hi << 32) | (unsigned)ts_lo) : 0ull;
        if (lane == 62) stamps[62] = rt_entry; if (lane == 63) stamps[63] = (unsigned long long)wall_clock64(); }
#undef PG8_STAMP
#undef PG8_SA
#undef PG8_SB
#undef PG8_STAGE
#undef PG8_LDA
#undef PG8_LDB
#undef PG8_MMA
#undef PG8_WAIT_V
#undef PG8_WAIT_L
#undef PG8_BAR
#undef PG8_SCHED
}
}

#include <cstdio>
#include <ctime>

#define GASP __attribute__((address_space(1)))
struct Params { GASP const float* in[23]; GASP float* out; GASP unsigned char* ws; int ph_lo, ph_hi; };
typedef const __attribute__((address_space(4))) Params* KParams;
struct Ctx {
    unsigned char* lds; GASP unsigned char* ws; KParams kp;
    int tid, lane, wave, gw, ngw, rep;
    __device__ __forceinline__ const float* x() const { return (const float*)kp->in[0]; }
    __device__ __forceinline__ const float* cvec() const { return (const float*)kp->in[1]; }
    __device__ __forceinline__ const float* ctxin() const { return (const float*)kp->in[2]; }
    __device__ __forceinline__ const float* c_ctx() const { return (const float*)kp->in[3]; }
    __device__ __forceinline__ const float* w_ada() const { return (const float*)kp->in[4]; }
    __device__ __forceinline__ const float* b_ada() const { return (const float*)kp->in[5]; }
    __device__ __forceinline__ const float* norm_mix_w() const { return (const float*)kp->in[6]; }
    __device__ __forceinline__ const float* norm_ffn_w() const { return (const float*)kp->in[7]; }
    __device__ __forceinline__ const float* w_in() const { return (const float*)kp->in[8]; }
    __device__ __forceinline__ const float* w_out() const { return (const float*)kp->in[9]; }
    __device__ __forceinline__ const float* na_rpb() const { return (const float*)kp->in[10]; }
    __device__ __forceinline__ const float* gla_gate_w() const { return (const float*)kp->in[11]; }
    __device__ __forceinline__ const float* gla_gate_b() const { return (const float*)kp->in[12]; }
    __device__ __forceinline__ const float* gla_norm_w() const { return (const float*)kp->in[13]; }
    __device__ __forceinline__ const float* gdn_conv_w() const { return (const float*)kp->in[14]; }
    __device__ __forceinline__ const float* gdn_a_log() const { return (const float*)kp->in[15]; }
    __device__ __forceinline__ const float* gdn_dt_bias() const { return (const float*)kp->in[16]; }
    __device__ __forceinline__ const float* gdn_norm_w() const { return (const float*)kp->in[17]; }
    __device__ __forceinline__ const float* w_router() const { return (const float*)kp->in[18]; }
    __device__ __forceinline__ const float* w_exp_gate() const { return (const float*)kp->in[19]; }
    __device__ __forceinline__ const float* w_exp_up() const { return (const float*)kp->in[20]; }
    __device__ __forceinline__ const float* w_exp_down() const { return (const float*)kp->in[21]; }
    __device__ __forceinline__ const float* final_norm_w() const { return (const float*)kp->in[22]; }
    __device__ __forceinline__ float* out() const { return (float*)kp->out; }
    __device__ __forceinline__ float* MOD() const { return (float*)(ws + WS_MOD); }
    __device__ __forceinline__ float* ROPE() const { return (float*)(ws + WS_ROPE); }
    __device__ __forceinline__ float* HX() const { return (float*)(ws + WS_HX); }
    __device__ __forceinline__ float* PS() const { return (float*)(ws + WS_PS); }
    __device__ __forceinline__ float* GQKV() const { return (float*)(ws + WS_GQKV); }
    __device__ __forceinline__ float* GGB() const { return (float*)(ws + WS_GGB); }
    __device__ __forceinline__ float* LQ() const { return (float*)(ws + WS_LQ); }
    __device__ __forceinline__ float* LK() const { return (float*)(ws + WS_LK); }
    __device__ __forceinline__ float* LA() const { return (float*)(ws + WS_LA); }
    __device__ __forceinline__ float* OGLA() const { return (float*)(ws + WS_OGLA); }
    __device__ __forceinline__ float* OGDN() const { return (float*)(ws + WS_OGDN); }
    __device__ __forceinline__ float* AFF() const { return (float*)(ws + WS_AFF); }
    __device__ __forceinline__ float* GATEV() const { return (float*)(ws + WS_GATE); }
    __device__ __forceinline__ bf16* WIN() const { return (bf16*)(ws + WS_WIN); }
    __device__ __forceinline__ bf16* WOUT() const { return (bf16*)(ws + WS_WOUT); }
    __device__ __forceinline__ bf16* WGU() const { return (bf16*)(ws + WS_WGU); }
    __device__ __forceinline__ bf16* WDN() const { return (bf16*)(ws + WS_WDN); }
    __device__ __forceinline__ bf16* NX() const { return (bf16*)(ws + WS_NX); }
    __device__ __forceinline__ bf16* P() const { return (bf16*)(ws + WS_P); }
    __device__ __forceinline__ bf16* CAT() const { return (bf16*)(ws + WS_CAT); }
    __device__ __forceinline__ bf16* AMOE() const { return (bf16*)(ws + WS_AMOE); }
    __device__ __forceinline__ bf16* HID() const { return (bf16*)(ws + WS_HID); }
    __device__ __forceinline__ int* IDX() const { return (int*)(ws + WS_IDX); }
    __device__ __forceinline__ unsigned* ctl() const { return (unsigned*)(ws + WS_CTL); }
    __device__ __forceinline__ int* SLOTOF() const { return (int*)(ws + WS_SLOTOF); }
    __device__ __forceinline__ bf16* Y() const { return (bf16*)(ws + WS_Y); }
    __device__ __forceinline__ bf16* GLQT() const { return (bf16*)(ws + WS_GLQT); }
    __device__ __forceinline__ bf16* GLKT() const { return (bf16*)(ws + WS_GLKT); }
    __device__ __forceinline__ bf16* GLKH() const { return (bf16*)(ws + WS_GLKH); }
    __device__ __forceinline__ bf16* GLVT() const { return (bf16*)(ws + WS_GLVT); }
    __device__ __forceinline__ float* GLDEC() const { return (float*)(ws + WS_GLDEC); }
    __device__ __forceinline__ bf16* GDST() const { return (bf16*)(ws + WS_GDST); }
    __device__ __forceinline__ bf16* GLST() const { return (bf16*)(ws + WS_GLST); }
    __device__ __forceinline__ bf16* GDQP() const { return (bf16*)(ws + WS_GDQP); }
    __device__ __forceinline__ bf16* GDO0() const { return (bf16*)(ws + WS_GDO0); }
    __device__ __forceinline__ bf16* GDAP() const { return (bf16*)(ws + WS_GDAP); }
    __device__ __forceinline__ bf16* GDBM() const { return (bf16*)(ws + WS_GDBM); }
    __device__ __forceinline__ float* GDGL() const { return (float*)(ws + WS_GDGL); }
};
__device__ __forceinline__ int modrow(int row) { return row < ML ? (row >> 12) : 2; }
__device__ __forceinline__ const float* src_row_ptr(const Ctx& c, int l, int row) {
    if (l == 0) return row < ML ? c.x() + (size_t)row * D : c.ctxin() + (size_t)(row - ML) * D;
    return c.HX() + (size_t)row * D;
}

__device__ __forceinline__ void transpose_item(const float* W, int ldw, int k0, int sn0, int nvalid, bf16* dst, int K, float* scr, int lane) {
    { const int c4 = lane & 7, rr = lane >> 3; const float* wp = W + (size_t)(k0 + rr) * ldw + sn0 + 4 * c4; const bool ok = 4 * c4 < nvalid;
        f4 v[8];
#pragma unroll
        for (int i = 0; i < 8; ++i) v[i] = ok ? *(const f4*)(wp + (size_t)(8 * i) * ldw) : (f4){0.f, 0.f, 0.f, 0.f};
#pragma unroll
        for (int i = 0; i < 8; ++i) { float* sp = scr + (rr + 8 * i) * 33 + 4 * c4; sp[0] = v[i].x; sp[1] = v[i].y; sp[2] = v[i].z; sp[3] = v[i].w; } }
    LDS_WAIT();
    const int cc = lane & 7;
#pragma unroll
    for (int j = 0; j < 4; ++j) { const int n = (lane >> 3) + 8 * j; const float* s = scr + (8 * cc) * 33 + n;
        u4 o; o.x = pk2(s[0 * 33], s[1 * 33]); o.y = pk2(s[2 * 33], s[3 * 33]); o.z = pk2(s[4 * 33], s[5 * 33]); o.w = pk2(s[6 * 33], s[7 * 33]);
        *(u4*)(dst + (size_t)n * K + 8 * cc) = o; }
    LDS_WAIT();
}
__device__ __forceinline__ float sat_fp8(float x) { return __builtin_amdgcn_fmed3f(x, -448.0f, 448.0f); }
__device__ __forceinline__ unsigned pk4_fp8(float a, float b, float cc, float d) { unsigned w = 0u; w = __builtin_amdgcn_cvt_pk_fp8_f32(sat_fp8(a), sat_fp8(b), w, false); w = __builtin_amdgcn_cvt_pk_fp8_f32(sat_fp8(cc), sat_fp8(d), w, true); return w; }
__device__ __forceinline__ void transpose_item8(const float* W, int ldw, int k0, int sn0, unsigned char* dst, int K8, float* scr, int lane) {
    { const int c4 = lane & 7, rr = lane >> 3; const float* wp = W + (size_t)(k0 + rr) * ldw + sn0 + 4 * c4;
        f4 v[8];
#pragma unroll
        for (int i = 0; i < 8; ++i) v[i] = *(const f4*)(wp + (size_t)(8 * i) * ldw);
#pragma unroll
        for (int i = 0; i < 8; ++i) { float* sp = scr + (rr + 8 * i) * 33 + 4 * c4; sp[0] = v[i].x; sp[1] = v[i].y; sp[2] = v[i].z; sp[3] = v[i].w; } }
    LDS_WAIT();
    const int cc = lane & 7; constexpr float SC = (float)(1 << pg8::F8_WSCALE_LOG2);
#pragma unroll
    for (int j = 0; j < 4; ++j) { const int n = (lane >> 3) + 8 * j; const float* s = scr + (8 * cc) * 33 + n;
        u2 o; o.x = pk4_fp8(s[0 * 33] * SC, s[1 * 33] * SC, s[2 * 33] * SC, s[3 * 33] * SC); o.y = pk4_fp8(s[4 * 33] * SC, s[5 * 33] * SC, s[6 * 33] * SC, s[7 * 33] * SC);
        *(u2*)(dst + (size_t)n * K8 + 8 * cc) = o; }
    LDS_WAIT();
}
__device__ __forceinline__ void transpose_item8w(const float* W, int ldw, int k0, int sn0, unsigned char* dst, int K8, float* scr, int lane) {
    { const int c4 = lane & 15, rr = lane >> 4; const float* wp = W + (size_t)(k0 + rr) * ldw + sn0 + 4 * c4;
        f4 v[16];
#pragma unroll
        for (int i = 0; i < 16; ++i) v[i] = *(const f4*)(wp + (size_t)(4 * i) * ldw);
#pragma unroll
        for (int i = 0; i < 16; ++i) { float* sp = scr + (rr + 4 * i) * 65 + 4 * c4; sp[0] = v[i].x; sp[1] = v[i].y; sp[2] = v[i].z; sp[3] = v[i].w; } }
    LDS_WAIT();
    const int cc = lane & 3; constexpr float SC = (float)(1 << pg8::F8_WSCALE_LOG2);
#pragma unroll
    for (int j = 0; j < 4; ++j) { const int n = (lane >> 2) + 16 * j; const float* s = scr + (16 * cc) * 65 + n;
        u4 o; o.x = pk4_fp8(s[0 * 65] * SC, s[1 * 65] * SC, s[2 * 65] * SC, s[3 * 65] * SC); o.y = pk4_fp8(s[4 * 65] * SC, s[5 * 65] * SC, s[6 * 65] * SC, s[7 * 65] * SC);
        o.z = pk4_fp8(s[8 * 65] * SC, s[9 * 65] * SC, s[10 * 65] * SC, s[11 * 65] * SC); o.w = pk4_fp8(s[12 * 65] * SC, s[13 * 65] * SC, s[14 * 65] * SC, s[15 * 65] * SC);
        *(u4*)(dst + (size_t)n * K8 + 16 * cc) = o; }
    LDS_WAIT();
}
__device__ __forceinline__ void ph_prologue(const Ctx& c) {
    float* S3 = (float*)c.lds;
    float* scr = (float*)(c.lds + 24576 + c.wave * 16640);
    for (int i = c.tid; i < 3 * D; i += NTHREADS) { const int r = i / D, k = i % D; const float v = r < 2 ? c.cvec()[r * D + k] : c.c_ctx()[k]; S3[i] = silu_f(v); }
    __syncthreads();
    constexpr int N_MOD = 2 * (MODW / 32);
    constexpr int N_ROPE = 16;
    constexpr int N_WIN = 2 * 32 * 210, N_WOUT = 2 * 32 * 64, N_EXP = 96 * 1024;
    constexpr int NITEMS = N_MOD + N_ROPE + N_WIN + N_WOUT + N_EXP;
    const int lane = c.lane;
    constexpr int NGRABS = N_MOD + (NITEMS - N_MOD + 7) / 8;
    for (;;) {
      int g = 0; if (lane == 0) g = (int)atomicAdd(c.ctl() + CW_PROQ, 1u);
      g = __builtin_amdgcn_readfirstlane(g);
      if (g >= NGRABS) break;
      const int it0 = g < N_MOD ? g : N_MOD + (g - N_MOD) * 8, it1 = g < N_MOD ? g + 1 : (it0 + 8 < NITEMS ? it0 + 8 : NITEMS);
      for (int it = it0; it < it1; ++it) {
        int r = it;
        if (r < N_MOD) {
            const int l = r / (MODW / 32), cb = r % (MODW / 32), kg = lane >> 3, cl = lane & 7, col = cb * 32 + 4 * cl;
            const float* wp = c.w_ada() + (size_t)l * D * MODW + col;
            f4 a0 = {0.f, 0.f, 0.f, 0.f}, a1 = a0, a2 = a0;
#pragma unroll 8
            for (int i = 0; i < 256; ++i) { const int k = kg + 8 * i; const f4 w = *(const f4*)(wp + (size_t)k * MODW); a0 += S3[k] * w; a1 += S3[D + k] * w; a2 += S3[2 * D + k] * w; }
#pragma unroll
            for (int q = 0; q < 4; ++q) {
#pragma unroll
                for (int o = 8; o < 64; o <<= 1) { a0[q] += __shfl_xor(a0[q], o); a1[q] += __shfl_xor(a1[q], o); a2[q] += __shfl_xor(a2[q], o); } }
            if (kg == 0) { const f4 bb = *(const f4*)(c.b_ada() + (size_t)l * MODW + col);
                *(f4*)(c.MOD() + (size_t)(l * 3 + 0) * MODW + col) = a0 + bb; *(f4*)(c.MOD() + (size_t)(l * 3 + 1) * MODW + col) = a1 + bb; *(f4*)(c.MOD() + (size_t)(l * 3 + 2) * MODW + col) = a2 + bb; }
            continue; }
        r -= N_MOD;
        if (r < N_ROPE) { const int en = r * 64 + lane, pos = en >> 4, i = en & 15; const float f = powf(10000.f, -(float)i / 16.f), ang = (float)pos * f;
            c.ROPE()[en * 2] = cosf(ang); c.ROPE()[en * 2 + 1] = sinf(ang); continue; }
        r -= N_ROPE;
        if (r < N_WIN) { const int l = r / (32 * 210), q = r % (32 * 210), kb = q / 210, nb = q % 210, n0 = nb * 32;
            int sn0, nv = 32;
            if (n0 < 4608) sn0 = n0; else if (n0 < 6656) sn0 = n0 + 32; else if (n0 < 6688) sn0 = 4608 + (n0 - 6656); else { sn0 = 6688; nv = 16; }
            transpose_item(c.w_in() + (size_t)l * D * INW, INW, kb * 64, sn0, nv, c.WIN() + ((size_t)l * NP + n0) * D + kb * 64, D, scr, lane); continue; }
        r -= N_WIN;
        if (r < N_WOUT) { const int l = r / 2048, q = r % 2048, kb = q / 64, nb = q % 64;
            transpose_item(c.w_out() + (size_t)l * D * D, D, kb * 64, nb * 32, 32, c.WOUT() + ((size_t)l * D + nb * 32) * D + kb * 64, D, scr, lane); continue; }
        r -= N_WOUT;
        { const int mtx = r / 1024, q = r % 1024, kb = q / 32, nb = q % 32; const int ty = mtx / 32, le = mtx % 32;
            const bool f8 = ((F8MASK) >> (le >> 4)) & 1;
            if (ty < 2) { const float* W = (ty == 0 ? c.w_exp_gate() : c.w_exp_up()) + (size_t)le * D * FF;
                const int drow = (nb >> 1) * 256 + ty * 128 + (nb & 1) * 64;
                if (!f8) { transpose_item(W, FF, kb * 64, nb * 64, 32, c.WGU() + ((size_t)le * 4096 + drow) * D + kb * 64, D, scr, lane); transpose_item(W, FF, kb * 64, nb * 64 + 32, 32, c.WGU() + ((size_t)le * 4096 + drow + 32) * D + kb * 64, D, scr, lane); }
                else transpose_item8w(W, FF, kb * 64, nb * 64, (unsigned char*)(c.WGU() + (size_t)(le >> 4) * NE * 4096 * D) + ((size_t)(le & 15) * 4096 + drow) * D + kb * 64, D, scr, lane); }
            else { const float* W = c.w_exp_down() + (size_t)le * FF * D;
                if (!f8) { transpose_item(W, D, kb * 64, nb * 64, 32, c.WDN() + ((size_t)le * D + nb * 64) * FF + kb * 64, FF, scr, lane); transpose_item(W, D, kb * 64, nb * 64 + 32, 32, c.WDN() + ((size_t)le * D + nb * 64 + 32) * FF + kb * 64, FF, scr, lane); }
                else transpose_item8w(W, D, kb * 64, nb * 64, (unsigned char*)(c.WDN() + (size_t)(le >> 4) * NE * D * FF) + ((size_t)(le & 15) * D + nb * 64) * FF + kb * 64, FF, scr, lane); } }
    }
    }
}


__device__ __forceinline__ void moe_combine_row(const Ctx& c, int lm, int row, int lane, f4 (&v)[8]) {
    f4 acc[8];
#pragma unroll
    for (int j = 0; j < 8; ++j) acc[j] = (f4){0.f, 0.f, 0.f, 0.f};
    const int* so = c.SLOTOF() + row;
    const int sl = lane < NE ? so[(size_t)lane * MROWS] : -1;
#pragma unroll
    for (int e = 0; e < NE; ++e) { const int s = __builtin_amdgcn_readlane(sl, e);
        if (s >= 0) { const float gate = c.GATEV()[e * ESLOT + s]; const bf16* yr = c.Y() + ((size_t)e * ESLOT + s) * D + 4 * lane;
#pragma unroll
            for (int j = 0; j < 8; ++j) { const u2 raw = *(const u2*)(yr + 256 * j);
                acc[j].x += gate * bf2f(raw.x & 0xffffu); acc[j].y += gate * bf2f(raw.x >> 16); acc[j].z += gate * bf2f(raw.y & 0xffffu); acc[j].w += gate * bf2f(raw.y >> 16); } } }
    const float* g2 = c.MOD() + (size_t)(lm * 3 + modrow(row)) * MODW + 5 * D + 4 * lane;
#pragma unroll
    for (int j = 0; j < 8; ++j) v[j] += *(const f4*)(g2 + 256 * j) * acc[j];
}

__device__ __forceinline__ void ph_norm1(const Ctx& c, int l) {
    const int lane = c.lane;
    for (int row = c.gw; row < MROWS; row += c.ngw) {
        const float* xr = src_row_ptr(c, l, row);
        f4 v[8]; float ss = 0.f;
#pragma unroll
        for (int j = 0; j < 8; ++j) v[j] = *(const f4*)(xr + 4 * lane + 256 * j);
        if (l > 0) { moe_combine_row(c, l - 1, row, lane, v); float* hw = c.HX() + (size_t)row * D;
#pragma unroll
            for (int j = 0; j < 8; ++j) *(f4*)(hw + 4 * lane + 256 * j) = v[j]; }
#pragma unroll
        for (int j = 0; j < 8; ++j) ss += v[j].x * v[j].x + v[j].y * v[j].y + v[j].z * v[j].z + v[j].w * v[j].w;
        ss = wave_sum(ss);
        const float rstd = 1.0f / sqrtf(ss * (1.0f / D) + 1e-6f);
        const float* nw = c.norm_mix_w() + (size_t)l * D; const float* md = c.MOD() + (size_t)(l * 3 + modrow(row)) * MODW;
        bf16* orow = c.NX() + (size_t)row * D;
#pragma unroll
        for (int j = 0; j < 8; ++j) { const int col = 4 * lane + 256 * j; const f4 w = *(const f4*)(nw + col), sh = *(const f4*)(md + col), sc = *(const f4*)(md + D + col);
            const f4 y = v[j] * rstd * w * (1.0f + sc) + sh; u2 o; o.x = pk2(y.x, y.y); o.y = pk2(y.z, y.w); *(u2*)(orow + col) = o; }
    }
}

using pg8::f32x4; using pg8::u32x4; using pg8::Unit;
struct EpiP {
    static constexpr bool PERM = true, AFTER_DRAIN = false;
    bf16* P; float* PS;
    __device__ __forceinline__ void operator()(const f32x4 (&acc)[2][2][4][2], const Unit& u, int wr, int wc, int fr, int fq) const {
        const int row0 = u.pm * 256 + wr * 64 + fr, col0 = u.pn * 256 + wc * 32 + 8 * fq;
#pragma unroll
        for (int ai = 0; ai < 2; ++ai)
#pragma unroll
            for (int m = 0; m < 4; ++m) { const int row = row0 + ai * 128 + m * 16; bf16* rowp = P + (size_t)row * NP + col0;
#pragma unroll
                for (int bj = 0; bj < 2; ++bj) { const f32x4 v0 = acc[ai][bj][m][0], v1 = acc[ai][bj][m][1];
                    u32x4 w; w.x = pg8::cvt_pk_bf16(v0[0], v0[1]); w.y = pg8::cvt_pk_bf16(v0[2], v0[3]); w.z = pg8::cvt_pk_bf16(v1[0], v1[1]); w.w = pg8::cvt_pk_bf16(v1[2], v1[3]);
                    *(u32x4*)(rowp + bj * 128) = w; }
                if (u.pn == 26 && wc < 2) { float* ps = PS + (size_t)row * 64 + wc * 32 + 8 * fq; *(f32x4*)ps = acc[ai][0][m][0]; *(f32x4*)(ps + 4) = acc[ai][0][m][1]; } }
    }
};
struct EpiResid {
    static constexpr bool PERM = false, AFTER_DRAIN = false;
    const float *x, *ctxin, *MOD; float* HX; int l;
    __device__ __forceinline__ void operator()(const f32x4 (&acc)[2][2][4][2], const Unit& u, int wr, int wc, int fr, int fq) const {
#pragma unroll
        for (int ai = 0; ai < 2; ++ai)
#pragma unroll
            for (int m = 0; m < 4; ++m) { const int row = u.pm * 256 + ai * 128 + wr * 64 + m * 16 + fr; float* dst = HX + (size_t)row * D;
                const float* src = (l == 0) ? (row < ML ? x + (size_t)row * D : ctxin + (size_t)(row - ML) * D) : dst;
                const float* g1 = MOD + (size_t)(l * 3 + modrow(row)) * MODW + 2 * D;
#pragma unroll
                for (int bj = 0; bj < 2; ++bj)
#pragma unroll
                    for (int n = 0; n < 2; ++n) { const int col = u.pn * 256 + bj * 128 + wc * 32 + n * 16 + 4 * fq;
                        *(f32x4*)(dst + col) = *(const f32x4*)(src + col) + *(const f32x4*)(g1 + col) * acc[ai][bj][m][n]; } }
    }
};
struct EpiSwiglu {
    static constexpr bool PERM = true, AFTER_DRAIN = false;
    bf16* HID;
    __device__ __forceinline__ void operator()(const f32x4 (&acc)[2][2][4][2], const Unit& u, int wr, int wc, int fr, int fq) const {
        const int row0 = u.pm * 256 + wr * 64 + fr, col0 = (u.pn & 15) * 128 + wc * 32 + 8 * fq;
#pragma unroll
        for (int ai = 0; ai < 2; ++ai)
#pragma unroll
            for (int m = 0; m < 4; ++m) { bf16* rowp = HID + (size_t)(row0 + ai * 128 + m * 16) * FF + col0;
                float h[8];
#pragma unroll
                for (int n = 0; n < 2; ++n)
#pragma unroll
                    for (int i = 0; i < 4; ++i) { const float g = acc[ai][0][m][n][i], up = acc[ai][1][m][n][i]; h[n * 4 + i] = silu_f(g) * up; }
                u32x4 w; w.x = pg8::cvt_pk_bf16(h[0], h[1]); w.y = pg8::cvt_pk_bf16(h[2], h[3]); w.z = pg8::cvt_pk_bf16(h[4], h[5]); w.w = pg8::cvt_pk_bf16(h[6], h[7]);
                *(u32x4*)rowp = w; }
    }
};
struct EpiSwiglu8 {
    static constexpr bool PERM = true, AFTER_DRAIN = false;
    unsigned char* HID8;
    __device__ __forceinline__ void operator()(const f32x4 (&acc)[2][2][4][2], const Unit& u, int wr, int wc, int fr, int fq) const {
        const int row0 = u.pm * 256 + wr * 64 + fr, col0 = (u.pn & 15) * 128 + wc * 32 + 8 * fq;
#pragma unroll
        for (int ai = 0; ai < 2; ++ai)
#pragma unroll
            for (int m = 0; m < 4; ++m) { unsigned char* rowp = HID8 + (size_t)(row0 + ai * 128 + m * 16) * FF + col0;
                float h[8];
#pragma unroll
                for (int n = 0; n < 2; ++n)
#pragma unroll
                    for (int i = 0; i < 4; ++i) { const float g = acc[ai][0][m][n][i], up = acc[ai][1][m][n][i]; h[n * 4 + i] = silu_f(g) * up; }
                u2 w; w.x = pk4_fp8(h[0], h[1], h[2], h[3]); w.y = pk4_fp8(h[4], h[5], h[6], h[7]);
                *(u2*)rowp = w; }
    }
};
struct EpiY {
    static constexpr bool PERM = true, AFTER_DRAIN = false;
    bf16* Yp;
    __device__ __forceinline__ void operator()(const f32x4 (&acc)[2][2][4][2], const Unit& u, int wr, int wc, int fr, int fq) const {
        const int row0 = u.pm * 256 + wr * 64 + fr, col0 = (u.pn & 7) * 256 + wc * 32 + 8 * fq;
#pragma unroll
        for (int ai = 0; ai < 2; ++ai)
#pragma unroll
            for (int m = 0; m < 4; ++m) { bf16* rowp = Yp + (size_t)(row0 + ai * 128 + m * 16) * D + col0;
#pragma unroll
                for (int bj = 0; bj < 2; ++bj) { const f32x4 v0 = acc[ai][bj][m][0], v1 = acc[ai][bj][m][1];
                    u32x4 w; w.x = pg8::cvt_pk_bf16(v0[0], v0[1]); w.y = pg8::cvt_pk_bf16(v0[2], v0[3]); w.z = pg8::cvt_pk_bf16(v1[0], v1[1]); w.w = pg8::cvt_pk_bf16(v1[2], v1[3]);
                    *(u32x4*)(rowp + bj * 128) = w; } }
    }
};
struct MoeOrder {
    int MT, NT, G, c;
    __device__ __forceinline__ bool next(int i, Unit& u) const { const int per = MT * NT; int e, r;
        if ((G & 7) == 0) { const int Lx = i * (G >> 3) + (c >> 3); if (Lx >= 2 * per) return false; e = 2 * (c & 7) + Lx / per; r = Lx % per; }
        else { const int L = i * G + c; if (L >= NE * per) return false; e = L / per; r = L % per; }
        u.pm = e * 5 + (r % MT); u.pn = e * NT + (r / MT); return true; }
    __device__ __forceinline__ void a_ready(const Unit&) const {}
    __device__ __forceinline__ void done(const Unit&) const {}
};
struct RowOrder {
    int nM, nN, G, c;
    __device__ __forceinline__ bool next(int i, Unit& u) const { const int L = i * G + c; if (L >= nM * nN) return false; u.pm = L % nM; u.pn = L / nM; return true; }
    __device__ __forceinline__ void a_ready(const Unit&) const {}
    __device__ __forceinline__ void done(const Unit&) const {}
};

__device__ __forceinline__ void ph_prep(const Ctx& c, int l) {
    const int lane = c.lane;
    const float* cw = c.gdn_conv_w() + (size_t)l * 5 * 1536;
    {
        for (int row = (blockIdx.x * 8 + c.wave) * 2; row < MROWS; row += gridDim.x * 16) {
            int t, T; if (row < ML) { t = row & (SEQ - 1); T = SEQ; } else { t = (row - ML) & (CTX - 1); T = CTX; }
#pragma unroll
            for (int j = 0; j < 3; ++j) {
                const int cb = j * 512 + lane * 8;
                u4 raw[6];
#pragma unroll
                for (int q = 0; q < 6; ++q) { const int tt = t + q - 2; raw[q] = (tt >= 0 && tt < T) ? *(const u4*)(c.P() + (size_t)(row + q - 2) * NP + PC_GDQ + cb) : (u4){0u, 0u, 0u, 0u}; }
                float a0[8], a1[8];
#pragma unroll
                for (int i = 0; i < 8; ++i) { a0[i] = 0.f; a1[i] = 0.f; }
#pragma unroll
                for (int tap = 0; tap < 5; ++tap) { const f4 w0 = *(const f4*)(cw + tap * 1536 + cb), w1 = *(const f4*)(cw + tap * 1536 + cb + 4);
                    const float wv[8] = {w0.x, w0.y, w0.z, w0.w, w1.x, w1.y, w1.z, w1.w};
                    const u4 r0 = raw[tap], r1 = raw[tap + 1];
                    const float x0[8] = {bf2f(r0.x & 0xffffu), bf2f(r0.x >> 16), bf2f(r0.y & 0xffffu), bf2f(r0.y >> 16), bf2f(r0.z & 0xffffu), bf2f(r0.z >> 16), bf2f(r0.w & 0xffffu), bf2f(r0.w >> 16)};
                    const float x1[8] = {bf2f(r1.x & 0xffffu), bf2f(r1.x >> 16), bf2f(r1.y & 0xffffu), bf2f(r1.y >> 16), bf2f(r1.z & 0xffffu), bf2f(r1.z >> 16), bf2f(r1.w & 0xffffu), bf2f(r1.w >> 16)};
#pragma unroll
                    for (int i = 0; i < 8; ++i) { a0[i] += wv[i] * x0[i]; a1[i] += wv[i] * x1[i]; } }
#pragma unroll
                for (int rr = 0; rr < 2; ++rr) { float* a = rr ? a1 : a0; float ss = 0.f;
#pragma unroll
                    for (int i = 0; i < 8; ++i) { a[i] = silu_f(a[i]); ss += a[i] * a[i]; }
                    if (j < 2) { ss += __shfl_xor(ss, 1); ss += __shfl_xor(ss, 2); ss += __shfl_xor(ss, 4); ss += __shfl_xor(ss, 8);
                        const float sc = (1.0f / sqrtf(ss + 1e-6f)) * (j == 0 ? 0.08838834764831845f : 1.0f);
#pragma unroll
                        for (int i = 0; i < 8; ++i) a[i] *= sc; }
                    float* o = c.GQKV() + (size_t)(row + rr) * 1536 + cb;
                    *(f4*)o = (f4){a[0], a[1], a[2], a[3]}; *(f4*)(o + 4) = (f4){a[4], a[5], a[6], a[7]}; }
            }
            if (lane < 16) { const int rr = lane >> 3, li = lane & 7; const float* ps = c.PS() + (size_t)(row + rr) * 64; const float av = ps[32 + li], bv = ps[40 + li];
                const float g = -expf(c.gdn_a_log()[l * 8 + li]) * softplus_f(av + c.gdn_dt_bias()[l * 8 + li]);
                c.GGB()[(size_t)(row + rr) * 16 + li] = g; c.GGB()[(size_t)(row + rr) * 16 + 8 + li] = 1.0f / (1.0f + expf(-bv)); }
        }
    }
}

__device__ __forceinline__ int scan_row(int s, int b, int dir) { if (s < CTX) return ML + b * CTX + (dir ? CTX - 1 - s : s); const int u = s - CTX; return b * SEQ + (dir ? SEQ - 1 - u : u); }
__device__ __forceinline__ void gla_scan_task(const Ctx& c, int b, int h, int dir) {
    float* sq = (float*)c.lds; float* sk = sq + 2048; float* sa = sk + 2048; float* sv = sa + 2048;
    const int e = c.wave * 16 + (c.lane & 15), dg = c.lane >> 4, d0 = dg * 16;
    float S[16];
#pragma unroll
    for (int i = 0; i < 16; ++i) S[i] = 0.f;
    for (int cs = 0; cs < (CTX + SEQ) / 32; ++cs) {
        __syncthreads();
        for (int idx = c.tid; idx < 2048; idx += NTHREADS) { const int tk = idx >> 6, d = idx & 63, row = scan_row(cs * 32 + tk, b, dir);
            sq[idx] = c.LQ()[(size_t)row * 256 + h * 64 + d]; sk[idx] = c.LK()[(size_t)row * 256 + h * 64 + d]; sa[idx] = expf(c.LA()[((size_t)dir * MROWS + row) * 256 + h * 64 + d]); }
        for (int idx = c.tid; idx < 4096; idx += NTHREADS) { const int tk = idx >> 7, e2 = idx & 127, row = scan_row(cs * 32 + tk, b, dir);
            sv[idx] = bf2f(c.P()[(size_t)row * NP + PC_GLV + h * 128 + e2]); }
        __syncthreads();
        for (int tk = 0; tk < 32; ++tk) {
            const float ve = sv[tk * 128 + e]; float o = 0.f;
#pragma unroll
            for (int i = 0; i < 16; ++i) { const int d = tk * 64 + d0 + i; S[i] = sa[d] * S[i] + sk[d] * ve; o += sq[d] * S[i]; }
            o += __shfl_xor(o, 16); o += __shfl_xor(o, 32);
            if (dg == 0) c.OGLA()[((size_t)dir * MROWS + scan_row(cs * 32 + tk, b, dir)) * 512 + h * 128 + e] = o;
        }
    }
}
__device__ __forceinline__ void gdn_scan_task(const Ctx& c, int b, int h, int dir) {
    float* sq = (float*)c.lds; float* sk = sq + 4096; float* sv = sk + 4096; float* sg = sv + 4096; float* sb = sg + 32;
    const int e = c.wave * 16 + (c.lane & 15), dg = c.lane >> 4, d0 = dg * 32;
    float S[32];
#pragma unroll
    for (int i = 0; i < 32; ++i) S[i] = 0.f;
    for (int cs = 0; cs < (CTX + SEQ) / 32; ++cs) {
        __syncthreads();
        for (int idx = c.tid; idx < 4096; idx += NTHREADS) { const int tk = idx >> 7, d = idx & 127, row = scan_row(cs * 32 + tk, b, dir); const float* g = c.GQKV() + (size_t)row * 1536 + h * 128 + d;
            sq[idx] = g[0]; sk[idx] = g[512]; sv[idx] = g[1024]; }
        if (c.tid < 32) { const int row = scan_row(cs * 32 + c.tid, b, dir); sg[c.tid] = expf(c.GGB()[(size_t)row * 16 + dir * 4 + h]); sb[c.tid] = c.GGB()[(size_t)row * 16 + 8 + dir * 4 + h]; }
        __syncthreads();
        for (int tk = 0; tk < 32; ++tk) {
            float ks = 0.f;
#pragma unroll
            for (int i = 0; i < 32; ++i) ks += sk[tk * 128 + d0 + i] * S[i];
            ks += __shfl_xor(ks, 16); ks += __shfl_xor(ks, 32);
            const float eg = sg[tk], delta = sb[tk] * (sv[tk * 128 + e] - eg * ks);
            float o = 0.f;
#pragma unroll
            for (int i = 0; i < 32; ++i) { const int d = tk * 128 + d0 + i; S[i] = eg * S[i] + sk[d] * delta; o += sq[d] * S[i]; }
            o += __shfl_xor(o, 16); o += __shfl_xor(o, 32);
            if (dg == 0) c.OGDN()[((size_t)dir * MROWS + scan_row(cs * 32 + tk, b, dir)) * 512 + h * 128 + e] = o;
        }
    }
}
__device__ __forceinline__ void na_task(const Ctx& c, int l, int task, int lane) {
    const bool lat = task < ML * 16;
    const int tq = lat ? task : task - ML * 16;
    const int h = tq & 15, row = (tq >> 4) + (lat ? 0 : ML);
    const int b = lat ? (row >> 12) : ((row - ML) >> 8);
    const bf16* P = c.P();
    const float qv = bf2f(P[(size_t)row * NP + PC_NAQ + h * 64 + lane]) * 0.125f;
    int krow[6]; float sc[6];
#pragma unroll
    for (int i = 0; i < 4; ++i) { krow[2 + i] = ML + b * CTX + lane + 64 * i; sc[2 + i] = 0.f; }
    if (lat) { const int t = row & (SEQ - 1), r = t >> 6, cq = t & 63; const int rs = min(max(r - 4, 0), 56), cs = min(max(cq - 8, 0), 48);
#pragma unroll
        for (int i = 0; i < 2; ++i) { const int lk = lane + 64 * i, j = lk >> 4, cc = lk & 15; krow[i] = b * SEQ + (rs + j) * 64 + cs + cc;
            sc[i] = c.na_rpb()[((size_t)(l * 16 + h) * 15 + (rs + j - r + 7)) * 31 + (cs + cc - cq + 15)]; } }
    else { krow[0] = krow[2]; krow[1] = krow[2]; sc[0] = -INFINITY; sc[1] = -INFINITY; }
#pragma unroll
    for (int i = 0; i < 6; ++i) {
        if (i >= 2 || lat) { const bf16* kp = P + (size_t)krow[i] * NP + PC_NAK + h * 64; float s = 0.f;
#pragma unroll
            for (int m = 0; m < 8; ++m) { const u4 w = *(const u4*)(kp + 8 * m);
                s += __int_as_float(__builtin_amdgcn_readlane(__float_as_int(qv), 8 * m + 0)) * bf2f(w.x & 0xffffu); s += __int_as_float(__builtin_amdgcn_readlane(__float_as_int(qv), 8 * m + 1)) * bf2f(w.x >> 16);
                s += __int_as_float(__builtin_amdgcn_readlane(__float_as_int(qv), 8 * m + 2)) * bf2f(w.y & 0xffffu); s += __int_as_float(__builtin_amdgcn_readlane(__float_as_int(qv), 8 * m + 3)) * bf2f(w.y >> 16);
                s += __int_as_float(__builtin_amdgcn_readlane(__float_as_int(qv), 8 * m + 4)) * bf2f(w.z & 0xffffu); s += __int_as_float(__builtin_amdgcn_readlane(__float_as_int(qv), 8 * m + 5)) * bf2f(w.z >> 16);
                s += __int_as_float(__builtin_amdgcn_readlane(__float_as_int(qv), 8 * m + 6)) * bf2f(w.w & 0xffffu); s += __int_as_float(__builtin_amdgcn_readlane(__float_as_int(qv), 8 * m + 7)) * bf2f(w.w >> 16); }
            sc[i] += s; } }
    float mx = sc[0];
#pragma unroll
    for (int i = 1; i < 6; ++i) mx = fmaxf(mx, sc[i]);
    mx = wave_max(mx);
    float sum = 0.f;
#pragma unroll
    for (int i = 0; i < 6; ++i) { sc[i] = expf(sc[i] - mx); sum += sc[i]; }
    sum = wave_sum(sum);
    const float inv = 1.0f / sum;
    float o = 0.f;
    const bf16* vp = P + PC_NAV + h * 64 + lane;
#pragma unroll
    for (int i = 0; i < 6; ++i) {
        if (i >= 2 || lat) {
#pragma unroll 8
            for (int sl = 0; sl < 64; ++sl) { const float p = __int_as_float(__builtin_amdgcn_readlane(__float_as_int(sc[i]), sl)); const int kr = __builtin_amdgcn_readlane(krow[i], sl);
                o += p * bf2f(vp[(size_t)kr * NP]); } } }
    c.CAT()[(size_t)row * D + h * 64 + lane] = (bf16)f2bf(o * inv);
}
__device__ __forceinline__ void ph_scan_na(const Ctx& c, int l) {
    for (int bt = blockIdx.x; bt < 32; bt += gridDim.x) { const int kind = bt >> 4, dir = (bt >> 3) & 1, b = (bt >> 2) & 1, h = bt & 3;
        if (kind == 0) gla_scan_task(c, b, h, dir); else gdn_scan_task(c, b, h, dir); }
    __syncthreads();
    const int ntask = ML * 16 + (l == 0 ? MC * 16 : 0), nchunk = ntask / 512;
    int* sh = (int*)(c.lds + MISC_OFF + 64);
    for (;;) {
        __syncthreads();
        if (c.tid == 0) *sh = (int)atomicAdd(c.ctl() + CW_NAQ + 64 * (l + 2 * c.rep), 1u);
        __syncthreads();
        const int ch = *sh;
        if (ch >= nchunk) break;
        for (int i = 0; i < 64; ++i) na_task(c, l, ch * 512 + c.wave * 64 + i, c.lane);
    }
}

__device__ __forceinline__ void ph_combine(const Ctx& c, int l) {
    const int lane = c.lane; const int nrows = l == 0 ? MROWS : ML;
    for (int row = c.gw; row < nrows; row += c.ngw) {
#pragma unroll
        for (int which = 0; which < 1; ++which) {
            const float* O = which == 0 ? c.OGLA() : c.OGDN(); const float* nwp = (which == 0 ? c.gla_norm_w() : c.gdn_norm_w()) + l * 128 + (lane & 15) * 8;
            const int gcol = (which == 0 ? PC_GLG : PC_GDZ) + lane * 8;
            const f4 a0 = *(const f4*)(O + (size_t)row * 512 + lane * 8), a1 = *(const f4*)(O + (size_t)row * 512 + lane * 8 + 4);
            const f4 b0 = *(const f4*)(O + ((size_t)MROWS + row) * 512 + lane * 8), b1 = *(const f4*)(O + ((size_t)MROWS + row) * 512 + lane * 8 + 4);
            float o[8] = {a0.x + b0.x, a0.y + b0.y, a0.z + b0.z, a0.w + b0.w, a1.x + b1.x, a1.y + b1.y, a1.z + b1.z, a1.w + b1.w};
            float ss = 0.f;
#pragma unroll
            for (int i = 0; i < 8; ++i) ss += o[i] * o[i];
            ss += __shfl_xor(ss, 1); ss += __shfl_xor(ss, 2); ss += __shfl_xor(ss, 4); ss += __shfl_xor(ss, 8);
            const float rstd = 1.0f / sqrtf(ss * (1.0f / 128.f) + 1e-6f);
            const u4 graw = *(const u4*)(c.P() + (size_t)row * NP + gcol);
            const float g[8] = {bf2f(graw.x & 0xffffu), bf2f(graw.x >> 16), bf2f(graw.y & 0xffffu), bf2f(graw.y >> 16), bf2f(graw.z & 0xffffu), bf2f(graw.z >> 16), bf2f(graw.w & 0xffffu), bf2f(graw.w >> 16)};
            float y[8];
#pragma unroll
            for (int i = 0; i < 8; ++i) y[i] = o[i] * rstd * nwp[i] * silu_f(g[i]);
            u4 w; w.x = pk2(y[0], y[1]); w.y = pk2(y[2], y[3]); w.z = pk2(y[4], y[5]); w.w = pk2(y[6], y[7]);
            *(u4*)(c.CAT() + (size_t)row * D + 1024 + which * 512 + lane * 8) = w;
        }
    }
}

__device__ __forceinline__ void ph_norm2_router(const Ctx& c, int l) {
    float* WR = (float*)c.lds;
    const float* wr = c.w_router() + (size_t)l * D * NE;
    __syncthreads();
    for (int idx = c.tid; idx < D * NE; idx += NTHREADS) WR[(idx & 15) * D + (idx >> 4)] = wr[idx];
    __syncthreads();
    const int lane = c.lane; const int nrows = l == 0 ? MROWS : ML;
    const int eid = ((lane >> 5) & 1) * 8 + ((lane >> 4) & 1) * 4 + ((lane >> 3) & 1) * 2 + ((lane >> 2) & 1);
    for (int row = c.gw; row < nrows; row += c.ngw) {
        const float* xr = c.HX() + (size_t)row * D;
        f4 v[8]; float ss = 0.f;
#pragma unroll
        for (int j = 0; j < 8; ++j) { v[j] = *(const f4*)(xr + 4 * lane + 256 * j); ss += v[j].x * v[j].x + v[j].y * v[j].y + v[j].z * v[j].z + v[j].w * v[j].w; }
        ss = wave_sum(ss);
        const float rstd = 1.0f / sqrtf(ss * (1.0f / D) + 1e-6f);
        const float* nw = c.norm_ffn_w() + (size_t)l * D; const float* md = c.MOD() + (size_t)(l * 3 + modrow(row)) * MODW;
        bf16* orow = c.NX() + (size_t)row * D;
#pragma unroll
        for (int j = 0; j < 8; ++j) { const int col = 4 * lane + 256 * j; const f4 w = *(const f4*)(nw + col), sh = *(const f4*)(md + 3 * D + col), sc = *(const f4*)(md + 4 * D + col);
            v[j] = v[j] * rstd * w * (1.0f + sc) + sh; u2 o; o.x = pk2(v[j].x, v[j].y); o.y = pk2(v[j].z, v[j].w); *(u2*)(orow + col) = o; }
        float acc[16];
#pragma unroll
        for (int e = 0; e < 16; ++e) acc[e] = 0.f;
#pragma unroll
        for (int j = 0; j < 8; ++j) {
            asm volatile("" ::: "memory");
#pragma unroll
            for (int e = 0; e < 16; ++e) { const f4 w = *(const f4*)(WR + e * D + 256 * j + 4 * lane); acc[e] += v[j].x * w.x + v[j].y * w.y + v[j].z * w.z + v[j].w * w.w; } }
        float a8[8], a4[4], a2[2];
        { const bool hi = (lane & 32) != 0;
#pragma unroll
            for (int e = 0; e < 8; ++e) { const float send = hi ? acc[e] : acc[e + 8], keep = hi ? acc[e + 8] : acc[e]; a8[e] = keep + __shfl_xor(send, 32); } }
        { const bool hi = (lane & 16) != 0;
#pragma unroll
            for (int e = 0; e < 4; ++e) { const float send = hi ? a8[e] : a8[e + 4], keep = hi ? a8[e + 4] : a8[e]; a4[e] = keep + __shfl_xor(send, 16); } }
        { const bool hi = (lane & 8) != 0;
#pragma unroll
            for (int e = 0; e < 2; ++e) { const float send = hi ? a4[e] : a4[e + 2], keep = hi ? a4[e + 2] : a4[e]; a2[e] = keep + __shfl_xor(send, 8); } }
        float lg; { const bool hi = (lane & 4) != 0; const float send = hi ? a2[0] : a2[1], keep = hi ? a2[1] : a2[0]; lg = keep + __shfl_xor(send, 4); }
        lg += __shfl_xor(lg, 1); lg += __shfl_xor(lg, 2);
        float mx = lg;
        mx = fmaxf(mx, __shfl_xor(mx, 4)); mx = fmaxf(mx, __shfl_xor(mx, 8)); mx = fmaxf(mx, __shfl_xor(mx, 16)); mx = fmaxf(mx, __shfl_xor(mx, 32));
        const float ex = expf(lg - mx); float sum = ex;
        sum += __shfl_xor(sum, 4); sum += __shfl_xor(sum, 8); sum += __shfl_xor(sum, 16); sum += __shfl_xor(sum, 32);
        if ((lane & 3) == 0) c.AFF()[(size_t)row * 16 + eid] = ex / sum;
    }
}

__device__ __forceinline__ int block_excl_scan(int v, int* sc, int tid, int& total) {
    const int lane = tid & 63, w = tid >> 6; int x = v;
#pragma unroll
    for (int o = 1; o < 64; o <<= 1) { const int y = __shfl_up(x, o); if (lane >= o) x += y; }
    if (lane == 63) sc[w] = x;
    __syncthreads();
    int woff = 0, tot = 0;
#pragma unroll
    for (int i = 0; i < NWAVES; ++i) { const int t = sc[i]; woff += (i < w) ? t : 0; tot += t; }
    __syncthreads();
    total = tot; return woff + x - v;
}
__device__ __forceinline__ void ph_topk(const Ctx& c, int l) {
    unsigned* keys = (unsigned*)c.lds; unsigned* hist = keys + 4096; unsigned* misc = hist + 256; int* scs = (int*)(misc + 16);
    const int ntask = l == 0 ? 64 : 32, tid = c.tid;
    for (int task = blockIdx.x; task < ntask; task += gridDim.x) {
        const int s = task >> 5, b = (task >> 4) & 1, e = task & 15;
        const int n = s ? CTX : SEQ, cap = s ? 32 : 512, base_row = s ? ML + b * CTX : b * SEQ, slot_base = s ? 1024 + b * 32 : b * 512;
        __syncthreads();
        for (int i = tid; i < n; i += NTHREADS) keys[i] = __float_as_uint(c.AFF()[(size_t)(base_row + i) * 16 + e]);
        if (tid == 0) { misc[0] = 0u; misc[1] = (unsigned)cap; }
        unsigned prefix = 0u, mask = 0u;
        for (int shift = 24; shift >= 0; shift -= 8) {
            if (tid < 256) hist[tid] = 0u;
            __syncthreads();
            for (int i = tid; i < n; i += NTHREADS) { const unsigned k = keys[i]; if ((k & mask) == prefix) atomicAdd(&hist[(k >> shift) & 255u], 1u); }
            __syncthreads();
            if (tid < 64) { const unsigned kk = misc[1]; const unsigned h0 = hist[4 * tid], h1 = hist[4 * tid + 1], h2 = hist[4 * tid + 2], h3 = hist[4 * tid + 3];
                const unsigned s4 = h0 + h1 + h2 + h3; unsigned suf = s4;
#pragma unroll
                for (int o = 1; o < 64; o <<= 1) { const unsigned y = __shfl_down(suf, o); if (tid + o < 64) suf += y; }
                const unsigned above = suf - s4;
                if (above < kk && kk <= suf) { unsigned cum = above; int bin;
                    if (cum + h3 >= kk) bin = 3; else { cum += h3; if (cum + h2 >= kk) bin = 2; else { cum += h2; if (cum + h1 >= kk) bin = 1; else { cum += h1; bin = 0; } } }
                    misc[0] = prefix | ((unsigned)(4 * tid + bin) << shift); misc[1] = kk - cum; } }
            __syncthreads();
            prefix = misc[0]; mask |= 255u << shift;
        }
        const unsigned thr = prefix; const int need = (int)misc[1];
        const int ipt = n >= NTHREADS ? n / NTHREADS : 1, i0 = tid * ipt;
        int cg = 0, ce = 0;
        if (i0 < n) for (int i = 0; i < ipt; ++i) { const unsigned k = keys[i0 + i]; cg += k > thr; ce += k == thr; }
        int G, Etot;
        int og = block_excl_scan(cg, scs, tid, G);
        int oe = block_excl_scan(ce, scs, tid, Etot);
        if (i0 < n) for (int i = 0; i < ipt; ++i) { const unsigned k = keys[i0 + i]; int slot = -1;
            if (k > thr) slot = og++; else if (k == thr) { if (oe < need) slot = G + oe; ++oe; }
            c.SLOTOF()[(size_t)e * MROWS + base_row + i0 + i] = slot >= 0 ? slot_base + slot : -1;
            if (slot >= 0) { c.IDX()[e * ESLOT + slot_base + slot] = base_row + i0 + i; c.GATEV()[e * ESLOT + slot_base + slot] = __uint_as_float(k); } }
    }
}

__device__ __forceinline__ void ph_gather(const Ctx& c, int l) {
    const int nsl = l == 0 ? 1088 : 1024, ntask = NE * nsl;
    const bool f8 = ((F8MASK) >> l) & 1;
    for (int task = c.gw; task < ntask; task += c.ngw) { const int e = task / nsl, slot = task % nsl; const int tok = c.IDX()[e * ESLOT + slot];
        if (!f8) { const u4* src = (const u4*)(c.NX() + (size_t)tok * D); u4* dst = (u4*)(c.AMOE() + ((size_t)e * ESLOT + slot) * D);
#pragma unroll
            for (int j = 0; j < 4; ++j) dst[c.lane + 64 * j] = src[c.lane + 64 * j]; }
        else { const u4* src = (const u4*)(c.NX() + (size_t)tok * D) + 4 * c.lane;
            const u4 r0 = src[0], r1 = src[1], r2 = src[2], r3 = src[3];
            u4 o0, o1;
            o0.x = pk4_fp8(bf2f(r0.x & 0xffffu), bf2f(r0.x >> 16), bf2f(r0.y & 0xffffu), bf2f(r0.y >> 16)); o0.y = pk4_fp8(bf2f(r0.z & 0xffffu), bf2f(r0.z >> 16), bf2f(r0.w & 0xffffu), bf2f(r0.w >> 16));
            o0.z = pk4_fp8(bf2f(r1.x & 0xffffu), bf2f(r1.x >> 16), bf2f(r1.y & 0xffffu), bf2f(r1.y >> 16)); o0.w = pk4_fp8(bf2f(r1.z & 0xffffu), bf2f(r1.z >> 16), bf2f(r1.w & 0xffffu), bf2f(r1.w >> 16));
            o1.x = pk4_fp8(bf2f(r2.x & 0xffffu), bf2f(r2.x >> 16), bf2f(r2.y & 0xffffu), bf2f(r2.y >> 16)); o1.y = pk4_fp8(bf2f(r2.z & 0xffffu), bf2f(r2.z >> 16), bf2f(r2.w & 0xffffu), bf2f(r2.w >> 16));
            o1.z = pk4_fp8(bf2f(r3.x & 0xffffu), bf2f(r3.x >> 16), bf2f(r3.y & 0xffffu), bf2f(r3.y >> 16)); o1.w = pk4_fp8(bf2f(r3.z & 0xffffu), bf2f(r3.z >> 16), bf2f(r3.w & 0xffffu), bf2f(r3.w >> 16));
            u4* dst = (u4*)((unsigned char*)c.AMOE() + ((size_t)e * ESLOT + slot) * D) + 2 * c.lane;
            dst[0] = o0; dst[1] = o1; } }
}

__device__ __forceinline__ void ph_final(const Ctx& c) {
    const int lane = c.lane;
    for (int row = c.gw; row < ML; row += c.ngw) {
        const float* xr = c.HX() + (size_t)row * D;
        f4 v[8]; float ss = 0.f;
#pragma unroll
        for (int j = 0; j < 8; ++j) v[j] = *(const f4*)(xr + 4 * lane + 256 * j);
        moe_combine_row(c, 1, row, lane, v);
#pragma unroll
        for (int j = 0; j < 8; ++j) ss += v[j].x * v[j].x + v[j].y * v[j].y + v[j].z * v[j].z + v[j].w * v[j].w;
        ss = wave_sum(ss);
        const float rstd = 1.0f / sqrtf(ss * (1.0f / D) + 1e-6f);
#pragma unroll
        for (int j = 0; j < 8; ++j) { const int col = 4 * lane + 256 * j; *(f4*)(c.out() + (size_t)row * D + col) = v[j] * rstd * *(const f4*)(c.final_norm_w() + col); }
    }
#if defined(TPROBE)
    if (TPROBE >= 0) { __syncthreads(); if (blockIdx.x == 0 && c.tid == 0) { asm volatile("s_waitcnt vmcnt(0)" ::: "memory"); c.out()[0] = 20480.0f * (float)(c.ctl()[CW_TP + 64 * TPROBE] >> 11); } }
#endif
}

typedef short bf16x8 __attribute__((ext_vector_type(8)));
#define RAW_BAR() do { asm volatile("s_waitcnt lgkmcnt(0)" ::: "memory"); __builtin_amdgcn_s_barrier(); asm volatile("" ::: "memory"); } while (0)
#define MFMA16(a, b, c) __builtin_amdgcn_mfma_f32_16x16x32_bf16((a), (b), (c), 0, 0, 0)
__device__ __forceinline__ bf16x8 ldfrag(const LAS unsigned char* base, int stride, int row0, int ks, int lane) {
    return *(const LAS bf16x8*)(base + (row0 + (lane & 15)) * stride + ks * 64 + (lane >> 4) * 16);
}
__device__ __forceinline__ int blk_row0(int b, int blk) { return blk < 4 ? ML + b * CTX + blk * 64 : b * SEQ + (blk - 4) * 64; }
__device__ __forceinline__ int scan_blk(int s, int dir) { return s < 4 ? (dir ? 3 - s : s) : (dir ? 71 - s : s); }

__device__ __forceinline__ void gla_tiles_unit(const Ctx& c, int lsel, int ud);
__device__ __forceinline__ void ph_gdn_chunk(const Ctx& c, int l) {
    LAS unsigned char* L = (LAS unsigned char*)c.lds;
    constexpr int O_D = 0, O_MO = 8192, O_A = 26624, O_G = 45056, O_R1 = 47104, O_SOL = 83968;
    const float* GQ = c.GQKV(); const float* GG = c.GGB();
    LAS float* gcf = (LAS float*)(L + O_G); LAS float* gcb = gcf + 64; LAS float* btf = gcf + 128; LAS float* btb = gcf + 192; LAS float* egf = gcf + 256; LAS float* egb = gcf + 320;
    __syncthreads();
    { const int tid = c.tid;
    for (int i = tid; i < 73728 / 16; i += NTHREADS) *(LAS u4*)(L + O_SOL + i * 16) = (u4){0u, 0u, 0u, 0u}; }
    int* qsh = (int*)(c.lds + MISC_OFF + 64);
    for (;;) {
        __syncthreads();
        if (c.tid == 0) *qsh = (int)atomicAdd(c.ctl() + CW_CHQ + 64 * (l + 2 * c.rep), 1u);
        __syncthreads();
        const int unit = *qsh;
        if (unit >= 544 + 1088) break;
        if (unit >= 544) { const int uu = unit - 544, bhq = (uu >> 1) / 68, blq = (uu >> 1) % 68; gla_tiles_unit(c, l, (bhq * UDS + blq) * 2 + (uu & 1)); continue; }
        const int bh = unit / 68, blk = unit % 68, b = bh >> 2, h = bh & 3, row0 = blk_row0(b, blk);
        int tid = c.tid; asm volatile("" : "+v"(tid));
        const int lane = tid & 63, w = __builtin_amdgcn_readfirstlane(tid >> 6);
        __syncthreads();
        for (int idx = tid; idx < 2048; idx += NTHREADS) { const int t = idx >> 5, d4 = (idx & 31) * 4; const float* src = GQ + (size_t)(row0 + t) * 1536 + h * 128 + d4;
            const f4 qv = *(const f4*)src, kv = *(const f4*)(src + 512);
            u2 qo, ko; qo.x = pk2(qv.x, qv.y); qo.y = pk2(qv.z, qv.w); ko.x = pk2(kv.x, kv.y); ko.y = pk2(kv.z, kv.w);
            *(LAS u2*)(L + O_R1 + t * 272 + d4 * 2) = ko; *(LAS u2*)(L + O_R1 + 17408 + t * 272 + d4 * 2) = qo; }
        if (w == 0) { const float* gp = GG + (size_t)(row0 + lane) * 16; float a = gp[h], bq = gp[4 + h];
#pragma unroll
            for (int o = 1; o < 64; o <<= 1) { const float y = __shfl_up(a, o); if (lane >= o) a += y; const float z = __shfl_down(bq, o); if (lane + o < 64) bq += z; }
            gcf[lane] = a; gcb[lane] = bq; btf[lane] = gp[8 + h]; btb[lane] = gp[12 + h]; egf[lane] = __expf(a); egb[lane] = __expf(bq); }
        const int sdir = tid >> 8, scol = tid & 255;
        const float* rp = GQ + (size_t)row0 * 1536 + (scol < 128 ? 1024 + h * 128 + scol : 512 + h * 128 + (scol - 128));
        __syncthreads();
        {
            const int which = w >> 2, tt = w & 3;
            const LAS unsigned char* Ab = L + O_R1 + (which ? 17408 : 0);
            const int t = tt * 16 + (lane & 15); const float gft = gcf[t], gbt = gcb[t], bft = btf[t], bbt = btb[t];
            bf16x8 ga[4], gb[4][4];
#pragma unroll
            for (int ks = 0; ks < 4; ++ks) { ga[ks] = ldfrag(Ab, 272, tt * 16, ks, lane);
#pragma unroll
                for (int st = 0; st < 4; ++st) gb[st][ks] = ldfrag(L + O_R1, 272, st * 16, ks, lane); }
            __builtin_amdgcn_sched_barrier(0);
#pragma unroll
            for (int st = 0; st < 4; ++st) {
                f32x4 acc = {0.f, 0.f, 0.f, 0.f};
#pragma unroll
                for (int ks = 0; ks < 4; ++ks) acc = MFMA16(gb[st][ks], ga[ks], acc);
                const int s0 = st * 16 + (lane >> 4) * 4;
                if (which == 0) { float mf[4], mb[4];
#pragma unroll
                    for (int j = 0; j < 4; ++j) { const int s = s0 + j; mf[j] = s < t ? bft * acc[j] * __expf(gft - gcf[s]) : 0.f; mb[j] = s > t ? bbt * acc[j] * __expf(gbt - gcb[s]) : 0.f; }
                    if (st == tt) { *(LAS f4*)(L + O_D + ((tt * 16 + (lane & 15)) * 16 + (lane >> 4) * 4) * 4) = (f4){mf[0], mf[1], mf[2], mf[3]};
                                    *(LAS f4*)(L + O_D + 4096 + ((tt * 16 + (lane & 15)) * 16 + (lane >> 4) * 4) * 4) = (f4){mb[0], mb[1], mb[2], mb[3]};
#pragma unroll
                                    for (int j = 0; j < 4; ++j) { mf[j] = 0.f; mb[j] = 0.f; } }
                    u2 of, ob; of.x = pk2(mf[0], mf[1]); of.y = pk2(mf[2], mf[3]); ob.x = pk2(mb[0], mb[1]); ob.y = pk2(mb[2], mb[3]);
                    *(LAS u2*)(L + O_MO + t * 144 + s0 * 2) = of; *(LAS u2*)(L + O_MO + 9216 + t * 144 + s0 * 2) = ob; }
                else { float vf[4], vb[4];
#pragma unroll
                    for (int j = 0; j < 4; ++j) { const int s = s0 + j; vf[j] = s <= t ? acc[j] * __expf(gft - gcf[s]) : 0.f; vb[j] = s >= t ? acc[j] * __expf(gbt - gcb[s]) : 0.f; }
                    u2 of, ob; of.x = pk2(vf[0], vf[1]); of.y = pk2(vf[2], vf[3]); ob.x = pk2(vb[0], vb[1]); ob.y = pk2(vb[2], vb[3]);
                    *(LAS u2*)(L + O_A + t * 144 + s0 * 2) = of; *(LAS u2*)(L + O_A + 9216 + t * 144 + s0 * 2) = ob; }
            }
        }
        __syncthreads();
        {
            const LAS float* btx = sdir ? btb : btf; const LAS float* egx = sdir ? egb : egf;
            LAS unsigned char* sp = L + O_SOL + (sdir * 256 + scol) * 144;
            const int mdir = w >> 2, mq = w & 3;
float rhn[16];
            { const int q0 = sdir ? 3 : 0;
#pragma unroll
                for (int ii = 0; ii < 16; ++ii) rhn[ii] = rp[(size_t)(16 * q0 + ii) * 1536]; }
#define GDN_ROUND(RR) { constexpr int R = RR; \
                constexpr int qf = R, qb = 3 - R; \
                if constexpr (R > 0) { \
                    const int q = mdir ? qb : qf; \
                    const LAS unsigned char* Mo = L + O_MO + mdir * 9216; const LAS unsigned char* So = L + O_SOL + mdir * 36864; \
                    const bf16x8 m0 = ldfrag(Mo, 144, q * 16, 0, lane), m1 = ldfrag(Mo, 144, q * 16, 1, lane); \
                    _Pragma("unroll") for (int ct = 0; ct < 4; ++ct) { const int ctile = mq * 4 + ct; f32x4 acc = {0.f, 0.f, 0.f, 0.f}; \
                        acc = MFMA16(m0, ldfrag(So, 144, ctile * 16, 0, lane), acc); acc = MFMA16(m1, ldfrag(So, 144, ctile * 16, 1, lane), acc); \
                        *(LAS f32x4*)(L + O_R1 + ((mdir * 256 + ctile * 16 + (lane & 15)) * 16 + (lane >> 4) * 4) * 4) = acc; } \
                    __syncthreads(); \
                } \
                const int q = sdir ? qb : qf; \
                float x[16]; \
                _Pragma("unroll") for (int ii = 0; ii < 16; ++ii) { const int t = 16 * q + ii; float v = rhn[ii] * btx[t]; if (scol >= 128) v *= egx[t]; x[ii] = v; } \
                if constexpr (R < 3) { const int qn = sdir ? qb - 1 : qf + 1; _Pragma("unroll") for (int ii = 0; ii < 16; ++ii) rhn[ii] = rp[(size_t)(16 * qn + ii) * 1536]; } \
                if constexpr (R > 0) { const LAS f4* cb = (const LAS f4*)(L + O_R1 + (sdir * 256 + scol) * 64); \
                    _Pragma("unroll") for (int i4 = 0; i4 < 4; ++i4) { const f4 cv = cb[i4]; x[4 * i4] -= cv.x; x[4 * i4 + 1] -= cv.y; x[4 * i4 + 2] -= cv.z; x[4 * i4 + 3] -= cv.w; } } \
                const LAS float* Dp = (const LAS float*)(L + O_D + sdir * 4096) + q * 256; \
                if (sdir == 0) { \
                    _Pragma("unroll") for (int ii = 1; ii < 16; ++ii) { float a = x[ii]; \
                        _Pragma("unroll") for (int j4 = 0; j4 < 16; j4 += 4) if (j4 < ii) { const f4 m = *(const LAS f4*)(Dp + ii * 16 + j4); \
                            _Pragma("unroll") for (int jj = 0; jj < 4; ++jj) if (j4 + jj < ii) a -= m[jj] * x[j4 + jj]; } \
                        x[ii] = a; } \
                } else { \
                    _Pragma("unroll") for (int ii = 14; ii >= 0; --ii) { float a = x[ii]; \
                        _Pragma("unroll") for (int j4 = 0; j4 < 16; j4 += 4) if (j4 + 3 > ii) { const f4 m = *(const LAS f4*)(Dp + ii * 16 + j4); \
                            _Pragma("unroll") for (int jj = 0; jj < 4; ++jj) if (j4 + jj > ii) a -= m[jj] * x[j4 + jj]; } \
                        x[ii] = a; } \
                } \
                u4 o0, o1; o0.x = pk2(x[0], x[1]); o0.y = pk2(x[2], x[3]); o0.z = pk2(x[4], x[5]); o0.w = pk2(x[6], x[7]); o1.x = pk2(x[8], x[9]); o1.y = pk2(x[10], x[11]); o1.z = pk2(x[12], x[13]); o1.w = pk2(x[14], x[15]); \
                *(LAS u4*)(sp + q * 32) = o0; *(LAS u4*)(sp + q * 32 + 16) = o1; \
                __syncthreads(); \
            }
            GDN_ROUND(0) GDN_ROUND(1) GDN_ROUND(2) GDN_ROUND(3)
#undef GDN_ROUND
        }
        for (int idx = tid; idx < 4096; idx += NTHREADS) { const int dir = idx >> 11, t = (idx >> 5) & 63, d4 = (idx & 31) * 4;
            const f4 kv = *(const f4*)(GQ + (size_t)(row0 + t) * 1536 + 512 + h * 128 + d4);
            const float sc = dir ? __expf(gcb[0] - gcb[t]) : __expf(gcf[63] - gcf[t]);
            LAS bf16* dst = (LAS bf16*)(L + O_R1 + dir * 18432) + t;
            dst[(d4 + 0) * 72] = (bf16)f2bf(kv.x * sc); dst[(d4 + 1) * 72] = (bf16)f2bf(kv.y * sc); dst[(d4 + 2) * 72] = (bf16)f2bf(kv.z * sc); dst[(d4 + 3) * 72] = (bf16)f2bf(kv.w * sc); }
        __syncthreads();
        {
            const int dir = w >> 2, wq = w & 3, ud = (bh * UDS + blk) * 2 + dir;
            const LAS unsigned char* Aa = L + O_A + dir * 9216; const LAS unsigned char* SolU = L + O_SOL + dir * 256 * 144; const LAS unsigned char* SolW = SolU + 128 * 144;
            const LAS unsigned char* Kd = L + O_R1 + dir * 18432;
            const LAS float* egx = dir ? egb : egf;
            const bf16x8 a0 = ldfrag(Aa, 144, wq * 16, 0, lane), a1 = ldfrag(Aa, 144, wq * 16, 1, lane);
            const int t = wq * 16 + (lane & 15); const float eg = egx[t];
            bf16* qp = c.GDQP() + (size_t)ud * 8192 + ((size_t)(wq * 4) * 64 + (lane & 15) + 16 * (lane >> 5)) * 8 + ((lane >> 4) & 1) * 4; bf16* o0 = c.GDO0() + ((size_t)ud * 64 + t) * 128 + (lane >> 4) * 4;
            const float* qsrc = GQ + (size_t)(row0 + t) * 1536 + h * 128 + (lane >> 4) * 4;
            const bf16x8 kd[2][2] = {{ldfrag(Kd, 144, (2 * wq) * 16, 0, lane), ldfrag(Kd, 144, (2 * wq) * 16, 1, lane)}, {ldfrag(Kd, 144, (2 * wq + 1) * 16, 0, lane), ldfrag(Kd, 144, (2 * wq + 1) * 16, 1, lane)}};
            {
                bf16x8 fw[8][2];
#pragma unroll
                for (int nt = 0; nt < 8; ++nt) { fw[nt][0] = ldfrag(SolW, 144, nt * 16, 0, lane); fw[nt][1] = ldfrag(SolW, 144, nt * 16, 1, lane); }
                __builtin_amdgcn_sched_barrier(0);
#pragma unroll
                for (int nt = 0; nt < 8; ++nt) { f32x4 acc = {0.f, 0.f, 0.f, 0.f};
                    acc = MFMA16(fw[nt][0], a0, acc); acc = MFMA16(fw[nt][1], a1, acc);
                    const f4 qv = *(const f4*)(qsrc + nt * 16);
                    u2 o; o.x = pk2(qv.x * eg - acc[0], qv.y * eg - acc[1]); o.y = pk2(qv.z * eg - acc[2], qv.w * eg - acc[3]);
                    *(u2*)(qp + ((nt >> 1) * 64 + 32 * (nt & 1)) * 8) = o; }
#pragma unroll
                for (int dt2 = 0; dt2 < 2; ++dt2) { const int dtile = 2 * wq + dt2;
                    bf16* ap = c.GDAP() + (size_t)ud * 16384 + ((size_t)(dtile * 4) * 64 + (lane & 15) + 16 * (lane >> 5)) * 8 + ((lane >> 4) & 1) * 4;
#pragma unroll
                    for (int nt = 0; nt < 8; ++nt) { f32x4 acc = {0.f, 0.f, 0.f, 0.f};
                        acc = MFMA16(fw[nt][0], kd[dt2][0], acc); acc = MFMA16(fw[nt][1], kd[dt2][1], acc);
                        u2 o; o.x = pk2(-acc[0], -acc[1]); o.y = pk2(-acc[2], -acc[3]); *(u2*)(ap + ((nt >> 1) * 64 + 32 * (nt & 1)) * 8) = o; } }
            }
            {
                bf16x8 fu[8][2];
                __builtin_amdgcn_sched_barrier(0);
#pragma unroll
                for (int nt = 0; nt < 8; ++nt) { fu[nt][0] = ldfrag(SolU, 144, nt * 16, 0, lane); fu[nt][1] = ldfrag(SolU, 144, nt * 16, 1, lane); }
                __builtin_amdgcn_sched_barrier(0);
#pragma unroll
                for (int nt = 0; nt < 8; ++nt) { f32x4 acc = {0.f, 0.f, 0.f, 0.f};
                    acc = MFMA16(fu[nt][0], a0, acc); acc = MFMA16(fu[nt][1], a1, acc);
                    u2 ob; ob.x = pk2(acc[0], acc[1]); ob.y = pk2(acc[2], acc[3]); *(u2*)(o0 + nt * 16) = ob; }
#pragma unroll
                for (int dt2 = 0; dt2 < 2; ++dt2) { const int dtile = 2 * wq + dt2;
                    bf16* bm = c.GDBM() + ((size_t)ud * 128 + (lane & 15)) * 128 + dtile * 16 + (lane >> 4) * 4;
#pragma unroll
                    for (int nt = 0; nt < 8; ++nt) { f32x4 acc = {0.f, 0.f, 0.f, 0.f};
                        acc = MFMA16(kd[dt2][0], fu[nt][0], acc); acc = MFMA16(kd[dt2][1], fu[nt][1], acc);
                        u2 bb; bb.x = pk2(acc[0], acc[1]); bb.y = pk2(acc[2], acc[3]); *(u2*)(bm + (size_t)nt * 16 * 128) = bb; } }
            }
            if ((tid & 255) == 0) c.GDGL()[ud] = dir ? egb[0] : egf[63];
        }
    }
}

struct GdnSet { bf16x8 fa[4]; u2 bm[2]; float gl; };
__device__ __forceinline__ f32x4 bf4_to_f32(u2 v) { return (f32x4){bf2f(v.x & 0xffffu), bf2f(v.x >> 16), bf2f(v.y & 0xffffu), bf2f(v.y >> 16)}; }
template <int MODE> __device__ __forceinline__ void gdn_scan2(const Ctx& c, int b, int h, int dir, int eq) {
    LAS unsigned char* L = (LAS unsigned char*)c.lds;
    constexpr int O_ST = 0, STB = 32 * 272;
    int tid = c.tid; asm volatile("" : "+v"(tid));
    const int lane = tid & 63, w = __builtin_amdgcn_readfirstlane(tid >> 6);
    f32x4 S[2];
    S[0] = (f32x4){0.f, 0.f, 0.f, 0.f}; S[1] = S[0];
    __syncthreads();
    for (int i = tid; i < 2 * STB / 16; i += NTHREADS) *(LAS u4*)(L + O_ST + i * 16) = (u4){0u, 0u, 0u, 0u};
    const int udb = (b * 4 + h) * UDS;
    const int gst_off = ((eq * 2 * 4 + (w >> 1)) * 64 + (lane & 15) + 16 * ((w & 1) * 2 + (lane >> 5))) * 8 + ((lane >> 4) & 1) * 4;
    { bf16* g0 = c.GDST() + (size_t)((udb + scan_blk(0, dir)) * 2 + dir) * 16384 + gst_off; *(u2*)g0 = (u2){0u, 0u}; *(u2*)(g0 + 4 * 64 * 8) = (u2){0u, 0u}; }
    GdnSet s0, s1, s2, s3, s4;
    int vzero = 0; asm volatile("" : "+v"(vzero));
#define GDN_LOAD(SET, sn) { const int udn = (udb + scan_blk((sn), dir)) * 2 + dir; \
        const bf16* ga = c.GDAP() + (size_t)udn * 16384 + ((size_t)(w * 4) * 64 + lane) * 8; \
        _Pragma("unroll") for (int ks = 0; ks < 4; ++ks) SET.fa[ks] = *(const bf16x8*)(ga + ks * 512); \
        const bf16* bmn = c.GDBM() + ((size_t)udn * 128 + eq * 32 + (lane & 15)) * 128 + w * 16 + (lane >> 4) * 4; \
        SET.bm[0] = *(const u2*)bmn; SET.bm[1] = *(const u2*)(bmn + 16 * 128); \
        SET.gl = c.GDGL()[udn + vzero]; }
#define GDN_STEP(s, SET) { const int buf = (s) & 1; \
        S[0] = S[0] * SET.gl + bf4_to_f32(SET.bm[0]); S[1] = S[1] * SET.gl + bf4_to_f32(SET.bm[1]); \
        RAW_BAR(); \
        const LAS unsigned char* ST = L + O_ST + buf * STB; \
        bf16x8 fs[2][4]; \
        _Pragma("unroll") for (int ks = 0; ks < 4; ++ks) { fs[0][ks] = ldfrag(ST, 272, 0, ks, lane); fs[1][ks] = ldfrag(ST, 272, 16, ks, lane); } \
        __builtin_amdgcn_sched_barrier(0); asm volatile("s_waitcnt lgkmcnt(0)" ::: "memory"); __builtin_amdgcn_sched_barrier(0); \
        _Pragma("unroll") for (int ks = 0; ks < 4; ++ks) { S[0] = MFMA16(SET.fa[ks], fs[0][ks], S[0]); S[1] = MFMA16(SET.fa[ks], fs[1][ks], S[1]); } \
        if (MODE == 0 || MODE == 2) GDN_LOAD(SET, ((s) + 5 < 68 ? (s) + 5 : 67)) \
        { bf16* gn = c.GDST() + (size_t)((udb + scan_blk(((s) + 1 < 68 ? (s) + 1 : 67), dir)) * 2 + dir) * 16384 + gst_off; \
          _Pragma("unroll") for (int et = 0; et < 2; ++et) { u2 o; o.x = pk2(S[et][0], S[et][1]); o.y = pk2(S[et][2], S[et][3]); \
            *(LAS u2*)(L + O_ST + (buf ^ 1) * STB + (et * 16 + (lane & 15)) * 272 + (w * 16 + (lane >> 4) * 4) * 2) = o; \
            if ((MODE == 0 || MODE == 3) && (s) + 1 < 68) *(u2*)(gn + et * 4 * 64 * 8) = o; } } }
    GDN_LOAD(s0, 0) GDN_LOAD(s1, 1) GDN_LOAD(s2, 2) GDN_LOAD(s3, 3) GDN_LOAD(s4, 4)
    for (int s = 0; s < 65; s += 5) { GDN_STEP(s, s0) GDN_STEP(s + 1, s1) GDN_STEP(s + 2, s2) GDN_STEP(s + 3, s3) GDN_STEP(s + 4, s4) }
    GDN_STEP(65, s0) GDN_STEP(66, s1) GDN_STEP(67, s2)
#undef GDN_LOAD
#undef GDN_STEP
}

__device__ __forceinline__ void gdn_out_unit(const Ctx& c, int l, int b, int h, int blk) {
    int tid = c.tid; asm volatile("" : "+v"(tid));
    const int lane = tid & 63, w = __builtin_amdgcn_readfirstlane(tid >> 6);
    const int tt = w & 3, ehh = w >> 2, t = tt * 16 + (lane & 15), row = blk_row0(b, blk) + t;
    float* red = (float*)c.lds;
    f32x4 acc[4];
#pragma unroll
    for (int i = 0; i < 4; ++i) acc[i] = (f32x4){0.f, 0.f, 0.f, 0.f};
#pragma unroll
    for (int dir = 0; dir < 2; ++dir) { const size_t ud = (size_t)(((b * 4 + h) * UDS + blk) * 2 + dir);
        const bf16* gq = c.GDQP() + ud * 8192 + ((size_t)(tt * 4) * 64 + lane) * 8;
        bf16x8 qf[4], sf[4][4]; u2 o0v[4];
#pragma unroll
        for (int ks = 0; ks < 4; ++ks) qf[ks] = *(const bf16x8*)(gq + ks * 512);
#pragma unroll
        for (int e4 = 0; e4 < 4; ++e4) { const int etile = ehh * 4 + e4; const bf16* gs = c.GDST() + ud * 16384 + ((size_t)(etile * 4) * 64 + lane) * 8;
            o0v[e4] = *(const u2*)(c.GDO0() + (ud * 64 + t) * 128 + etile * 16 + (lane >> 4) * 4);
#pragma unroll
            for (int ks = 0; ks < 4; ++ks) sf[e4][ks] = *(const bf16x8*)(gs + ks * 512); }
        __builtin_amdgcn_sched_barrier(0);
#pragma unroll
        for (int e4 = 0; e4 < 4; ++e4) { acc[e4] += bf4_to_f32(o0v[e4]);
#pragma unroll
            for (int ks = 0; ks < 4; ++ks) acc[e4] = MFMA16(sf[e4][ks], qf[ks], acc[e4]); }
        __builtin_amdgcn_sched_barrier(0); }
    float ss = 0.f;
#pragma unroll
    for (int e4 = 0; e4 < 4; ++e4) ss += acc[e4][0] * acc[e4][0] + acc[e4][1] * acc[e4][1] + acc[e4][2] * acc[e4][2] + acc[e4][3] * acc[e4][3];
    ss += __shfl_xor(ss, 16); ss += __shfl_xor(ss, 32);
    __syncthreads();
    if (lane < 16) red[ehh * 64 + t] = ss;
    __syncthreads();
    const float rstd = 1.0f / sqrtf((red[t] + red[64 + t]) * (1.0f / 128.f) + 1e-6f);
    const float* nw = c.gdn_norm_w() + l * 128;
#pragma unroll
    for (int e4 = 0; e4 < 4; ++e4) { const int e0 = (ehh * 4 + e4) * 16 + (lane >> 4) * 4;
        const u2 zr = *(const u2*)(c.P() + (size_t)row * NP + PC_GDZ + h * 128 + e0); const f32x4 z = bf4_to_f32(zr); const f4 nv = *(const f4*)(nw + e0);
        u2 o; o.x = pk2(acc[e4][0] * rstd * nv.x * silu_f(z[0]), acc[e4][1] * rstd * nv.y * silu_f(z[1])); o.y = pk2(acc[e4][2] * rstd * nv.z * silu_f(z[2]), acc[e4][3] * rstd * nv.w * silu_f(z[3]));
        *(u2*)(c.CAT() + (size_t)row * D + 1536 + h * 128 + e0) = o; }
}
__device__ __forceinline__ void gla_out_unit(const Ctx& c, int l, int b, int h, int blk);
__device__ __forceinline__ void ph_combine2(const Ctx& c, int l) {
    const int nb = l == 0 ? 68 : 64, nunit = 8 * nb;
    for (int u = blockIdx.x; u < 2 * nunit; u += gridDim.x) { const int kind = u >= nunit, uu = kind ? u - nunit : u, bh = uu / nb, blk = (uu % nb) + (68 - nb);
        if (kind == 0) gdn_out_unit(c, l, bh >> 2, bh & 3, blk); else gla_out_unit(c, l, bh >> 2, bh & 3, blk); }
}

__device__ __forceinline__ void gla_scan2(const Ctx& c, int b, int h, int dir, int eh) {
    LAS unsigned char* L = (LAS unsigned char*)c.lds;
    constexpr int O_QT = 0, O_KT = 9216, O_KH = 18432, O_VT = 27648, O_ATT = 36864, O_ST = 46080, O_CP = 64512, O_DEC = O_CP + 2048;
    const int tid = c.tid, lane = c.lane, w = c.wave, d = tid & 63, part = tid >> 6;
    LAS float* CP = (LAS float*)(L + O_CP); LAS float* DEC = (LAS float*)(L + O_DEC);
    const float* LQp = c.LQ(); const float* LKp = c.LK(); const float* LAp = c.LA() + (size_t)dir * MROWS * 256; const bf16* Pp = c.P();
    f32x4 S[2];
    S[0] = (f32x4){0.f, 0.f, 0.f, 0.f}; S[1] = S[0];
    __syncthreads();
    for (int i = tid; i < 9216 / 16; i += NTHREADS) *(LAS u4*)(L + O_ST + i * 16) = (u4){0u, 0u, 0u, 0u};
    float la[8], qv[8], kv[8]; unsigned vv[8];
    { const int row0 = blk_row0(b, scan_blk(0, dir));
#pragma unroll
        for (int ii = 0; ii < 8; ++ii) { const int i = part * 8 + ii, row = row0 + (dir ? 63 - i : i);
            la[ii] = LAp[(size_t)row * 256 + h * 64 + d]; qv[ii] = LQp[(size_t)row * 256 + h * 64 + d]; kv[ii] = LKp[(size_t)row * 256 + h * 64 + d]; vv[ii] = Pp[(size_t)row * NP + PC_GLV + h * 128 + eh * 64 + d]; } }
    for (int s = 0; s < 68; ++s) {
        const int blk = scan_blk(s, dir), row0 = blk_row0(b, blk), buf = s & 1;
        float p[8]; float run = 0.f;
#pragma unroll
        for (int ii = 0; ii < 8; ++ii) { run += la[ii]; p[ii] = run; }
        CP[part * 64 + d] = run;
        RAW_BAR();
        float off = 0.f, tot = 0.f;
#pragma unroll
        for (int pp = 0; pp < 8; ++pp) { const float xx = CP[pp * 64 + d]; tot += xx; off += (pp < part) ? xx : 0.f; }
        unsigned kh[8];
#pragma unroll
        for (int ii = 0; ii < 8; ++ii) { const float cum = off + p[ii]; const int i = part * 8 + ii;
            *(LAS bf16*)(L + O_QT + i * 144 + d * 2) = (bf16)f2bf(qv[ii] * __expf(cum)); *(LAS bf16*)(L + O_KT + i * 144 + d * 2) = (bf16)f2bf(kv[ii] * __expf(-cum)); kh[ii] = f2bf(kv[ii] * __expf(tot - cum)); }
        { u4 o; o.x = kh[0] | (kh[1] << 16); o.y = kh[2] | (kh[3] << 16); o.z = kh[4] | (kh[5] << 16); o.w = kh[6] | (kh[7] << 16); *(LAS u4*)(L + O_KH + d * 144 + part * 16) = o;
          u4 v; v.x = vv[0] | (vv[1] << 16); v.y = vv[2] | (vv[3] << 16); v.z = vv[4] | (vv[5] << 16); v.w = vv[6] | (vv[7] << 16); *(LAS u4*)(L + O_VT + d * 144 + part * 16) = v; }
        if (part == 0) DEC[d] = __expf(tot);
        if (s + 1 < 68) { const int rown = blk_row0(b, scan_blk(s + 1, dir));
#pragma unroll
            for (int ii = 0; ii < 8; ++ii) { const int i = part * 8 + ii, row = rown + (dir ? 63 - i : i);
                la[ii] = LAp[(size_t)row * 256 + h * 64 + d]; qv[ii] = LQp[(size_t)row * 256 + h * 64 + d]; kv[ii] = LKp[(size_t)row * 256 + h * 64 + d]; vv[ii] = Pp[(size_t)row * NP + PC_GLV + h * 128 + eh * 64 + d]; } }
        RAW_BAR();
        const int tt = w & 3, wh = w >> 2, ti = tt * 16 + (lane & 15);
#pragma unroll
        for (int i2 = 0; i2 < 2; ++i2) { const int st = 2 * wh + i2; f32x4 acc = {0.f, 0.f, 0.f, 0.f};
#pragma unroll
            for (int ks = 0; ks < 2; ++ks) acc = MFMA16(ldfrag(L + O_KT, 144, st * 16, ks, lane), ldfrag(L + O_QT, 144, tt * 16, ks, lane), acc);
            const int s0 = st * 16 + (lane >> 4) * 4;
            u2 o; o.x = pk2(s0 + 0 <= ti ? acc[0] : 0.f, s0 + 1 <= ti ? acc[1] : 0.f); o.y = pk2(s0 + 2 <= ti ? acc[2] : 0.f, s0 + 3 <= ti ? acc[3] : 0.f);
            *(LAS u2*)(L + O_ATT + ti * 144 + s0 * 2) = o; }
        RAW_BAR();
        { const int trow = row0 + (dir ? 63 - ti : ti); float* og = c.OGLA() + ((size_t)dir * MROWS + trow) * 512 + h * 128 + eh * 64 + (lane >> 4) * 4;
            const LAS unsigned char* ST = L + O_ST + buf * 9216;
#pragma unroll
            for (int i2 = 0; i2 < 2; ++i2) { const int et = 2 * wh + i2; f32x4 acc = {0.f, 0.f, 0.f, 0.f};
#pragma unroll
                for (int ks = 0; ks < 2; ++ks) acc = MFMA16(ldfrag(L + O_VT, 144, et * 16, ks, lane), ldfrag(L + O_ATT, 144, tt * 16, ks, lane), acc);
#pragma unroll
                for (int ks = 0; ks < 2; ++ks) acc = MFMA16(ldfrag(ST, 144, et * 16, ks, lane), ldfrag(L + O_QT, 144, tt * 16, ks, lane), acc);
                *(f32x4*)(og + et * 16) = acc; }
            const f4 dec = *(const LAS f4*)(DEC + tt * 16 + (lane >> 4) * 4);
#pragma unroll
            for (int i2 = 0; i2 < 2; ++i2) { const int et = 2 * wh + i2; S[i2] = S[i2] * dec;
#pragma unroll
                for (int ks = 0; ks < 2; ++ks) S[i2] = MFMA16(ldfrag(L + O_KH, 144, tt * 16, ks, lane), ldfrag(L + O_VT, 144, et * 16, ks, lane), S[i2]);
                u2 o; o.x = pk2(S[i2][0], S[i2][1]); o.y = pk2(S[i2][2], S[i2][3]);
                *(LAS u2*)(L + O_ST + (buf ^ 1) * 9216 + (et * 16 + (lane & 15)) * 144 + (tt * 16 + (lane >> 4) * 4) * 2) = o; } }
    }
}

__device__ __forceinline__ void gla_tiles_unit(const Ctx& c, int lsel, int ud) {
    LAS unsigned char* L = (LAS unsigned char*)c.lds;
    constexpr int O_QT = 0, O_KT = 9216, O_KH = 18432, O_VT = 27648, O_CP = 46080;
    int tid = c.tid; asm volatile("" : "+v"(tid));
    const int d = tid & 63, part = tid >> 6;
    const int dir = ud & 1, blk = (ud >> 1) % UDS, bh = (ud >> 1) / UDS, b = bh >> 2, h = bh & 3, row0 = blk_row0(b, blk);
    LAS float* CP = (LAS float*)(L + O_CP);
    const bf16* Pp = c.P();
    float la[8], qv[8], kv[8];
    { const float* gwp = c.gla_gate_w() + ((size_t)(lsel * 2 + dir) * 16) * 256 + h * 64 + d; const float gbias = c.gla_gate_b()[(size_t)(lsel * 2 + dir) * 256 + h * 64 + d];
        float gwv[16];
#pragma unroll
        for (int r = 0; r < 16; ++r) gwv[r] = gwp[(size_t)r * 256];
        const bool latent = blk >= 4; const int half = d >> 5, fi = d & 15; const bool lo = (d & 16) == 0;
        unsigned qraw[8], kraw[8];
#pragma unroll
        for (int ii = 0; ii < 8; ++ii) { const int i = part * 8 + ii, row = row0 + (dir ? 63 - i : i);
            qraw[ii] = Pp[(size_t)row * NP + PC_GLQ + h * 64 + d]; kraw[ii] = Pp[(size_t)row * NP + PC_GLK + h * 64 + d]; }
#pragma unroll
        for (int ii = 0; ii < 8; ++ii) { const int i = part * 8 + ii, tk = dir ? 63 - i : i, row = row0 + tk;
            float q = bf2f(qraw[ii]), k = bf2f(kraw[ii]);
            const float qo = __shfl_xor(q, 16), ko = __shfl_xor(k, 16);
            if (latent) { const int t = (blk - 4) * 64 + tk, pos = half ? (t & 63) : (t >> 6); const float cs = c.ROPE()[(pos * 16 + fi) * 2], sn = c.ROPE()[(pos * 16 + fi) * 2 + 1];
                q = lo ? q * cs - qo * sn : q * cs + qo * sn; k = lo ? k * cs - ko * sn : k * cs + ko * sn; }
            qv[ii] = q * 0.125f; kv[ii] = k;
            const float* ps = c.PS() + (size_t)row * 64 + dir * 16; float z = gbias;
#pragma unroll
            for (int r = 0; r < 16; ++r) z += ps[r] * gwv[r];
            la[ii] = logsigmoid_f(z) * 0.0625f; } }
    unsigned vv[16];
    { const int e = tid & 127, qtr = tid >> 7;
#pragma unroll
        for (int ii = 0; ii < 16; ++ii) { const int i = qtr * 16 + ii, row = row0 + (dir ? 63 - i : i); vv[ii] = Pp[(size_t)row * NP + PC_GLV + h * 128 + e]; } }
    float p[8]; float run = 0.f;
#pragma unroll
    for (int ii = 0; ii < 8; ++ii) { run += la[ii]; p[ii] = run; }
    __syncthreads();
    CP[part * 64 + d] = run;
    __syncthreads();
    float off = 0.f, tot = 0.f;
#pragma unroll
    for (int pp = 0; pp < 8; ++pp) { const float xx = CP[pp * 64 + d]; tot += xx; off += (pp < part) ? xx : 0.f; }
    unsigned kh[8];
#pragma unroll
    for (int ii = 0; ii < 8; ++ii) { const float cum = off + p[ii]; const int i = part * 8 + ii;
        *(LAS bf16*)(L + O_QT + i * 144 + d * 2) = (bf16)f2bf(qv[ii] * __expf(cum)); *(LAS bf16*)(L + O_KT + i * 144 + d * 2) = (bf16)f2bf(kv[ii] * __expf(-cum)); kh[ii] = f2bf(kv[ii] * __expf(tot - cum)); }
    { u4 o; o.x = kh[0] | (kh[1] << 16); o.y = kh[2] | (kh[3] << 16); o.z = kh[4] | (kh[5] << 16); o.w = kh[6] | (kh[7] << 16); *(LAS u4*)(L + O_KH + d * 144 + part * 16) = o; }
    { const int e = tid & 127, qtr = tid >> 7; u4 v0, v1;
        v0.x = vv[0] | (vv[1] << 16); v0.y = vv[2] | (vv[3] << 16); v0.z = vv[4] | (vv[5] << 16); v0.w = vv[6] | (vv[7] << 16);
        v1.x = vv[8] | (vv[9] << 16); v1.y = vv[10] | (vv[11] << 16); v1.z = vv[12] | (vv[13] << 16); v1.w = vv[14] | (vv[15] << 16);
        *(LAS u4*)(L + O_VT + e * 144 + qtr * 32) = v0; *(LAS u4*)(L + O_VT + e * 144 + qtr * 32 + 16) = v1; }
    if (part == 0) c.GLDEC()[(size_t)ud * 64 + d] = __expf(tot);
    __syncthreads();
    { const int f = tid >> 6, lp = tid & 63, r = (f >> 1) * 16 + (lp & 15), kc = (f & 1) * 4 + (lp >> 4);
        *(u4*)(c.GLQT() + (size_t)ud * 4096 + tid * 8) = *(const LAS u4*)(L + O_QT + r * 144 + kc * 16);
        *(u4*)(c.GLKT() + (size_t)ud * 4096 + tid * 8) = *(const LAS u4*)(L + O_KT + r * 144 + kc * 16);
        *(u4*)(c.GLKH() + (size_t)ud * 4096 + tid * 8) = *(const LAS u4*)(L + O_KH + r * 144 + kc * 16);
#pragma unroll
        for (int hh = 0; hh < 2; ++hh) { const int j = tid + 512 * hh, f2 = j >> 6, r2 = (f2 >> 1) * 16 + (lp & 15), kc2 = (f2 & 1) * 4 + (lp >> 4);
            *(u4*)(c.GLVT() + (size_t)ud * 8192 + j * 8) = *(const LAS u4*)(L + O_VT + r2 * 144 + kc2 * 16); } }
}

struct GlaSet { bf16x8 vt[2][2], kh[2]; f4 dec; };
__device__ __forceinline__ void gla_scan3(const Ctx& c, int b, int h, int dir, int eh) {
    int tid = c.tid; asm volatile("" : "+v"(tid));
    const int lane = tid & 63, w = __builtin_amdgcn_readfirstlane(tid >> 6);
    const int tt = w & 3, wh = w >> 2;
    f32x4 S[2];
    S[0] = (f32x4){0.f, 0.f, 0.f, 0.f}; S[1] = S[0];
    const int udb = (b * 4 + h) * UDS;
    const int gst_off = (((eh * 4 + 2 * wh) * 2 + (tt >> 1)) * 64 + (lane & 15) + 16 * ((tt & 1) * 2 + (lane >> 5))) * 8 + ((lane >> 4) & 1) * 4;
    { bf16* g0 = c.GLST() + (size_t)((udb + scan_blk(0, dir)) * 2 + dir) * 8192 + gst_off; *(u2*)g0 = (u2){0u, 0u}; *(u2*)(g0 + 2 * 64 * 8) = (u2){0u, 0u}; }
    GlaSet s0, s1, s2, s3, s4;
#define GLA_LOAD(SET, sn) { const size_t udn = (size_t)((udb + scan_blk((sn), dir)) * 2 + dir); \
        _Pragma("unroll") for (int ks = 0; ks < 2; ++ks) { \
            SET.kh[ks] = *(const bf16x8*)(c.GLKH() + udn * 4096 + ((tt * 2 + ks) * 64 + lane) * 8); \
            _Pragma("unroll") for (int i2 = 0; i2 < 2; ++i2) SET.vt[i2][ks] = *(const bf16x8*)(c.GLVT() + udn * 8192 + (((eh * 4 + 2 * wh + i2) * 2 + ks) * 64 + lane) * 8); } \
        SET.dec = *(const f4*)(c.GLDEC() + udn * 64 + tt * 16 + (lane >> 4) * 4); }
#define GLA_STEP(s, SET) { \
        _Pragma("unroll") for (int i2 = 0; i2 < 2; ++i2) { S[i2] = S[i2] * SET.dec; S[i2] = MFMA16(SET.kh[0], SET.vt[i2][0], S[i2]); S[i2] = MFMA16(SET.kh[1], SET.vt[i2][1], S[i2]); } \
        GLA_LOAD(SET, ((s) + 5 < 68 ? (s) + 5 : 67)) \
        if ((s) + 1 < 68) { bf16* gn = c.GLST() + (size_t)((udb + scan_blk((s) + 1, dir)) * 2 + dir) * 8192 + gst_off; \
            _Pragma("unroll") for (int i2 = 0; i2 < 2; ++i2) { u2 o; o.x = pk2(S[i2][0], S[i2][1]); o.y = pk2(S[i2][2], S[i2][3]); *(u2*)(gn + i2 * 2 * 64 * 8) = o; } } }
    GLA_LOAD(s0, 0) GLA_LOAD(s1, 1) GLA_LOAD(s2, 2) GLA_LOAD(s3, 3) GLA_LOAD(s4, 4)
    for (int s = 0; s < 65; s += 5) { GLA_STEP(s, s0) GLA_STEP(s + 1, s1) GLA_STEP(s + 2, s2) GLA_STEP(s + 3, s3) GLA_STEP(s + 4, s4) }
    GLA_STEP(65, s0) GLA_STEP(66, s1) GLA_STEP(67, s2)
#undef GLA_LOAD
#undef GLA_STEP
}

__device__ __forceinline__ void gla_out_unit(const Ctx& c, int l, int b, int h, int blk) {
    LAS unsigned char* L = (LAS unsigned char*)c.lds;
    constexpr int O_ATT = 0, O_O = 9216, OST = 132;
    int tid = c.tid; asm volatile("" : "+v"(tid));
    const int lane = tid & 63, w = __builtin_amdgcn_readfirstlane(tid >> 6);
    const int tt = w & 3, ehh = w >> 2, ti = tt * 16 + (lane & 15), row0 = blk_row0(b, blk);
    LAS float* Ob = (LAS float*)(L + O_O);
#pragma unroll 1
    for (int dir = 0; dir < 2; ++dir) { const size_t ud = (size_t)(((b * 4 + h) * UDS + blk) * 2 + dir);
        const bf16x8 q0 = *(const bf16x8*)(c.GLQT() + ud * 4096 + ((tt * 2 + 0) * 64 + lane) * 8), q1 = *(const bf16x8*)(c.GLQT() + ud * 4096 + ((tt * 2 + 1) * 64 + lane) * 8);
        __syncthreads();
        bf16x8 vf[4][2], sf[4][2];
#pragma unroll
        for (int e4 = 0; e4 < 4; ++e4) { const int etile = ehh * 4 + e4;
            const bf16* gv = c.GLVT() + ud * 8192 + ((size_t)(etile * 2) * 64 + lane) * 8; const bf16* gs = c.GLST() + ud * 8192 + ((size_t)(etile * 2) * 64 + lane) * 8;
            vf[e4][0] = *(const bf16x8*)gv; vf[e4][1] = *(const bf16x8*)(gv + 512); sf[e4][0] = *(const bf16x8*)gs; sf[e4][1] = *(const bf16x8*)(gs + 512); }
        if (ehh == 0) {
            bf16x8 kf[4][2];
#pragma unroll
            for (int st = 0; st < 4; ++st) { kf[st][0] = *(const bf16x8*)(c.GLKT() + ud * 4096 + ((st * 2 + 0) * 64 + lane) * 8); kf[st][1] = *(const bf16x8*)(c.GLKT() + ud * 4096 + ((st * 2 + 1) * 64 + lane) * 8); }
#pragma unroll
            for (int st = 0; st < 4; ++st) { f32x4 acc = {0.f, 0.f, 0.f, 0.f};
                acc = MFMA16(kf[st][0], q0, acc); acc = MFMA16(kf[st][1], q1, acc);
                const int s0i = st * 16 + (lane >> 4) * 4;
                u2 o; o.x = pk2(s0i + 0 <= ti ? acc[0] : 0.f, s0i + 1 <= ti ? acc[1] : 0.f); o.y = pk2(s0i + 2 <= ti ? acc[2] : 0.f, s0i + 3 <= ti ? acc[3] : 0.f);
                *(LAS u2*)(L + O_ATT + ti * 144 + s0i * 2) = o; } }
        __syncthreads();
        const bf16x8 at0 = ldfrag(L + O_ATT, 144, tt * 16, 0, lane), at1 = ldfrag(L + O_ATT, 144, tt * 16, 1, lane);
        const int tok = dir ? 63 - ti : ti;
#pragma unroll
        for (int e4 = 0; e4 < 4; ++e4) { const int etile = ehh * 4 + e4; f32x4 acc = {0.f, 0.f, 0.f, 0.f};
            acc = MFMA16(vf[e4][0], at0, acc); acc = MFMA16(vf[e4][1], at1, acc);
            acc = MFMA16(sf[e4][0], q0, acc); acc = MFMA16(sf[e4][1], q1, acc);
            LAS float* op = Ob + tok * OST + etile * 16 + (lane >> 4) * 4;
            if (dir == 0) *(LAS f32x4*)op = acc; else { const f32x4 prev = *(LAS f32x4*)op; *(LAS f32x4*)op = prev + acc; } }
    }
    __syncthreads();
    const float* nw = c.gla_norm_w() + l * 128;
    unsigned grv[8];
#pragma unroll
    for (int i = 0; i < 8; ++i) grv[i] = *(const unsigned*)(c.P() + (size_t)(row0 + w * 8 + i) * NP + PC_GLG + h * 128 + 2 * lane);
    const float nw0 = nw[2 * lane], nw1 = nw[2 * lane + 1];
#pragma unroll
    for (int i = 0; i < 8; ++i) { const int tok = w * 8 + i, row = row0 + tok;
        const float o0 = Ob[tok * OST + 2 * lane], o1 = Ob[tok * OST + 2 * lane + 1];
        const float ss = wave_sum(o0 * o0 + o1 * o1);
        const float rstd = 1.0f / sqrtf(ss * (1.0f / 128.f) + 1e-6f);
        const unsigned gr = grv[i];
        *(unsigned*)(c.CAT() + (size_t)row * D + 1024 + h * 128 + 2 * lane) = pk2(o0 * rstd * nw0 * silu_f(bf2f(gr & 0xffffu)), o1 * rstd * nw1 * silu_f(bf2f(gr >> 16))); }
}

__device__ __forceinline__ void ph_scan_na2(const Ctx& c, int l) {
    for (int bt = blockIdx.x; bt < 64; bt += gridDim.x) { const int kind = bt >> 5, dir = (bt >> 4) & 1, b = (bt >> 3) & 1, h = (bt >> 1) & 3, eh = bt & 1;
        if (kind == 0) gla_scan2(c, b, h, dir, eh); else gdn_scan2<0>(c, b, h, dir, eh); }
    __syncthreads();
    const int ntask = ML * 16 + (l == 0 ? MC * 16 : 0), nchunk = ntask / 512;
    int* sh = (int*)(c.lds + MISC_OFF + 64);
    for (;;) {
        __syncthreads();
        if (c.tid == 0) *sh = (int)atomicAdd(c.ctl() + CW_NAQ + 64 * (l + 2 * c.rep), 1u);
        __syncthreads();
        const int ch = *sh;
        if (ch >= nchunk) break;
        for (int i = 0; i < 64; ++i) na_task(c, l, ch * 512 + c.wave * 64 + i, c.lane);
    }
}

__device__ __forceinline__ void na_unit(const Ctx& c, int l, int unit) {
    LAS unsigned char* L = (LAS unsigned char*)c.lds;
    constexpr int VST = 1936, O_VT = 0, O_RPB = 64 * VST + 64, O_KC = O_RPB + 1984, KST = 144, CTXC = 704;
    static_assert(O_KC + 256 * KST <= MISC_OFF, "NA LDS map");
    int tid = c.tid; asm volatile("" : "+v"(tid));
    const int lane = tid & 63, w = __builtin_amdgcn_readfirstlane(tid >> 6);
    const int ql = lane & 15, kg = lane >> 4;
    const bool lat = unit < 512;
    int b, h, r0 = 0, rs0 = 0, nlr = 0, half = 0;
    if (lat) { b = unit >> 8; h = (unit >> 4) & 15; r0 = (unit & 15) * 4; rs0 = min(max(r0 - 4, 0), 56); nlr = min(max(r0 - 1, 0), 56) + 8 - rs0; }
    else { const int u = unit - 512; b = u >> 5; h = (u >> 1) & 15; half = u & 1; }
    const bf16* P = c.P();
    LAS float* RPB = (LAS float*)(L + O_RPB);
    const int g = w & 3;
    int r = lat ? r0 + (w >> 2) : 0;
    int qrow0 = lat ? b * SEQ + r * 64 + 16 * g : ML + b * CTX + half * 128 + w * 16;
    bf16x8 qf0, qf1;
    { const bf16* qp = P + (size_t)(qrow0 + ql) * NP + PC_NAQ + h * 64 + kg * 8; qf0 = *(const bf16x8*)qp; qf1 = *(const bf16x8*)(qp + 32); }
    __syncthreads();
    { const int npl = nlr * 32, npairs = npl + 128;
        u4 va[8], vb[8], kc[4];
#pragma unroll
        for (int it = 0; it < 8; ++it) { const int id = tid + NTHREADS * it, dc = id & 7, pi = id >> 3;
            if (pi < npairs) { const int row = pi < npl ? b * SEQ + rs0 * 64 + 2 * pi : ML + b * CTX + 2 * (pi - npl);
                const bf16* vp = P + (size_t)row * NP + PC_NAV + h * 64 + dc * 8; va[it] = *(const u4*)vp; vb[it] = *(const u4*)(vp + NP); } }
#pragma unroll
        for (int it = 0; it < 4; ++it) { const int id = tid + NTHREADS * it; kc[it] = *(const u4*)(P + (size_t)(ML + b * CTX + (id >> 3)) * NP + PC_NAK + h * 64 + (id & 7) * 8); }
#pragma unroll
        for (int it = 0; it < 8; ++it) { const int id = tid + NTHREADS * it, dc = id & 7, pi = id >> 3;
            if (pi < npairs) { const int col = pi < npl ? 2 * pi : CTXC + 2 * (pi - npl); const u4 a = va[it], bb = vb[it];
                LAS unsigned char* dst = L + O_VT + (dc * 8) * VST + col * 2;
                *(LAS unsigned*)(dst + 0 * VST) = (a.x & 0xffffu) | (bb.x << 16); *(LAS unsigned*)(dst + 1 * VST) = (a.x >> 16) | (bb.x & 0xffff0000u);
                *(LAS unsigned*)(dst + 2 * VST) = (a.y & 0xffffu) | (bb.y << 16); *(LAS unsigned*)(dst + 3 * VST) = (a.y >> 16) | (bb.y & 0xffff0000u);
                *(LAS unsigned*)(dst + 4 * VST) = (a.z & 0xffffu) | (bb.z << 16); *(LAS unsigned*)(dst + 5 * VST) = (a.z >> 16) | (bb.z & 0xffff0000u);
                *(LAS unsigned*)(dst + 6 * VST) = (a.w & 0xffffu) | (bb.w << 16); *(LAS unsigned*)(dst + 7 * VST) = (a.w >> 16) | (bb.w & 0xffff0000u); } }
#pragma unroll
        for (int it = 0; it < 4; ++it) { const int id = tid + NTHREADS * it; *(LAS u4*)(L + O_KC + (id >> 3) * KST + (id & 7) * 16) = kc[it]; }
        if (lat) for (int i = tid; i < 465; i += NTHREADS) RPB[i] = c.na_rpb()[(size_t)(l * 16 + h) * 465 + i] * 1.44269504f; }
    __syncthreads();
#define NA_LOADK(CH, RS) { _Pragma("unroll") for (int tl = 0; tl < 8; ++tl) { const int krow = b * SEQ + ((RS) + 4 * (CH) + (tl >> 1)) * 64 + c0 + 16 * (tl & 1); \
        const unsigned char* kb = (const unsigned char*)(P + (size_t)krow * NP + PC_NAK + h * 64);     \
        kf[tl][0] = *(const bf16x8*)(kb + loff); kf[tl][1] = *(const bf16x8*)(kb + loff + 64); } }
#define NA_QK_G() { _Pragma("unroll") for (int tl = 0; tl < 8; ++tl) { f32x4 acc = {0.f, 0.f, 0.f, 0.f}; acc = MFMA16(kf[tl][0], qf0, acc); acc = MFMA16(kf[tl][1], qf1, acc); S[tl] = acc; } }
#define NA_QK_L(CH) { _Pragma("unroll") for (int hb = 0; hb < 4; ++hb) { bf16x8 kl[2][2]; \
        __builtin_amdgcn_sched_barrier(0); \
        _Pragma("unroll") for (int t4 = 0; t4 < 2; ++t4) { const LAS unsigned char* kp = L + O_KC + (((CH) - 2) * 128 + (hb * 2 + t4) * 16 + ql) * KST + kg * 16; \
            kl[t4][0] = *(const LAS bf16x8*)kp; kl[t4][1] = *(const LAS bf16x8*)(kp + 64); } \
        __builtin_amdgcn_sched_barrier(0); \
        _Pragma("unroll") for (int t4 = 0; t4 < 2; ++t4) { f32x4 acc = {0.f, 0.f, 0.f, 0.f}; acc = MFMA16(kl[t4][0], qf0, acc); acc = MFMA16(kl[t4][1], qf1, acc); S[hb * 2 + t4] = acc; } } }
#define NA_CHUNK(CH, AFTER_QK) { f32x4 S[8]; \
        if ((CH) < 2) NA_QK_G() else NA_QK_L(CH) \
        __builtin_amdgcn_sched_barrier(0); \
        AFTER_QK \
        __builtin_amdgcn_sched_barrier(0); \
        float cm = -INFINITY; \
        _Pragma("unroll") for (int tl = 0; tl < 8; ++tl) _Pragma("unroll") for (int jj = 0; jj < 4; ++jj) { float sv; \
            if ((CH) < 2) { const float bv = rpl[(4 * (CH) + (tl >> 1)) * 31 + 16 * (tl & 1) + jj]; sv = __builtin_fmaf(S[tl][jj], 0.18033688f, vld[(tl & 1) * 4 + jj] ? bv : -INFINITY); } \
            else sv = S[tl][jj] * 0.18033688f; \
            S[tl][jj] = sv; cm = fmaxf(cm, sv); } \
        cm = fmaxf(cm, __shfl_xor(cm, 16)); cm = fmaxf(cm, __shfl_xor(cm, 32)); \
        const float mn = fmaxf(m, cm), alpha = __builtin_amdgcn_exp2f(m - mn); m = mn; \
        lsum *= alpha; \
        _Pragma("unroll") for (int dt = 0; dt < 4; ++dt) O[dt] = O[dt] * alpha; \
        bf16x8 pfr[4]; \
        _Pragma("unroll") for (int s4 = 0; s4 < 4; ++s4) { float p[8]; \
            _Pragma("unroll") for (int jj = 0; jj < 4; ++jj) { p[jj] = __builtin_amdgcn_exp2f(S[2 * s4][jj] - m); p[4 + jj] = __builtin_amdgcn_exp2f(S[2 * s4 + 1][jj] - m); lsum += p[jj] + p[4 + jj]; } \
            u4 pw; pw.x = pk2(p[0], p[1]); pw.y = pk2(p[2], p[3]); pw.z = pk2(p[4], p[5]); pw.w = pk2(p[6], p[7]); \
            pfr[s4] = __builtin_bit_cast(bf16x8, pw); } \
        _Pragma("unroll") for (int sh = 0; sh < 2; ++sh) { bf16x8 vfr[2][4]; \
            __builtin_amdgcn_sched_barrier(0); \
            _Pragma("unroll") for (int s2 = 0; s2 < 2; ++s2) { const int s4 = 2 * sh + s2; \
                const int colA = ((CH) < 2) ? (rs - rs0 + 4 * (CH) + s4) * 64 + c0 + 4 * kg : CTXC + ((CH) - 2) * 128 + 32 * s4 + 4 * kg; \
                _Pragma("unroll") for (int dt = 0; dt < 4; ++dt) { const LAS unsigned char* vp = L + O_VT + (dt * 16 + ql) * VST + colA * 2; \
                    const u2 va = *(const LAS u2*)vp, vb = *(const LAS u2*)(vp + 32); \
                    u4 vw; vw.x = va.x; vw.y = va.y; vw.z = vb.x; vw.w = vb.y; vfr[s2][dt] = __builtin_bit_cast(bf16x8, vw); } } \
            __builtin_amdgcn_sched_barrier(0); \
            _Pragma("unroll") for (int s2 = 0; s2 < 2; ++s2) _Pragma("unroll") for (int dt = 0; dt < 4; ++dt) O[dt] = MFMA16(vfr[s2][dt], pfr[2 * sh + s2], O[dt]); } \
        __builtin_amdgcn_sched_barrier(0); }
#define NA_FINISH() { lsum += __shfl_xor(lsum, 16); lsum += __shfl_xor(lsum, 32); const float inv = 1.0f / lsum; \
        bf16* op = c.CAT() + (size_t)(qrow0 + ql) * D + h * 64 + 4 * kg; \
        _Pragma("unroll") for (int dt = 0; dt < 4; ++dt) { u2 o; o.x = pk2(O[dt][0] * inv, O[dt][1] * inv); o.y = pk2(O[dt][2] * inv, O[dt][3] * inv); *(u2*)(op + dt * 16) = o; } }
    if (lat) {
        const int c0 = min(max(16 * g - 8, 0), 32), cq = 16 * g + ql, cs = min(max(cq - 8, 0), 48);
        bool vld[8];
#pragma unroll
        for (int i = 0; i < 8; ++i) vld[i] = (unsigned)(c0 + 16 * (i >> 2) + 4 * kg + (i & 3) - cs) < 16u;
        bf16x8 kf[8][2];
        int rs = min(max(r - 4, 0), 56);
        const unsigned loff = (unsigned)(ql * NP + kg * 8) * 2u;
        NA_LOADK(0, rs)
#define NA_TASK(FIRST) { \
            const LAS float* rpl = RPB + ((rs - r + 7) * 31 + (c0 + 4 * kg - cq + 15)); \
            const int rsn = min(max(r - 2, 0), 56); \
            float m = -INFINITY, lsum = 0.f; \
            f32x4 O[4]; \
            _Pragma("unroll") for (int dt = 0; dt < 4; ++dt) O[dt] = (f32x4){0.f, 0.f, 0.f, 0.f}; \
            NA_CHUNK(2, ) \
            NA_CHUNK(0, NA_LOADK(1, rs)) \
            NA_CHUNK(3, ) \
            NA_CHUNK(1, if (FIRST) { NA_LOADK(0, rsn) const bf16* qp = P + (size_t)(qrow0 + 128 + ql) * NP + PC_NAQ + h * 64 + kg * 8; qf0 = *(const bf16x8*)qp; qf1 = *(const bf16x8*)(qp + 32); }) \
            NA_FINISH() \
            r += 2; rs = rsn; qrow0 += 128; }
        NA_TASK(1)
        NA_TASK(0)
#undef NA_TASK
    } else {
        const int rs = 0, c0 = 0; const LAS float* rpl = RPB; const bool vld[8] = {true, true, true, true, true, true, true, true};
        float m = -INFINITY, lsum = 0.f;
        f32x4 O[4];
#pragma unroll
        for (int dt = 0; dt < 4; ++dt) O[dt] = (f32x4){0.f, 0.f, 0.f, 0.f};
        bf16x8 kf[8][2];
        NA_CHUNK(2, ) NA_CHUNK(3, )
        NA_FINISH()
    }
#undef NA_LOADK
#undef NA_QK_G
#undef NA_QK_L
#undef NA_CHUNK
#undef NA_FINISH
}
#ifndef TPROBE
#define TPROBE -1
#endif
#define TP_MARK(k) do { if (TPROBE >= 0 && l == 0 && c.tid == 0) atomicMax(c.ctl() + CW_TP + 64 * (k), (unsigned)(wall_clock64() - tp0)); } while (0)
__device__ __forceinline__ void ph_scan_na3(const Ctx& c, int l) {
    const unsigned long long tp0 = TPROBE >= 0 ? wall_clock64() : 0ull;
    for (int bt = blockIdx.x; bt < 96; bt += gridDim.x) { const int kind = bt >= 32, bq = kind ? bt - 32 : bt;
        const int dir = kind ? (bq >> 5) & 1 : (bq >> 4) & 1, b = kind ? (bq >> 4) & 1 : (bq >> 3) & 1, h = kind ? (bq >> 2) & 3 : (bq >> 1) & 3, eh = kind ? bq & 3 : bq & 1;
        if (kind == 0) { gla_scan3(c, b, h, dir, eh); __syncthreads(); TP_MARK(0); }
        else { gdn_scan2<0>(c, b, h, dir, eh); __syncthreads(); TP_MARK(1); } }
    const int nunit = 512 + (l == 0 ? 64 : 0);
    int* sh = (int*)(c.lds + MISC_OFF + 64);
    for (;;) {
        __syncthreads();
        if (c.tid == 0) *sh = (int)atomicAdd(c.ctl() + CW_NAQ + 64 * (l + 2 * c.rep), 1u);
        __syncthreads();
        const int u = __builtin_amdgcn_readfirstlane(*sh);
        if (u >= nunit) break;
        if (TPROBE == 3 && l == 0 && u == 0) { const unsigned long long t1 = wall_clock64(); na_unit(c, l, u); __syncthreads(); if (c.tid == 0) atomicMax(c.ctl() + CW_TP + 64 * 3, (unsigned)(wall_clock64() - t1)); }
#ifndef NO_NA
        else na_unit(c, l, u);
#endif
    }
    TP_MARK(2);
}
constexpr int NPH_LAYER = 12, NPHASES = 2 + 2 * NPH_LAYER;
__global__ void __launch_bounds__(NTHREADS, 2) fwd(Params p) {
    extern __shared__ __attribute__((aligned(16))) unsigned char lds[];
    Ctx cb;
    cb.lds = lds; cb.tid = threadIdx.x; cb.lane = cb.tid & 63; cb.wave = __builtin_amdgcn_readfirstlane(cb.tid >> 6);
    cb.gw = blockIdx.x * NWAVES + cb.wave; cb.ngw = gridDim.x * NWAVES;
    cb.kp = (KParams)__builtin_amdgcn_kernarg_segment_ptr(); cb.ws = p.ws;
    LAS unsigned char* ldsl = (LAS unsigned char*)lds;
    volatile LAS unsigned* MISC = (volatile LAS unsigned*)(ldsl + MISC_OFF);
    if (cb.tid < 64) MISC[cb.tid] = 0u;
    __syncthreads();
    const int lo = p.ph_lo, hi = p.ph_hi;
    XcdBarrier bar; bar.bar = cb.ctl() + CW_BAR; bar.x = 0; bar.st = MISC;
    if (hi - lo > 1) bar = xcd_barrier_post(cb.ctl() + CW_BAR, MISC);
#ifndef REPMASK
#define REPMASK 0
#endif
#ifndef PHMASK
#define PHMASK 0xffff
#endif
#define RUN(ty, k, ...) do { if constexpr (((PHMASK) >> (ty)) & 1) { if (lo <= (k) && (k) < hi) for (int rep_ = 0; rep_ < ((((REPMASK) >> (ty)) & 1) ? 2 : 1); ++rep_) { Ctx c = cb; c.rep = rep_; asm volatile("" : "+s"(c.ws)); asm volatile("" : "+s"(c.kp)); asm volatile("" : "+v"(c.tid)); c.lane = c.tid & 63; c.wave = __builtin_amdgcn_readfirstlane(c.tid >> 6); c.gw = blockIdx.x * NWAVES + c.wave; __VA_ARGS__; if ((k) + 1 < hi || rep_ == 0 && ((((REPMASK) >> (ty)) & 1))) xcd_barrier(bar); } } } while (0)
    RUN(0, 0, ph_prologue(c));
    for (int l = 0; l < 2; ++l) {
        const int pb = 1 + NPH_LAYER * l;
        RUN(1, pb + 0, ph_norm1(c, l));
        RUN(2, pb + 1, { pg8::Gemm g{c.NX(), c.WIN() + (size_t)l * NP * D, MROWS, NP, D}; pg8::StaticOrder S; S.init(MROWS, NP, (int)gridDim.x, (int)blockIdx.x); EpiP E{c.P(), c.PS()};
                      pg8::gemm_phase<EpiP, pg8::StaticOrder>(ldsl, g, S, E, nullptr); });
        RUN(3, pb + 2, ph_prep(c, l));
        RUN(4, pb + 3, ph_gdn_chunk(c, l));
        RUN(5, pb + 4, ph_scan_na3(c, l));
        RUN(6, pb + 5, ph_combine2(c, l));
        RUN(7, pb + 6, { pg8::Gemm g{c.CAT(), c.WOUT() + (size_t)l * D * D, MROWS, D, D}; pg8::StaticOrder S; S.init(l == 0 ? MROWS : ML, D, (int)gridDim.x, (int)blockIdx.x); EpiResid E{c.x(), c.ctxin(), c.MOD(), c.HX(), l};
                      pg8::gemm_phase<EpiResid, pg8::StaticOrder>(ldsl, g, S, E, nullptr); });
        RUN(8, pb + 7, ph_norm2_router(c, l));
        RUN(9, pb + 8, ph_topk(c, l));
        RUN(10, pb + 9, ph_gather(c, l));
        RUN(11, pb + 10, { MoeOrder S{l == 0 ? 5 : 4, 16, (int)gridDim.x, (int)blockIdx.x};
                      if (!(((F8MASK) >> l) & 1)) { pg8::Gemm g{c.AMOE(), c.WGU() + (size_t)l * NE * 4096 * D, NE * ESLOT, NE * 4096, D}; EpiSwiglu E{c.HID()};
                          pg8::gemm_phase<EpiSwiglu, MoeOrder>(ldsl, g, S, E, nullptr); }
                      else { pg8::Gemm g{c.AMOE(), c.WGU() + (size_t)l * NE * 4096 * D, NE * ESLOT, NE * 4096, D / 2}; EpiSwiglu8 E{(unsigned char*)c.HID()};
                          pg8::gemm_phase<EpiSwiglu8, MoeOrder, false, true>(ldsl, g, S, E, nullptr); } });
        RUN(12, pb + 11, { MoeOrder S{l == 0 ? 5 : 4, 8, (int)gridDim.x, (int)blockIdx.x}; EpiY E{c.Y()};
                      if (!(((F8MASK) >> l) & 1)) { pg8::Gemm g{c.HID(), c.WDN() + (size_t)l * NE * D * FF, NE * ESLOT, NE * D, FF};
                          pg8::gemm_phase<EpiY, MoeOrder>(ldsl, g, S, E, nullptr); }
                      else { pg8::Gemm g{c.HID(), c.WDN() + (size_t)l * NE * D * FF, NE * ESLOT, NE * D, FF / 2};
                          pg8::gemm_phase<EpiY, MoeOrder, false, true>(ldsl, g, S, E, nullptr); } });
    }
    RUN(13, NPHASES - 1, ph_final(c));
#undef RUN
}

extern "C" void kernel_launch(void* const* d_in, const int* in_sizes, int n_in, void* d_out, int out_size, void* d_ws, size_t ws_size, hipStream_t stream) {
    static int grid = 0;
    if (grid == 0) {
        if (n_in != 23 || ws_size < WS_END) { fprintf(stderr, "kernel_launch: need 23 inputs and %zu bytes of workspace (got %d, %zu)\n", (size_t)WS_END, n_in, ws_size); grid = -1; return; }
        int dev = 0, cus = 0, per_cu = 0;
        if (hipGetDevice(&dev) != hipSuccess || hipDeviceGetAttribute(&cus, hipDeviceAttributeMultiprocessorCount, dev) != hipSuccess) { grid = -1; return; }
        if (hipFuncSetAttribute((const void*)fwd, hipFuncAttributeMaxDynamicSharedMemorySize, LDS_BYTES) != hipSuccess) { fprintf(stderr, "kernel_launch: hipFuncSetAttribute failed\n"); grid = -1; return; }
        if (hipOccupancyMaxActiveBlocksPerMultiprocessor(&per_cu, (const void*)fwd, NTHREADS, LDS_BYTES) != hipSuccess || per_cu < 1) { fprintf(stderr, "kernel_launch: occupancy query says %d\n", per_cu); per_cu = 1; }
        grid = cus;
    }
    if (grid <= 0) return;
    hipMemsetAsync((char*)d_ws + WS_CTL, 0, CTL_BYTES, stream);
    Params p; memset(&p, 0, sizeof(p));
    for (int i = 0; i < 23; ++i) p.in[i] = (GASP const float*)d_in[i];
    p.out = (GASP float*)d_out; p.ws = (GASP unsigned char*)d_ws;
#if ONE_LAUNCH
    p.ph_lo = 0; p.ph_hi = NPHASES;
    hipLaunchKernelGGL(fwd, dim3(grid), dim3(NTHREADS), LDS_BYTES, stream, p);
#else
    for (int k = 0; k < NPHASES; ++k) { p.ph_lo = k; p.ph_hi = k + 1; hipLaunchKernelGGL(fwd, dim3(grid), dim3(NTHREADS), LDS_BYTES, stream, p); }
#endif
}
```

```cpp
#include <hip/hip_runtime.h>
#include <cstdio>
#include <cstdint>
#include <cstring>

#ifndef F8MASK
#define F8MASK 3
#endif
#ifndef L2PROBE
#define L2PROBE 0
#endif
#ifndef SUBREP
#define SUBREP 0
#endif
#ifndef ONE_LAUNCH
#define ONE_LAUNCH 1
#endif

#define LAS __attribute__((address_space(3)))
typedef unsigned short bf16;
typedef float f4 __attribute__((ext_vector_type(4)));
typedef unsigned u4 __attribute__((ext_vector_type(4)));
typedef unsigned u2 __attribute__((ext_vector_type(2)));

constexpr int D = 2048, NB = 2, SEQ = 4096, CTX = 256;
constexpr int ML = NB * SEQ, MC = NB * CTX, MROWS = ML + MC;
constexpr int INW = 6704, NP = 6912;
constexpr int NE = 16, FF = 2048, ESLOT = 1280;
constexpr int MODW = 6 * D;
constexpr int PC_NAQ = 0, PC_NAK = 1024, PC_NAV = 2048, PC_GLQ = 3072, PC_GLK = 3328, PC_GLV = 3584, PC_GLG = 4096, PC_GDQ = 4608, PC_GDZ = 6144, PC_SMALL = 6656;
constexpr int NTHREADS = 512, NWAVES = 8;
constexpr int LDS_BYTES = 163840, MISC_OFF = LDS_BYTES - 256;

constexpr size_t al256(size_t x) { return (x + 255) & ~(size_t)255; }
constexpr size_t WS_CTL = 0, CTL_BYTES = 1u << 20;
constexpr size_t WS_MOD = WS_CTL + CTL_BYTES;
constexpr size_t WS_ROPE = al256(WS_MOD + (size_t)2 * 3 * MODW * 4);
constexpr size_t WS_WIN = al256(WS_ROPE + 64 * 16 * 2 * 4);
constexpr size_t WS_WOUT = al256(WS_WIN + (size_t)2 * NP * D * 2);
constexpr size_t WS_WGU = al256(WS_WOUT + (size_t)2 * D * D * 2);
constexpr size_t WS_WDN = al256(WS_WGU + (size_t)2 * NE * 2 * FF * D * 2);
constexpr size_t WS_HX = al256(WS_WDN + (size_t)2 * NE * D * FF * 2);
constexpr size_t WS_NX = al256(WS_HX + (size_t)MROWS * D * 4);
constexpr size_t WS_P = al256(WS_NX + (size_t)MROWS * D * 2);
constexpr size_t WS_PS = al256(WS_P + (size_t)MROWS * NP * 2);
constexpr size_t WS_GQKV = al256(WS_PS + (size_t)MROWS * 64 * 4);
constexpr size_t WS_GGB = al256(WS_GQKV + (size_t)MROWS * 1536 * 4);
constexpr size_t WS_LQ = al256(WS_GGB + (size_t)MROWS * 16 * 4);
constexpr size_t WS_LK = al256(WS_LQ + (size_t)MROWS * 256 * 4);
constexpr size_t WS_LA = al256(WS_LK + (size_t)MROWS * 256 * 4);
constexpr size_t WS_OGLA = al256(WS_LA + (size_t)2 * MROWS * 256 * 4);
constexpr size_t WS_OGDN = al256(WS_OGLA + (size_t)2 * MROWS * 512 * 4);
constexpr size_t WS_CAT = al256(WS_OGDN + (size_t)2 * MROWS * 512 * 4);
constexpr size_t WS_AFF = al256(WS_CAT + (size_t)MROWS * D * 2);
constexpr size_t WS_IDX = al256(WS_AFF + (size_t)MROWS * 16 * 4);
constexpr size_t WS_GATE = al256(WS_IDX + (size_t)NE * ESLOT * 4);
constexpr size_t WS_AMOE = al256(WS_GATE + (size_t)NE * ESLOT * 4);
constexpr size_t WS_HID = al256(WS_AMOE + (size_t)NE * ESLOT * D * 2);
constexpr int UDS = 69;
constexpr int NUD = 2 * 4 * UDS * 2;
constexpr size_t WS_GDQP = al256(WS_HID + (size_t)NE * ESLOT * FF * 2);
constexpr size_t WS_GDO0 = al256(WS_GDQP + (size_t)NUD * 64 * 128 * 2);
constexpr size_t WS_GDAP = al256(WS_GDO0 + (size_t)NUD * 64 * 128 * 4);
constexpr size_t WS_GDBM = al256(WS_GDAP + (size_t)NUD * 128 * 128 * 2);
constexpr size_t WS_GDGL = al256(WS_GDBM + (size_t)NUD * 128 * 128 * 4);
constexpr size_t WS_GLQT = al256(WS_GDGL + (size_t)NUD * 4);
constexpr size_t WS_GLKT = al256(WS_GLQT + (size_t)NUD * 4096 * 2);
constexpr size_t WS_GLKH = al256(WS_GLKT + (size_t)NUD * 4096 * 2);
constexpr size_t WS_GLVT = al256(WS_GLKH + (size_t)NUD * 4096 * 2);
constexpr size_t WS_GLDEC = al256(WS_GLVT + (size_t)NUD * 8192 * 2);
constexpr size_t WS_GDST = al256(WS_GLDEC + (size_t)NUD * 64 * 4);
constexpr size_t WS_GLST = al256(WS_GDST + (size_t)NUD * 16384 * 2);
constexpr size_t WS_SLOTOF = al256(WS_GLST + (size_t)NUD * 8192 * 2);
constexpr size_t WS_Y = al256(WS_SLOTOF + (size_t)NE * MROWS * 4);
constexpr size_t WS_END = al256(WS_Y + (size_t)NE * ESLOT * D * 2);
constexpr int CW_BAR = 1024;
constexpr int CW_PROQ = 7040;
constexpr int CW_TP = 9216;
constexpr int CW_CHQ = 7680;
constexpr int CW_NAQ = 8192;

__device__ __forceinline__ float bf2f(unsigned b) { return __uint_as_float(b << 16); }
__device__ __forceinline__ unsigned f2bf(float f) { unsigned u = __float_as_uint(f); return (u + 0x7fffu + ((u >> 16) & 1u)) >> 16; }
typedef __bf16 bf2_t __attribute__((ext_vector_type(2)));
typedef float f2_t __attribute__((ext_vector_type(2)));
__device__ __forceinline__ unsigned pk2(float lo, float hi) { const bf2_t r = __builtin_convertvector((f2_t){lo, hi}, bf2_t); return __builtin_bit_cast(unsigned, r); }
__device__ __forceinline__ float wave_sum(float v) {
#pragma unroll
    for (int o = 1; o < 64; o <<= 1) v += __shfl_xor(v, o);
    return v;
}
__device__ __forceinline__ float wave_max(float v) {
#pragma unroll
    for (int o = 1; o < 64; o <<= 1) v = fmaxf(v, __shfl_xor(v, o));
    return v;
}
__device__ __forceinline__ float silu_f(float x) { return x * __builtin_amdgcn_rcpf(1.f + __expf(-x)); }
__device__ __forceinline__ float softplus_f(float x) { return x > 20.f ? x : log1pf(__expf(x)); }
__device__ __forceinline__ float logsigmoid_f(float z) { return fminf(z, 0.f) - __logf(1.f + __expf(-fabsf(z))); }
#define LDS_WAIT() asm volatile("s_waitcnt lgkmcnt(0)" ::: "memory")
#define XB_TMO      128
#define XB_XCNT(j)  (256  + 64 * (j))
#define XB_XSUB(j)  (1280 + 64 * (j))
#define XB_XGEN(j)  (2304 + 64 * (j))
#define XB_TOP      3328
#define XB_TOPGEN   3392
#define XCD_BAR_WORDS 3456
#define XB_SPIN_CAP (1u << 20)

__device__ __forceinline__ unsigned xb_ld(unsigned* p)              { return __hip_atomic_load(p, __ATOMIC_RELAXED, __HIP_MEMORY_SCOPE_AGENT); }
__device__ __forceinline__ unsigned xb_add(unsigned* p, unsigned v) { return __hip_atomic_fetch_add(p, v, __ATOMIC_RELAXED, __HIP_MEMORY_SCOPE_AGENT); }
__device__ __forceinline__ unsigned xb_xcc_id() { return (unsigned)__builtin_amdgcn_s_getreg((3 << 11) | 20) & 0xFu; }
#define XB_SPIN(cond, bar) do { unsigned _sp = 0; while (cond) { __builtin_amdgcn_s_sleep(1); \
    if ((++_sp & 255u) == 0u) { if (xb_ld(&(bar)[XB_TMO])) break; if (_sp > XB_SPIN_CAP) { atomicAdd(&(bar)[XB_TMO], 1u); break; } } } } while (0)

struct XcdBarrier {
    unsigned* bar; unsigned x;
    volatile LAS unsigned* st;
};

__device__ __forceinline__ XcdBarrier xcd_barrier_post(unsigned* bar, volatile LAS unsigned* st) {
    XcdBarrier b; b.bar = bar; b.x = xb_xcc_id(); b.st = st;
    if (threadIdx.x == 0) (void)xb_add(&bar[XB_XCNT(b.x)], 1u);
    return b;
}
__device__ __forceinline__ void xcd_barrier_complete(unsigned* bar, unsigned x, unsigned& nloc, unsigned& nx) {
    const unsigned G = gridDim.x * gridDim.y * gridDim.z;
    unsigned sum, cnt, mine, sp = 0u;
    for (;;) {
        sum = 0u; cnt = 0u; mine = 0u;
#pragma unroll
        for (unsigned j = 0; j < 16; ++j) { const unsigned c = xb_ld(&bar[XB_XCNT(j)]); sum += c; cnt += (c > 0u) ? 1u : 0u; mine = (j == x) ? c : mine; }
        if (sum == G) break;
        __builtin_amdgcn_s_sleep(1);
        if ((++sp & 255u) == 0u) { if (xb_ld(&bar[XB_TMO])) break; if (sp > XB_SPIN_CAP) { atomicAdd(&bar[XB_TMO], 1u); break; } }
    }
    nloc = mine > 0u ? mine : 1u; nx = cnt > 0u ? cnt : 1u;
}

__device__ __forceinline__ void xcd_barrier(const XcdBarrier& b) {
    asm volatile("s_waitcnt vmcnt(0)" ::: "memory");
    __syncthreads();
    if (threadIdx.x == 0) {
        unsigned* bar = b.bar;
        __builtin_amdgcn_s_waitcnt(0);
        unsigned nloc = b.st[0], nx = b.st[1];
        if (nloc == 0u) { xcd_barrier_complete(bar, b.x, nloc, nx); b.st[0] = nloc; b.st[1] = nx; }
        const unsigned old = xb_add(&bar[XB_XSUB(b.x)], 1u);
        const unsigned gen = old / nloc;
        if (old + 1u == (gen + 1u) * nloc) {
            __builtin_amdgcn_fence(__ATOMIC_RELEASE, "agent");
            asm volatile("s_waitcnt vmcnt(0)" ::: "memory");
            const unsigned og = xb_add(&bar[XB_TOP], 1u);
            const unsigned tg = og / nx;
            if (og + 1u == (tg + 1u) * nx) xb_add(&bar[XB_TOPGEN], 1u);
            else XB_SPIN(xb_ld(&bar[XB_TOPGEN]) == tg, bar);
            __builtin_amdgcn_fence(__ATOMIC_ACQUIRE, "agent");
            xb_add(&bar[XB_XGEN(b.x)], 1u);
            asm volatile("s_waitcnt vmcnt(0)" ::: "memory");
        } else {
            XB_SPIN(xb_ld(&bar[XB_XGEN(b.x)]) == gen, bar);
            __builtin_amdgcn_fence(__ATOMIC_ACQUIRE, "agent");
            asm volatile("s_waitcnt vmcnt(0)" ::: "memory");
        }
    }
    __syncthreads();
}

namespace pg8 {
#define PG8_LAS __attribute__((address_space(3)))
typedef unsigned short bf16_t;
typedef short bf16x8 __attribute__((ext_vector_type(8)));
typedef float f32x4 __attribute__((ext_vector_type(4)));
typedef unsigned u32x4 __attribute__((ext_vector_type(4)));
constexpr int BM = 256, BK = 64, HALF = 128, HTB = HALF * BK * 2  , STAGE_BYTES = 8 * HTB, NXCD = 8, WGM = 8;

__host__ __device__ __forceinline__ int lds_byte(int r, int c) { const int st = (r >> 4) * 2 + (c >> 5), rr = r & 15, cc = c & 31, ob = rr * 64 + cc * 2; return st * 1024 + (ob ^ (((ob >> 9) & 1) << 5)); }
__host__ __device__ __forceinline__ void stage_rc(int b, int& R, int& C) { const int st = b / 1024, sb = b % 1024, swz = sb ^ (((sb >> 9) & 1) << 5); R = (st >> 1) * 16 + swz / 64; C = (st & 1) * 32 + (swz % 64) / 2; }
__host__ __device__ __forceinline__ int perm32(int rho) { const int n = rho >> 4, i = rho & 15; return 8 * (i >> 2) + 4 * n + (i & 3); }

struct Unit { int pm, pn; };
struct Gemm { const bf16_t* A; const bf16_t* Bt; int M, N, K; };
struct StaticOrder {
    int nM, nN, nwg, G, c;
    __host__ __device__ void init(int M, int N, int G_, int c_) { nM = M / BM; nN = N / BM; nwg = nM * nN; G = G_; c = c_; }
    __host__ __device__ bool next(int i, Unit& u) const {
        const long L = (long)i * G + c; if (L >= nwg) return false;
        int wgid = (int)L; { const int q = nwg / NXCD, r = nwg % NXCD, xcd = wgid % NXCD, off = wgid / NXCD; wgid = (xcd < r ? xcd * (q + 1) : r * (q + 1) + (xcd - r) * q) + off; }
        const int nig = WGM * nN, gid = wgid / nig, fm = gid * WGM, gsz = (nM - fm) < WGM ? (nM - fm) : WGM;
        u.pm = fm + ((wgid % nig) % gsz); u.pn = (wgid % nig) / gsz; return true;
    }
    __device__ __forceinline__ void a_ready(const Unit&) const {}
    __device__ __forceinline__ void done(const Unit&) const {}
};
__device__ __forceinline__ unsigned cvt_pk_bf16(float lo, float hi) { unsigned r; asm volatile("v_cvt_pk_bf16_f32 %0, %1, %2" : "=v"(r) : "v"(lo), "v"(hi)); return r; }

typedef int v8i32 __attribute__((ext_vector_type(8)));
typedef int v4i32 __attribute__((ext_vector_type(4)));
constexpr int F8_WSCALE_LOG2 = 6;
template <class Epi, class Sched, bool STAMP = false, bool F8 = false>
__device__ __forceinline__ void gemm_phase(PG8_LAS unsigned char* lds, const Gemm g, const Sched& S, const Epi& E, unsigned long long* stamps) {
    int tid_ = threadIdx.x; asm volatile("" : "+v"(tid_));
    const int tid = tid_, wid = __builtin_amdgcn_readfirstlane(tid >> 6), lane = tid & 63, wr = wid >> 2, wc = wid & 3, fr = lane & 15, fq = lane >> 4;
    const int K = g.K, nt = K / BK;
    const int f8_sw = 127 - F8_WSCALE_LOG2, f8_s1 = 127;
    int ts_lo = 0, ts_hi = 0, nts = 0; const unsigned long long rt_entry = STAMP ? (unsigned long long)wall_clock64() : 0ull;
#define PG8_STAMP() do { if (STAMP && wid == 0 && nts < 64) { const unsigned long long _c = (unsigned long long)clock64(); \
        ts_lo = (lane == nts) ? (int)(unsigned)_c : ts_lo; ts_hi = (lane == nts) ? (int)(unsigned)(_c >> 32) : ts_hi; ++nts; } } while (0)
    PG8_STAMP();
    unsigned voffA[2], voffB[2];
#pragma unroll
    for (int i = 0; i < 2; ++i) { int R, C; stage_rc(tid * 16 + i * 8192, R, C); const int Rb = Epi::PERM ? ((R & ~31) + perm32(R & 31)) : R;
        voffA[i] = (unsigned)(R * K + C) * 2u; voffB[i] = (unsigned)(Rb * K + C) * 2u; }
    const size_t kstep = (size_t)(BK * 2);
    const size_t hstep = (size_t)HALF * K * 2;
    const size_t tstep = 2 * hstep;
    const unsigned ldsw = (unsigned)wid * 1024u;
    const int aoff = lds_byte(wr * 64 + fr, fq * 8), boff = lds_byte(wc * 32 + fr, fq * 8);
#define PG8_SA(b, h) (((b) * 2 + (h)) * HTB)
#define PG8_SB(b, h) ((4 + (b) * 2 + (h)) * HTB)
#define PG8_STAGE(bufoff, gbase, voff) do { _Pragma("unroll") for (int _i = 0; _i < 2; ++_i) \
        __builtin_amdgcn_global_load_lds((const unsigned*)((const char*)(gbase) + (voff)[_i]), (PG8_LAS unsigned*)(lds + (bufoff) + ldsw + _i * 8192), 16, 0, 0); } while (0)
#define PG8_LDA(dst, b, h) do { _Pragma("unroll") for (int m = 0; m < 4; ++m) _Pragma("unroll") for (int k = 0; k < 2; ++k) dst[m][k] = *(const PG8_LAS bf16x8*)(lds + PG8_SA(b, h) + aoff + m * 2048 + k * 1024); } while (0)
#define PG8_LDB(dst, b, h) do { _Pragma("unroll") for (int n = 0; n < 2; ++n) _Pragma("unroll") for (int k = 0; k < 2; ++k) dst[n][k] = *(const PG8_LAS bf16x8*)(lds + PG8_SB(b, h) + boff + n * 2048 + k * 1024); } while (0)
#define PG8_MMA(ai, bj, At, Bt) do { __builtin_amdgcn_s_setprio(1); \
        if constexpr (!F8) { _Pragma("unroll") for (int m = 0; m < 4; ++m) _Pragma("unroll") for (int n = 0; n < 2; ++n) _Pragma("unroll") for (int k = 0; k < 2; ++k) \
            acc[ai][bj][m][n] = __builtin_amdgcn_mfma_f32_16x16x32_bf16(Bt[n][k], At[m][k], acc[ai][bj][m][n], 0, 0, 0); } \
        else { _Pragma("unroll") for (int m = 0; m < 4; ++m) _Pragma("unroll") for (int n = 0; n < 2; ++n) \
            asm volatile("v_mfma_scale_f32_16x16x128_f8f6f4 %0, %1, %2, %0, %3, %4 op_sel_hi:[0,0,0]" : "+v"(acc[ai][bj][m][n]) \
                : "v"(__builtin_shufflevector(__builtin_bit_cast(v4i32, Bt[n][0]), __builtin_bit_cast(v4i32, Bt[n][1]), 0, 1, 2, 3, 4, 5, 6, 7)), \
                  "v"(__builtin_shufflevector(__builtin_bit_cast(v4i32, At[m][0]), __builtin_bit_cast(v4i32, At[m][1]), 0, 1, 2, 3, 4, 5, 6, 7)), "v"(f8_sw), "v"(f8_s1)); } \
        __builtin_amdgcn_s_setprio(0); } while (0)
#define PG8_WAIT_V(n) asm volatile("s_waitcnt vmcnt(" #n ")" ::: "memory")
#define PG8_WAIT_L(n) asm volatile("s_waitcnt lgkmcnt(" #n ")" ::: "memory")
#define PG8_BAR __builtin_amdgcn_s_barrier()
#define PG8_SCHED __builtin_amdgcn_sched_barrier(0)
    Unit cur, nxt; int ui = 0;
    if (!S.next(0, cur)) return;
    f32x4 acc[2][2][4][2];
#pragma unroll
    for (int a = 0; a < 2; ++a)
#pragma unroll
        for (int b = 0; b < 2; ++b)
#pragma unroll
            for (int m = 0; m < 4; ++m)
#pragma unroll
                for (int n = 0; n < 2; ++n) acc[a][b][m][n] = (f32x4){0.f, 0.f, 0.f, 0.f};
    bf16x8 At[4][2], B0[2][2], B1[2][2];
    const char* cA = (const char*)g.A + (size_t)cur.pm * tstep; const char* cB = (const char*)g.Bt + (size_t)cur.pn * tstep;
    S.a_ready(cur);
    PG8_STAGE(PG8_SB(0, 0), cB, voffB); PG8_STAGE(PG8_SA(0, 0), cA, voffA); PG8_STAGE(PG8_SB(0, 1), cB + hstep, voffB); PG8_STAGE(PG8_SA(0, 1), cA + hstep, voffA);
    if (wr == 1) PG8_BAR;
    PG8_WAIT_V(4); PG8_BAR;
    PG8_STAGE(PG8_SB(1, 0), cB + kstep, voffB); PG8_STAGE(PG8_SA(1, 0), cA + kstep, voffA); PG8_STAGE(PG8_SB(1, 1), cB + hstep + kstep, voffB);
    PG8_WAIT_V(6); PG8_BAR;
    PG8_STAMP();
    for (;;) {
        const bool has_next = S.next(ui + 1, nxt);
        const char* nA = has_next ? (const char*)g.A + (size_t)nxt.pm * tstep : cA; const char* nB = has_next ? (const char*)g.Bt + (size_t)nxt.pn * tstep : cB;
        for (int t = 0; t < nt; t += 2) {
            const bool last = (t == nt - 2);
            const char* a1 = cA + (size_t)(t + 1) * kstep;
            const char* a2 = last ? nA : cA + (size_t)(t + 2) * kstep; const char* b2 = last ? nB : cB + (size_t)(t + 2) * kstep;
            const char* a3 = a2 + kstep; const char* b3 = b2 + kstep;
            if (last && has_next) S.a_ready(nxt);
            PG8_LDB(B0, 0, 0); PG8_SCHED; PG8_LDA(At, 0, 0); PG8_STAGE(PG8_SA(1, 1), a1 + hstep, voffA);
            PG8_WAIT_L(8); PG8_BAR; PG8_WAIT_L(0); PG8_MMA(0, 0, At, B0); PG8_BAR; PG8_SCHED;
            PG8_LDB(B1, 0, 1); PG8_STAGE(PG8_SB(0, 0), b2, voffB);
            PG8_BAR; PG8_WAIT_L(0); PG8_MMA(0, 1, At, B1); PG8_BAR;
            PG8_LDA(At, 0, 1); PG8_STAGE(PG8_SA(0, 0), a2, voffA);
            PG8_BAR; PG8_WAIT_L(0); PG8_MMA(1, 0, At, B0); PG8_BAR; PG8_SCHED;
            PG8_STAGE(PG8_SB(0, 1), b2 + hstep, voffB);
            PG8_WAIT_V(6); PG8_BAR; PG8_MMA(1, 1, At, B1); PG8_BAR;
            PG8_LDB(B0, 1, 0); PG8_SCHED; PG8_LDA(At, 1, 0); PG8_STAGE(PG8_SA(0, 1), a2 + hstep, voffA);
            PG8_WAIT_L(8); PG8_BAR; PG8_WAIT_L(0); PG8_MMA(0, 0, At, B0); PG8_BAR; PG8_SCHED;
            PG8_LDB(B1, 1, 1); PG8_STAGE(PG8_SB(1, 0), b3, voffB);
            PG8_BAR; PG8_WAIT_L(0); PG8_MMA(0, 1, At, B1); PG8_BAR;
            PG8_LDA(At, 1, 1); PG8_STAGE(PG8_SA(1, 0), a3, voffA);
            PG8_BAR; PG8_WAIT_L(0); PG8_MMA(1, 0, At, B0); PG8_BAR; PG8_SCHED;
            PG8_STAGE(PG8_SB(1, 1), b3 + hstep, voffB);
            PG8_WAIT_V(6); PG8_BAR; PG8_MMA(1, 1, At, B1); PG8_BAR;
        }
        PG8_STAMP();
        if constexpr (F8) asm volatile("s_nop 15\n\ts_nop 15" ::: "memory");
        if constexpr (!Epi::AFTER_DRAIN) { E(acc, cur, wr, wc, fr, fq); S.done(cur); }
        PG8_STAMP();
        if (!has_next) break;
#pragma unroll
        for (int a = 0; a < 2; ++a)
#pragma unroll
            for (int b = 0; b < 2; ++b)
#pragma unroll
                for (int m = 0; m < 4; ++m)
#pragma unroll
                    for (int n = 0; n < 2; ++n) acc[a][b][m][n] = (f32x4){0.f, 0.f, 0.f, 0.f};
        cur = nxt; cA = nA; cB = nB; ++ui;
    }
    PG8_WAIT_V(0);
    if (wr == 0) PG8_BAR;
    PG8_BAR;
    if constexpr (Epi::AFTER_DRAIN) { E.fused(acc, cur, wr, wc, fr, fq, lds, wid, lane); S.done(cur); }
    PG8_STAMP();
    if (STAMP && wid == 0) { stamps[lane] = lane < nts ? (((unsigned long long)(unsigned)ts_hi << 32) | (unsigned)ts_lo) : 0ull;
        if (lane == 62) stamps[62] = rt_entry; if (lane == 63) stamps[63] = (unsigned long long)wall_clock64(); }
#undef PG8_STAMP
#undef PG8_SA
#undef PG8_SB
#undef PG8_STAGE
#undef PG8_LDA
#undef PG8_LDB
#undef PG8_MMA
#undef PG8_WAIT_V
#undef PG8_WAIT_L
#undef PG8_BAR
#undef PG8_SCHED
}
}

#include <cstdio>
#include <ctime>

#define GASP __attribute__((address_space(1)))
struct Params { GASP const float* in[23]; GASP float* out; GASP unsigned char* ws; int ph_lo, ph_hi; };
typedef const __attribute__((address_space(4))) Params* KParams;
struct Ctx {
    unsigned char* lds; GASP unsigned char* ws; KParams kp;
    int tid, lane, wave, gw, ngw, rep;
    __device__ __forceinline__ const float* x() const { return (const float*)kp->in[0]; }
    __device__ __forceinline__ const float* cvec() const { return (const float*)kp->in[1]; }
    __device__ __forceinline__ const float* ctxin() const { return (const float*)kp->in[2]; }
    __device__ __forceinline__ const float* c_ctx() const { return (const float*)kp->in[3]; }
    __device__ __forceinline__ const float* w_ada() const { return (const float*)kp->in[4]; }
    __device__ __forceinline__ const float* b_ada() const { return (const float*)kp->in[5]; }
    __device__ __forceinline__ const float* norm_mix_w() const { return (const float*)kp->in[6]; }
    __device__ __forceinline__ const float* norm_ffn_w() const { return (const float*)kp->in[7]; }
    __device__ __forceinline__ const float* w_in() const { return (const float*)kp->in[8]; }
    __device__ __forceinline__ const float* w_out() const { return (const float*)kp->in[9]; }
    __device__ __forceinline__ const float* na_rpb() const { return (const float*)kp->in[10]; }
    __device__ __forceinline__ const float* gla_gate_w() const { return (const float*)kp->in[11]; }
    __device__ __forceinline__ const float* gla_gate_b() const { return (const float*)kp->in[12]; }
    __device__ __forceinline__ const float* gla_norm_w() const { return (const float*)kp->in[13]; }
    __device__ __forceinline__ const float* gdn_conv_w() const { return (const float*)kp->in[14]; }
    __device__ __forceinline__ const float* gdn_a_log() const { return (const float*)kp->in[15]; }
    __device__ __forceinline__ const float* gdn_dt_bias() const { return (const float*)kp->in[16]; }
    __device__ __forceinline__ const float* gdn_norm_w() const { return (const float*)kp->in[17]; }
    __device__ __forceinline__ const float* w_router() const { return (const float*)kp->in[18]; }
    __device__ __forceinline__ const float* w_exp_gate() const { return (const float*)kp->in[19]; }
    __device__ __forceinline__ const float* w_exp_up() const { return (const float*)kp->in[20]; }
    __device__ __forceinline__ const float* w_exp_down() const { return (const float*)kp->in[21]; }
    __device__ __forceinline__ const float* final_norm_w() const { return (const float*)kp->in[22]; }
    __device__ __forceinline__ float* out() const { return (float*)kp->out; }
    __device__ __forceinline__ float* MOD() const { return (float*)(ws + WS_MOD); }
    __device__ __forceinline__ float* ROPE() const { return (float*)(ws + WS_ROPE); }
    __device__ __forceinline__ float* HX() const { return (float*)(ws + WS_HX); }
    __device__ __forceinline__ float* PS() const { return (float*)(ws + WS_PS); }
    __device__ __forceinline__ float* GQKV() const { return (float*)(ws + WS_GQKV); }
    __device__ __forceinline__ float* GGB() const { return (float*)(ws + WS_GGB); }
    __device__ __forceinline__ float* LQ() const { return (float*)(ws + WS_LQ); }
    __device__ __forceinline__ float* LK() const { return (float*)(ws + WS_LK); }
    __device__ __forceinline__ float* LA() const { return (float*)(ws + WS_LA); }
    __device__ __forceinline__ float* OGLA() const { return (float*)(ws + WS_OGLA); }
    __device__ __forceinline__ float* OGDN() const { return (float*)(ws + WS_OGDN); }
    __device__ __forceinline__ float* AFF() const { return (float*)(ws + WS_AFF); }
    __device__ __forceinline__ float* GATEV() const { return (float*)(ws + WS_GATE); }
    __device__ __forceinline__ bf16* WIN() const { return (bf16*)(ws + WS_WIN); }
    __device__ __forceinline__ bf16* WOUT() const { return (bf16*)(ws + WS_WOUT); }
    __device__ __forceinline__ bf16* WGU() const { return (bf16*)(ws + WS_WGU); }
    __device__ __forceinline__ bf16* WDN() const { return (bf16*)(ws + WS_WDN); }
    __device__ __forceinline__ bf16* NX() const { return (bf16*)(ws + WS_NX); }
    __device__ __forceinline__ bf16* P() const { return (bf16*)(ws + WS_P); }
    __device__ __forceinline__ bf16* CAT() const { return (bf16*)(ws + WS_CAT); }
    __device__ __forceinline__ bf16* AMOE() const { return (bf16*)(ws + WS_AMOE); }
    __device__ __forceinline__ bf16* HID() const { return (bf16*)(ws + WS_HID); }
    __device__ __forceinline__ int* IDX() const { return (int*)(ws + WS_IDX); }
    __device__ __forceinline__ unsigned* ctl() const { return (unsigned*)(ws + WS_CTL); }
    __device__ __forceinline__ int* SLOTOF() const { return (int*)(ws + WS_SLOTOF); }
    __device__ __forceinline__ bf16* Y() const { return (bf16*)(ws + WS_Y); }
    __device__ __forceinline__ bf16* GLQT() const { return (bf16*)(ws + WS_GLQT); }
    __device__ __forceinline__ bf16* GLKT() const { return (bf16*)(ws + WS_GLKT); }
    __device__ __forceinline__ bf16* GLKH() const { return (bf16*)(ws + WS_GLKH); }
    __device__ __forceinline__ bf16* GLVT() const { return (bf16*)(ws + WS_GLVT); }
    __device__ __forceinline__ float* GLDEC() const { return (float*)(ws + WS_GLDEC); }
    __device__ __forceinline__ bf16* GDST() const { return (bf16*)(ws + WS_GDST); }
    __device__ __forceinline__ bf16* GLST() const { return (bf16*)(ws + WS_GLST); }
    __device__ __forceinline__ bf16* GDQP() const { return (bf16*)(ws + WS_GDQP); }
    __device__ __forceinline__ bf16* GDO0() const { return (bf16*)(ws + WS_GDO0); }
    __device__ __forceinline__ bf16* GDAP() const { return (bf16*)(ws + WS_GDAP); }
    __device__ __forceinline__ bf16* GDBM() const { return (bf16*)(ws + WS_GDBM); }
    __device__ __forceinline__ float* GDGL() const { return (float*)(ws + WS_GDGL); }
};
__device__ __forceinline__ int modrow(int row) { return row < ML ? (row >> 12) : 2; }
__device__ __forceinline__ const float* src_row_ptr(const Ctx& c, int l, int row) {
    if (l == 0) return row < ML ? c.x() + (size_t)row * D : c.ctxin() + (size_t)(row - ML) * D;
    return c.HX() + (size_t)row * D;
}

__device__ __forceinline__ void transpose_item(const float* W, int ldw, int k0, int sn0, int nvalid, bf16* dst, int K, float* scr, int lane) {
    { const int c4 = lane & 7, rr = lane >> 3; const float* wp = W + (size_t)(k0 + rr) * ldw + sn0 + 4 * c4; const bool ok = 4 * c4 < nvalid;
        f4 v[8];
#pragma unroll
        for (int i = 0; i < 8; ++i) v[i] = ok ? *(const f4*)(wp + (size_t)(8 * i) * ldw) : (f4){0.f, 0.f, 0.f, 0.f};
#pragma unroll
        for (int i = 0; i < 8; ++i) { float* sp = scr + (rr + 8 * i) * 33 + 4 * c4; sp[0] = v[i].x; sp[1] = v[i].y; sp[2] = v[i].z; sp[3] = v[i].w; } }
    LDS_WAIT();
    const int cc = lane & 7;
#pragma unroll
    for (int j = 0; j < 4; ++j) { const int n = (lane >> 3) + 8 * j; const float* s = scr + (8 * cc) * 33 + n;
        u4 o; o.x = pk2(s[0 * 33], s[1 * 33]); o.y = pk2(s[2 * 33], s[3 * 33]); o.z = pk2(s[4 * 33], s[5 * 33]); o.w = pk2(s[6 * 33], s[7 * 33]);
        *(u4*)(dst + (size_t)n * K + 8 * cc) = o; }
    LDS_WAIT();
}
__device__ __forceinline__ float sat_fp8(float x) { return __builtin_amdgcn_fmed3f(x, -448.0f, 448.0f); }
__device__ __forceinline__ unsigned pk4_fp8(float a, float b, float cc, float d) { unsigned w = 0u; w = __builtin_amdgcn_cvt_pk_fp8_f32(sat_fp8(a), sat_fp8(b), w, false); w = __builtin_amdgcn_cvt_pk_fp8_f32(sat_fp8(cc), sat_fp8(d), w, true); return w; }
__device__ __forceinline__ void transpose_item8(const float* W, int ldw, int k0, int sn0, unsigned char* dst, int K8, float* scr, int lane) {
    { const int c4 = lane & 7, rr = lane >> 3; const float* wp = W + (size_t)(k0 + rr) * ldw + sn0 + 4 * c4;
        f4 v[8];
#pragma unroll
        for (int i = 0; i < 8; ++i) v[i] = *(const f4*)(wp + (size_t)(8 * i) * ldw);
#pragma unroll
        for (int i = 0; i < 8; ++i) { float* sp = scr + (rr + 8 * i) * 33 + 4 * c4; sp[0] = v[i].x; sp[1] = v[i].y; sp[2] = v[i].z; sp[3] = v[i].w; } }
    LDS_WAIT();
    const int cc = lane & 7; constexpr float SC = (float)(1 << pg8::F8_WSCALE_LOG2);
#pragma unroll
    for (int j = 0; j < 4; ++j) { const int n = (lane >> 3) + 8 * j; const float* s = scr + (8 * cc) * 33 + n;
        u2 o; o.x = pk4_fp8(s[0 * 33] * SC, s[1 * 33] * SC, s[2 * 33] * SC, s[3 * 33] * SC); o.y = pk4_fp8(s[4 * 33] * SC, s[5 * 33] * SC, s[6 * 33] * SC, s[7 * 33] * SC);
        *(u2*)(dst + (size_t)n * K8 + 8 * cc) = o; }
    LDS_WAIT();
}
__device__ __forceinline__ void ph_prologue(const Ctx& c) {
    float* S3 = (float*)c.lds;
    float* scr = (float*)(c.lds + 32768 + c.wave * 8704);
    for (int i = c.tid; i < 3 * D; i += NTHREADS) { const int r = i / D, k = i % D; const float v = r < 2 ? c.cvec()[r * D + k] : c.c_ctx()[k]; S3[i] = silu_f(v); }
    __syncthreads();
    constexpr int N_MOD = 2 * (MODW / 32);
    constexpr int N_ROPE = 16;
    constexpr int N_WIN = 2 * 32 * 210, N_WOUT = 2 * 32 * 64, N_EXP = 96 * 2048;
    constexpr int NITEMS = N_MOD + N_ROPE + N_WIN + N_WOUT + N_EXP;
    const int lane = c.lane;
    constexpr int NGRABS = N_MOD + (NITEMS - N_MOD + 7) / 8;
    for (;;) {
      int g = 0; if (lane == 0) g = (int)atomicAdd(c.ctl() + CW_PROQ, 1u);
      g = __builtin_amdgcn_readfirstlane(g);
      if (g >= NGRABS) break;
      const int it0 = g < N_MOD ? g : N_MOD + (g - N_MOD) * 8, it1 = g < N_MOD ? g + 1 : (it0 + 8 < NITEMS ? it0 + 8 : NITEMS);
      for (int it = it0; it < it1; ++it) {
        int r = it;
        if (r < N_MOD) {
            const int l = r / (MODW / 32), cb = r % (MODW / 32), kg = lane >> 3, cl = lane & 7, col = cb * 32 + 4 * cl;
            const float* wp = c.w_ada() + (size_t)l * D * MODW + col;
            f4 a0 = {0.f, 0.f, 0.f, 0.f}, a1 = a0, a2 = a0;
#pragma unroll 8
            for (int i = 0; i < 256; ++i) { const int k = kg + 8 * i; const f4 w = *(const f4*)(wp + (size_t)k * MODW); a0 += S3[k] * w; a1 += S3[D + k] * w; a2 += S3[2 * D + k] * w; }
#pragma unroll
            for (int q = 0; q < 4; ++q) {
#pragma unroll
                for (int o = 8; o < 64; o <<= 1) { a0[q] += __shfl_xor(a0[q], o); a1[q] += __shfl_xor(a1[q], o); a2[q] += __shfl_xor(a2[q], o); } }
            if (kg == 0) { const f4 bb = *(const f4*)(c.b_ada() + (size_t)l * MODW + col);
                *(f4*)(c.MOD() + (size_t)(l * 3 + 0) * MODW + col) = a0 + bb; *(f4*)(c.MOD() + (size_t)(l * 3 + 1) * MODW + col) = a1 + bb; *(f4*)(c.MOD() + (size_t)(l * 3 + 2) * MODW + col) = a2 + bb; }
            continue; }
        r -= N_MOD;
        if (r < N_ROPE) { const int en = r * 64 + lane, pos = en >> 4, i = en & 15; const float f = powf(10000.f, -(float)i / 16.f), ang = (float)pos * f;
            c.ROPE()[en * 2] = cosf(ang); c.ROPE()[en * 2 + 1] = sinf(ang); continue; }
        r -= N_ROPE;
        if (r < N_WIN) { const int l = r / (32 * 210), q = r % (32 * 210), kb = q / 210, nb = q % 210, n0 = nb * 32;
            int sn0, nv = 32;
            if (n0 < 4608) sn0 = n0; else if (n0 < 6656) sn0 = n0 + 32; else if (n0 < 6688) sn0 = 4608 + (n0 - 6656); else { sn0 = 6688; nv = 16; }
            transpose_item(c.w_in() + (size_t)l * D * INW, INW, kb * 64, sn0, nv, c.WIN() + ((size_t)l * NP + n0) * D + kb * 64, D, scr, lane); continue; }
        r -= N_WIN;
        if (r < N_WOUT) { const int l = r / 2048, q = r % 2048, kb = q / 64, nb = q % 64;
            transpose_item(c.w_out() + (size_t)l * D * D, D, kb * 64, nb * 32, 32, c.WOUT() + ((size_t)l * D + nb * 32) * D + kb * 64, D, scr, lane); continue; }
        r -= N_WOUT;
        { const int mtx = r / 2048, q = r % 2048, kb = q / 64, nb = q % 64; const int ty = mtx / 32, le = mtx % 32;
            const bool f8 = ((F8MASK) >> (le >> 4)) & 1;
            if (ty < 2) { const float* W = (ty == 0 ? c.w_exp_gate() : c.w_exp_up()) + (size_t)le * D * FF;
                const int drow = (nb >> 2) * 256 + ty * 128 + (nb & 3) * 32;
                if (!f8) transpose_item(W, FF, kb * 64, nb * 32, 32, c.WGU() + ((size_t)le * 4096 + drow) * D + kb * 64, D, scr, lane);
                else transpose_item8(W, FF, kb * 64, nb * 32, (unsigned char*)(c.WGU() + (size_t)(le >> 4) * NE * 4096 * D) + ((size_t)(le & 15) * 4096 + drow) * D + kb * 64, D, scr, lane); }
            else { const float* W = c.w_exp_down() + (size_t)le * FF * D;
                if (!f8) transpose_item(W, D, kb * 64, nb * 32, 32, c.WDN() + ((size_t)le * D + nb * 32) * FF + kb * 64, FF, scr, lane);
                else transpose_item8(W, D, kb * 64, nb * 32, (unsigned char*)(c.WDN() + (size_t)(le >> 4) * NE * D * FF) + ((size_t)(le & 15) * D + nb * 32) * FF + kb * 64, FF, scr, lane); } }
    }
    }
}


__device__ __forceinline__ void moe_combine_row(const Ctx& c, int lm, int row, int lane, f4 (&v)[8]) {
    f4 acc[8];
#pragma unroll
    for (int j = 0; j < 8; ++j) acc[j] = (f4){0.f, 0.f, 0.f, 0.f};
    const int* so = c.SLOTOF() + row;
    const int sl = lane < NE ? so[(size_t)lane * MROWS] : -1;
#pragma unroll
    for (int e = 0; e < NE; ++e) { const int s = __builtin_amdgcn_readlane(sl, e);
        if (s >= 0) { const float gate = c.GATEV()[e * ESLOT + s]; const bf16* yr = c.Y() + ((size_t)e * ESLOT + s) * D + 4 * lane;
#pragma unroll
            for (int j = 0; j < 8; ++j) { const u2 raw = *(const u2*)(yr + 256 * j);
                acc[j].x += gate * bf2f(raw.x & 0xffffu); acc[j].y += gate * bf2f(raw.x >> 16); acc[j].z += gate * bf2f(raw.y & 0xffffu); acc[j].w += gate * bf2f(raw.y >> 16); } } }
    const float* g2 = c.MOD() + (size_t)(lm * 3 + modrow(row)) * MODW + 5 * D + 4 * lane;
#pragma unroll
    for (int j = 0; j < 8; ++j) v[j] += *(const f4*)(g2 + 256 * j) * acc[j];
}

__device__ __forceinline__ void ph_norm1(const Ctx& c, int l) {
    const int lane = c.lane;
    for (int row = c.gw; row < MROWS; row += c.ngw) {
        const float* xr = src_row_ptr(c, l, row);
        f4 v[8]; float ss = 0.f;
#pragma unroll
        for (int j = 0; j < 8; ++j) v[j] = *(const f4*)(xr + 4 * lane + 256 * j);
        if (l > 0) { moe_combine_row(c, l - 1, row, lane, v); float* hw = c.HX() + (size_t)row * D;
#pragma unroll
            for (int j = 0; j < 8; ++j) *(f4*)(hw + 4 * lane + 256 * j) = v[j]; }
#pragma unroll
        for (int j = 0; j < 8; ++j) ss += v[j].x * v[j].x + v[j].y * v[j].y + v[j].z * v[j].z + v[j].w * v[j].w;
        ss = wave_sum(ss);
        const float rstd = 1.0f / sqrtf(ss * (1.0f / D) + 1e-6f);
        const float* nw = c.norm_mix_w() + (size_t)l * D; const float* md = c.MOD() + (size_t)(l * 3 + modrow(row)) * MODW;
        bf16* orow = c.NX() + (size_t)row * D;
#pragma unroll
        for (int j = 0; j < 8; ++j) { const int col = 4 * lane + 256 * j; const f4 w = *(const f4*)(nw + col), sh = *(const f4*)(md + col), sc = *(const f4*)(md + D + col);
            const f4 y = v[j] * rstd * w * (1.0f + sc) + sh; u2 o; o.x = pk2(y.x, y.y); o.y = pk2(y.z, y.w); *(u2*)(orow + col) = o; }
    }
}

using pg8::f32x4; using pg8::u32x4; using pg8::Unit;
struct EpiP {
    static constexpr bool PERM = true, AFTER_DRAIN = false;
    bf16* P; float* PS;
    __device__ __forceinline__ void operator()(const f32x4 (&acc)[2][2][4][2], const Unit& u, int wr, int wc, int fr, int fq) const {
        const int row0 = u.pm * 256 + wr * 64 + fr, col0 = u.pn * 256 + wc * 32 + 8 * fq;
#pragma unroll
        for (int ai = 0; ai < 2; ++ai)
#pragma unroll
            for (int m = 0; m < 4; ++m) { const int row = row0 + ai * 128 + m * 16; bf16* rowp = P + (size_t)row * NP + col0;
#pragma unroll
                for (int bj = 0; bj < 2; ++bj) { const f32x4 v0 = acc[ai][bj][m][0], v1 = acc[ai][bj][m][1];
                    u32x4 w; w.x = pg8::cvt_pk_bf16(v0[0], v0[1]); w.y = pg8::cvt_pk_bf16(v0[2], v0[3]); w.z = pg8::cvt_pk_bf16(v1[0], v1[1]); w.w = pg8::cvt_pk_bf16(v1[2], v1[3]);
                    *(u32x4*)(rowp + bj * 128) = w; }
                if (u.pn == 26 && wc < 2) { float* ps = PS + (size_t)row * 64 + wc * 32 + 8 * fq; *(f32x4*)ps = acc[ai][0][m][0]; *(f32x4*)(ps + 4) = acc[ai][0][m][1]; } }
    }
};
struct EpiResid {
    static constexpr bool PERM = false, AFTER_DRAIN = false;
    const float *x, *ctxin, *MOD; float* HX; int l;
    __device__ __forceinline__ void operator()(const f32x4 (&acc)[2][2][4][2], const Unit& u, int wr, int wc, int fr, int fq) const {
#pragma unroll
        for (int ai = 0; ai < 2; ++ai)
#pragma unroll
            for (int m = 0; m < 4; ++m) { const int row = u.pm * 256 + ai * 128 + wr * 64 + m * 16 + fr; float* dst = HX + (size_t)row * D;
                const float* src = (l == 0) ? (row < ML ? x + (size_t)row * D : ctxin + (size_t)(row - ML) * D) : dst;
                const float* g1 = MOD + (size_t)(l * 3 + modrow(row)) * MODW + 2 * D;
#pragma unroll
                for (int bj = 0; bj < 2; ++bj)
#pragma unroll
                    for (int n = 0; n < 2; ++n) { const int col = u.pn * 256 + bj * 128 + wc * 32 + n * 16 + 4 * fq;
                        *(f32x4*)(dst + col) = *(const f32x4*)(src + col) + *(const f32x4*)(g1 + col) * acc[ai][bj][m][n]; } }
    }
};
struct EpiSwiglu {
    static constexpr bool PERM = true, AFTER_DRAIN = false;
    bf16* HID;
    __device__ __forceinline__ void operator()(const f32x4 (&acc)[2][2][4][2], const Unit& u, int wr, int wc, int fr, int fq) const {
        const int row0 = u.pm * 256 + wr * 64 + fr, col0 = (u.pn & 15) * 128 + wc * 32 + 8 * fq;
#pragma unroll
        for (int ai = 0; ai < 2; ++ai)
#pragma unroll
            for (int m = 0; m < 4; ++m) { bf16* rowp = HID + (size_t)(row0 + ai * 128 + m * 16) * FF + col0;
                float h[8];
#pragma unroll
                for (int n = 0; n < 2; ++n)
#pragma unroll
                    for (int i = 0; i < 4; ++i) { const float g = acc[ai][0][m][n][i], up = acc[ai][1][m][n][i]; h[n * 4 + i] = silu_f(g) * up; }
                u32x4 w; w.x = pg8::cvt_pk_bf16(h[0], h[1]); w.y = pg8::cvt_pk_bf16(h[2], h[3]); w.z = pg8::cvt_pk_bf16(h[4], h[5]); w.w = pg8::cvt_pk_bf16(h[6], h[7]);
                *(u32x4*)rowp = w; }
    }
};
struct EpiSwiglu8 {
    static constexpr bool PERM = true, AFTER_DRAIN = false;
    unsigned char* HID8;
    __device__ __forceinline__ void operator()(const f32x4 (&acc)[2][2][4][2], const Unit& u, int wr, int wc, int fr, int fq) const {
        const int row0 = u.pm * 256 + wr * 64 + fr, col0 = (u.pn & 15) * 128 + wc * 32 + 8 * fq;
#pragma unroll
        for (int ai = 0; ai < 2; ++ai)
#pragma unroll
            for (int m = 0; m < 4; ++m) { unsigned char* rowp = HID8 + (size_t)(row0 + ai * 128 + m * 16) * FF + col0;
                float h[8];
#pragma unroll
                for (int n = 0; n < 2; ++n)
#pragma unroll
                    for (int i = 0; i < 4; ++i) { const float g = acc[ai][0][m][n][i], up = acc[ai][1][m][n][i]; h[n * 4 + i] = silu_f(g) * up; }
                u2 w; w.x = pk4_fp8(h[0], h[1], h[2], h[3]); w.y = pk4_fp8(h[4], h[5], h[6], h[7]);
                *(u2*)rowp = w; }
    }
};
struct EpiY {
    static constexpr bool PERM = true, AFTER_DRAIN = false;
    bf16* Yp;
    __device__ __forceinline__ void operator()(const f32x4 (&acc)[2][2][4][2], const Unit& u, int wr, int wc, int fr, int fq) const {
        const int row0 = u.pm * 256 + wr * 64 + fr, col0 = (u.pn & 7) * 256 + wc * 32 + 8 * fq;
#pragma unroll
        for (int ai = 0; ai < 2; ++ai)
#pragma unroll
            for (int m = 0; m < 4; ++m) { bf16* rowp = Yp + (size_t)(row0 + ai * 128 + m * 16) * D + col0;
#pragma unroll
                for (int bj = 0; bj < 2; ++bj) { const f32x4 v0 = acc[ai][bj][m][0], v1 = acc[ai][bj][m][1];
                    u32x4 w; w.x = pg8::cvt_pk_bf16(v0[0], v0[1]); w.y = pg8::cvt_pk_bf16(v0[2], v0[3]); w.z = pg8::cvt_pk_bf16(v1[0], v1[1]); w.w = pg8::cvt_pk_bf16(v1[2], v1[3]);
                    *(u32x4*)(rowp + bj * 128) = w; } }
    }
};
struct MoeOrder {
    int MT, NT, G, c;
    __device__ __forceinline__ bool next(int i, Unit& u) const { const int per = MT * NT; int e, r;
        if ((G & 7) == 0) { const int Lx = i * (G >> 3) + (c >> 3); if (Lx >= 2 * per) return false; e = 2 * (c & 7) + Lx / per; r = Lx % per; }
        else { const int L = i * G + c; if (L >= NE * per) return false; e = L / per; r = L % per; }
        u.pm = e * 5 + (r % MT); u.pn = e * NT + (r / MT); return true; }
    __device__ __forceinline__ void a_ready(const Unit&) const {}
    __device__ __forceinline__ void done(const Unit&) const {}
};
struct RowOrder {
    int nM, nN, G, c;
    __device__ __forceinline__ bool next(int i, Unit& u) const { const int L = i * G + c; if (L >= nM * nN) return false; u.pm = L % nM; u.pn = L / nM; return true; }
    __device__ __forceinline__ void a_ready(const Unit&) const {}
    __device__ __forceinline__ void done(const Unit&) const {}
};

__device__ __forceinline__ void ph_prep(const Ctx& c, int l) {
    const int lane = c.lane;
    const float* cw = c.gdn_conv_w() + (size_t)l * 5 * 1536;
    {
        for (int row = (blockIdx.x * 8 + c.wave) * 2; row < MROWS; row += gridDim.x * 16) {
            int t, T; if (row < ML) { t = row & (SEQ - 1); T = SEQ; } else { t = (row - ML) & (CTX - 1); T = CTX; }
#pragma unroll
            for (int j = 0; j < 3; ++j) {
                const int cb = j * 512 + lane * 8;
                u4 raw[6];
#pragma unroll
                for (int q = 0; q < 6; ++q) { const int tt = t + q - 2; raw[q] = (tt >= 0 && tt < T) ? *(const u4*)(c.P() + (size_t)(row + q - 2) * NP + PC_GDQ + cb) : (u4){0u, 0u, 0u, 0u}; }
                float a0[8], a1[8];
#pragma unroll
                for (int i = 0; i < 8; ++i) { a0[i] = 0.f; a1[i] = 0.f; }
#pragma unroll
                for (int tap = 0; tap < 5; ++tap) { const f4 w0 = *(const f4*)(cw + tap * 1536 + cb), w1 = *(const f4*)(cw + tap * 1536 + cb + 4);
                    const float wv[8] = {w0.x, w0.y, w0.z, w0.w, w1.x, w1.y, w1.z, w1.w};
                    const u4 r0 = raw[tap], r1 = raw[tap + 1];
                    const float x0[8] = {bf2f(r0.x & 0xffffu), bf2f(r0.x >> 16), bf2f(r0.y & 0xffffu), bf2f(r0.y >> 16), bf2f(r0.z & 0xffffu), bf2f(r0.z >> 16), bf2f(r0.w & 0xffffu), bf2f(r0.w >> 16)};
                    const float x1[8] = {bf2f(r1.x & 0xffffu), bf2f(r1.x >> 16), bf2f(r1.y & 0xffffu), bf2f(r1.y >> 16), bf2f(r1.z & 0xffffu), bf2f(r1.z >> 16), bf2f(r1.w & 0xffffu), bf2f(r1.w >> 16)};
#pragma unroll
                    for (int i = 0; i < 8; ++i) { a0[i] += wv[i] * x0[i]; a1[i] += wv[i] * x1[i]; } }
#pragma unroll
                for (int rr = 0; rr < 2; ++rr) { float* a = rr ? a1 : a0; float ss = 0.f;
#pragma unroll
                    for (int i = 0; i < 8; ++i) { a[i] = silu_f(a[i]); ss += a[i] * a[i]; }
                    if (j < 2) { ss += __shfl_xor(ss, 1); ss += __shfl_xor(ss, 2); ss += __shfl_xor(ss, 4); ss += __shfl_xor(ss, 8);
                        const float sc = (1.0f / sqrtf(ss + 1e-6f)) * (j == 0 ? 0.08838834764831845f : 1.0f);
#pragma unroll
                        for (int i = 0; i < 8; ++i) a[i] *= sc; }
                    float* o = c.GQKV() + (size_t)(row + rr) * 1536 + cb;
                    *(f4*)o = (f4){a[0], a[1], a[2], a[3]}; *(f4*)(o + 4) = (f4){a[4], a[5], a[6], a[7]}; }
            }
            if (lane < 16) { const int rr = lane >> 3, li = lane & 7; const float* ps = c.PS() + (size_t)(row + rr) * 64; const float av = ps[32 + li], bv = ps[40 + li];
                const float g = -expf(c.gdn_a_log()[l * 8 + li]) * softplus_f(av + c.gdn_dt_bias()[l * 8 + li]);
                c.GGB()[(size_t)(row + rr) * 16 + li] = g; c.GGB()[(size_t)(row + rr) * 16 + 8 + li] = 1.0f / (1.0f + expf(-bv)); }
        }
    }
}

__device__ __forceinline__ int scan_row(int s, int b, int dir) { if (s < CTX) return ML + b * CTX + (dir ? CTX - 1 - s : s); const int u = s - CTX; return b * SEQ + (dir ? SEQ - 1 - u : u); }
__device__ __forceinline__ void gla_scan_task(const Ctx& c, int b, int h, int dir) {
    float* sq = (float*)c.lds; float* sk = sq + 2048; float* sa = sk + 2048; float* sv = sa + 2048;
    const int e = c.wave * 16 + (c.lane & 15), dg = c.lane >> 4, d0 = dg * 16;
    float S[16];
#pragma unroll
    for (int i = 0; i < 16; ++i) S[i] = 0.f;
    for (int cs = 0; cs < (CTX + SEQ) / 32; ++cs) {
        __syncthreads();
        for (int idx = c.tid; idx < 2048; idx += NTHREADS) { const int tk = idx >> 6, d = idx & 63, row = scan_row(cs * 32 + tk, b, dir);
            sq[idx] = c.LQ()[(size_t)row * 256 + h * 64 + d]; sk[idx] = c.LK()[(size_t)row * 256 + h * 64 + d]; sa[idx] = expf(c.LA()[((size_t)dir * MROWS + row) * 256 + h * 64 + d]); }
        for (int idx = c.tid; idx < 4096; idx += NTHREADS) { const int tk = idx >> 7, e2 = idx & 127, row = scan_row(cs * 32 + tk, b, dir);
            sv[idx] = bf2f(c.P()[(size_t)row * NP + PC_GLV + h * 128 + e2]); }
        __syncthreads();
        for (int tk = 0; tk < 32; ++tk) {
            const float ve = sv[tk * 128 + e]; float o = 0.f;
#pragma unroll
            for (int i = 0; i < 16; ++i) { const int d = tk * 64 + d0 + i; S[i] = sa[d] * S[i] + sk[d] * ve; o += sq[d] * S[i]; }
            o += __shfl_xor(o, 16); o += __shfl_xor(o, 32);
            if (dg == 0) c.OGLA()[((size_t)dir * MROWS + scan_row(cs * 32 + tk, b, dir)) * 512 + h * 128 + e] = o;
        }
    }
}
__device__ __forceinline__ void gdn_scan_task(const Ctx& c, int b, int h, int dir) {
    float* sq = (float*)c.lds; float* sk = sq + 4096; float* sv = sk + 4096; float* sg = sv + 4096; float* sb = sg + 32;
    const int e = c.wave * 16 + (c.lane & 15), dg = c.lane >> 4, d0 = dg * 32;
    float S[32];
#pragma unroll
    for (int i = 0; i < 32; ++i) S[i] = 0.f;
    for (int cs = 0; cs < (CTX + SEQ) / 32; ++cs) {
        __syncthreads();
        for (int idx = c.tid; idx < 4096; idx += NTHREADS) { const int tk = idx >> 7, d = idx & 127, row = scan_row(cs * 32 + tk, b, dir); const float* g = c.GQKV() + (size_t)row * 1536 + h * 128 + d;
            sq[idx] = g[0]; sk[idx] = g[512]; sv[idx] = g[1024]; }
        if (c.tid < 32) { const int row = scan_row(cs * 32 + c.tid, b, dir); sg[c.tid] = expf(c.GGB()[(size_t)row * 16 + dir * 4 + h]); sb[c.tid] = c.GGB()[(size_t)row * 16 + 8 + dir * 4 + h]; }
        __syncthreads();
        for (int tk = 0; tk < 32; ++tk) {
            float ks = 0.f;
#pragma unroll
            for (int i = 0; i < 32; ++i) ks += sk[tk * 128 + d0 + i] * S[i];
            ks += __shfl_xor(ks, 16); ks += __shfl_xor(ks, 32);
            const float eg = sg[tk], delta = sb[tk] * (sv[tk * 128 + e] - eg * ks);
            float o = 0.f;
#pragma unroll
            for (int i = 0; i < 32; ++i) { const int d = tk * 128 + d0 + i; S[i] = eg * S[i] + sk[d] * delta; o += sq[d] * S[i]; }
            o += __shfl_xor(o, 16); o += __shfl_xor(o, 32);
            if (dg == 0) c.OGDN()[((size_t)dir * MROWS + scan_row(cs * 32 + tk, b, dir)) * 512 + h * 128 + e] = o;
        }
    }
}
__device__ __forceinline__ void na_task(const Ctx& c, int l, int task, int lane) {
    const bool lat = task < ML * 16;
    const int tq = lat ? task : task - ML * 16;
    const int h = tq & 15, row = (tq >> 4) + (lat ? 0 : ML);
    const int b = lat ? (row >> 12) : ((row - ML) >> 8);
    const bf16* P = c.P();
    const float qv = bf2f(P[(size_t)row * NP + PC_NAQ + h * 64 + lane]) * 0.125f;
    int krow[6]; float sc[6];
#pragma unroll
    for (int i = 0; i < 4; ++i) { krow[2 + i] = ML + b * CTX + lane + 64 * i; sc[2 + i] = 0.f; }
    if (lat) { const int t = row & (SEQ - 1), r = t >> 6, cq = t & 63; const int rs = min(max(r - 4, 0), 56), cs = min(max(cq - 8, 0), 48);
#pragma unroll
        for (int i = 0; i < 2; ++i) { const int lk = lane + 64 * i, j = lk >> 4, cc = lk & 15; krow[i] = b * SEQ + (rs + j) * 64 + cs + cc;
            sc[i] = c.na_rpb()[((size_t)(l * 16 + h) * 15 + (rs + j - r + 7)) * 31 + (cs + cc - cq + 15)]; } }
    else { krow[0] = krow[2]; krow[1] = krow[2]; sc[0] = -INFINITY; sc[1] = -INFINITY; }
#pragma unroll
    for (int i = 0; i < 6; ++i) {
        if (i >= 2 || lat) { const bf16* kp = P + (size_t)krow[i] * NP + PC_NAK + h * 64; float s = 0.f;
#pragma unroll
            for (int m = 0; m < 8; ++m) { const u4 w = *(const u4*)(kp + 8 * m);
                s += __int_as_float(__builtin_amdgcn_readlane(__float_as_int(qv), 8 * m + 0)) * bf2f(w.x & 0xffffu); s += __int_as_float(__builtin_amdgcn_readlane(__float_as_int(qv), 8 * m + 1)) * bf2f(w.x >> 16);
                s += __int_as_float(__builtin_amdgcn_readlane(__float_as_int(qv), 8 * m + 2)) * bf2f(w.y & 0xffffu); s += __int_as_float(__builtin_amdgcn_readlane(__float_as_int(qv), 8 * m + 3)) * bf2f(w.y >> 16);
                s += __int_as_float(__builtin_amdgcn_readlane(__float_as_int(qv), 8 * m + 4)) * bf2f(w.z & 0xffffu); s += __int_as_float(__builtin_amdgcn_readlane(__float_as_int(qv), 8 * m + 5)) * bf2f(w.z >> 16);
                s += __int_as_float(__builtin_amdgcn_readlane(__float_as_int(qv), 8 * m + 6)) * bf2f(w.w & 0xffffu); s += __int_as_float(__builtin_amdgcn_readlane(__float_as_int(qv), 8 * m + 7)) * bf2f(w.w >> 16); }
            sc[i] += s; } }
    float mx = sc[0];
#pragma unroll
    for (int i = 1; i < 6; ++i) mx = fmaxf(mx, sc[i]);
    mx = wave_max(mx);
    float sum = 0.f;
#pragma unroll
    for (int i = 0; i < 6; ++i) { sc[i] = expf(sc[i] - mx); sum += sc[i]; }
    sum = wave_sum(sum);
    const float inv = 1.0f / sum;
    float o = 0.f;
    const bf16* vp = P + PC_NAV + h * 64 + lane;
#pragma unroll
    for (int i = 0; i < 6; ++i) {
        if (i >= 2 || lat) {
#pragma unroll 8
            for (int sl = 0; sl < 64; ++sl) { const float p = __int_as_float(__builtin_amdgcn_readlane(__float_as_int(sc[i]), sl)); const int kr = __builtin_amdgcn_readlane(krow[i], sl);
                o += p * bf2f(vp[(size_t)kr * NP]); } } }
    c.CAT()[(size_t)row * D + h * 64 + lane] = (bf16)f2bf(o * inv);
}
__device__ __forceinline__ void ph_scan_na(const Ctx& c, int l) {
    for (int bt = blockIdx.x; bt < 32; bt += gridDim.x) { const int kind = bt >> 4, dir = (bt >> 3) & 1, b = (bt >> 2) & 1, h = bt & 3;
        if (kind == 0) gla_scan_task(c, b, h, dir); else gdn_scan_task(c, b, h, dir); }
    __syncthreads();
    const int ntask = ML * 16 + (l == 0 ? MC * 16 : 0), nchunk = ntask / 512;
    int* sh = (int*)(c.lds + MISC_OFF + 64);
    for (;;) {
        __syncthreads();
        if (c.tid == 0) *sh = (int)atomicAdd(c.ctl() + CW_NAQ + 64 * (l + 2 * c.rep), 1u);
        __syncthreads();
        const int ch = *sh;
        if (ch >= nchunk) break;
        for (int i = 0; i < 64; ++i) na_task(c, l, ch * 512 + c.wave * 64 + i, c.lane);
    }
}

__device__ __forceinline__ void ph_combine(const Ctx& c, int l) {
    const int lane = c.lane; const int nrows = l == 0 ? MROWS : ML;
    for (int row = c.gw; row < nrows; row += c.ngw) {
#pragma unroll
        for (int which = 0; which < 1; ++which) {
            const float* O = which == 0 ? c.OGLA() : c.OGDN(); const float* nwp = (which == 0 ? c.gla_norm_w() : c.gdn_norm_w()) + l * 128 + (lane & 15) * 8;
            const int gcol = (which == 0 ? PC_GLG : PC_GDZ) + lane * 8;
            const f4 a0 = *(const f4*)(O + (size_t)row * 512 + lane * 8), a1 = *(const f4*)(O + (size_t)row * 512 + lane * 8 + 4);
            const f4 b0 = *(const f4*)(O + ((size_t)MROWS + row) * 512 + lane * 8), b1 = *(const f4*)(O + ((size_t)MROWS + row) * 512 + lane * 8 + 4);
            float o[8] = {a0.x + b0.x, a0.y + b0.y, a0.z + b0.z, a0.w + b0.w, a1.x + b1.x, a1.y + b1.y, a1.z + b1.z, a1.w + b1.w};
            float ss = 0.f;
#pragma unroll
            for (int i = 0; i < 8; ++i) ss += o[i] * o[i];
            ss += __shfl_xor(ss, 1); ss += __shfl_xor(ss, 2); ss += __shfl_xor(ss, 4); ss += __shfl_xor(ss, 8);
            const float rstd = 1.0f / sqrtf(ss * (1.0f / 128.f) + 1e-6f);
            const u4 graw = *(const u4*)(c.P() + (size_t)row * NP + gcol);
            const float g[8] = {bf2f(graw.x & 0xffffu), bf2f(graw.x >> 16), bf2f(graw.y & 0xffffu), bf2f(graw.y >> 16), bf2f(graw.z & 0xffffu), bf2f(graw.z >> 16), bf2f(graw.w & 0xffffu), bf2f(graw.w >> 16)};
            float y[8];
#pragma unroll
            for (int i = 0; i < 8; ++i) y[i] = o[i] * rstd * nwp[i] * silu_f(g[i]);
            u4 w; w.x = pk2(y[0], y[1]); w.y = pk2(y[2], y[3]); w.z = pk2(y[4], y[5]); w.w = pk2(y[6], y[7]);
            *(u4*)(c.CAT() + (size_t)row * D + 1024 + which * 512 + lane * 8) = w;
        }
    }
}

__device__ __forceinline__ void ph_norm2_router(const Ctx& c, int l) {
    constexpr int DP = D + 4;
    float* WR = (float*)c.lds;
    const float* wr = c.w_router() + (size_t)l * D * NE;
    __syncthreads();
#pragma unroll 8
    for (int idx = c.tid; idx < D * NE; idx += NTHREADS) WR[(idx & 15) * DP + (idx >> 4)] = wr[idx];
    __syncthreads();
    const int lane = c.lane; const int nrows = l == 0 ? MROWS : ML;
    const int eid = ((lane >> 5) & 1) * 8 + ((lane >> 4) & 1) * 4 + ((lane >> 3) & 1) * 2 + ((lane >> 2) & 1);
    for (int row = c.gw; row < nrows; row += c.ngw) {
        const float* xr = c.HX() + (size_t)row * D;
        f4 v[8]; float ss = 0.f;
#pragma unroll
        for (int j = 0; j < 8; ++j) { v[j] = *(const f4*)(xr + 4 * lane + 256 * j); ss += v[j].x * v[j].x + v[j].y * v[j].y + v[j].z * v[j].z + v[j].w * v[j].w; }
        ss = wave_sum(ss);
        const float rstd = 1.0f / sqrtf(ss * (1.0f / D) + 1e-6f);
        const float* nw = c.norm_ffn_w() + (size_t)l * D; const float* md = c.MOD() + (size_t)(l * 3 + modrow(row)) * MODW;
        bf16* orow = c.NX() + (size_t)row * D;
#pragma unroll
        for (int j = 0; j < 8; ++j) { const int col = 4 * lane + 256 * j; const f4 w = *(const f4*)(nw + col), sh = *(const f4*)(md + 3 * D + col), sc = *(const f4*)(md + 4 * D + col);
            v[j] = v[j] * rstd * w * (1.0f + sc) + sh; u2 o; o.x = pk2(v[j].x, v[j].y); o.y = pk2(v[j].z, v[j].w); *(u2*)(orow + col) = o; }
        float acc[16];
#pragma unroll
        for (int e = 0; e < 16; ++e) acc[e] = 0.f;
#pragma unroll
        for (int j = 0; j < 8; ++j) {
            asm volatile("" ::: "memory");
#pragma unroll
            for (int e = 0; e < 16; ++e) { const f4 w = *(const f4*)(WR + e * DP + 256 * j + 4 * lane); acc[e] += v[j].x * w.x + v[j].y * w.y + v[j].z * w.z + v[j].w * w.w; } }
        float a8[8], a4[4], a2[2];
        { const bool hi = (lane & 32) != 0;
#pragma unroll
            for (int e = 0; e < 8; ++e) { const float send = hi ? acc[e] : acc[e + 8], keep = hi ? acc[e + 8] : acc[e]; a8[e] = keep + __shfl_xor(send, 32); } }
        { const bool hi = (lane & 16) != 0;
#pragma unroll
            for (int e = 0; e < 4; ++e) { const float send = hi ? a8[e] : a8[e + 4], keep = hi ? a8[e + 4] : a8[e]; a4[e] = keep + __shfl_xor(send, 16); } }
        { const bool hi = (lane & 8) != 0;
#pragma unroll
            for (int e = 0; e < 2; ++e) { const float send = hi ? a4[e] : a4[e + 2], keep = hi ? a4[e + 2] : a4[e]; a2[e] = keep + __shfl_xor(send, 8); } }
        float lg; { const bool hi = (lane & 4) != 0; const float send = hi ? a2[0] : a2[1], keep = hi ? a2[1] : a2[0]; lg = keep + __shfl_xor(send, 4); }
        lg += __shfl_xor(lg, 1); lg += __shfl_xor(lg, 2);
        float mx = lg;
        mx = fmaxf(mx, __shfl_xor(mx, 4)); mx = fmaxf(mx, __shfl_xor(mx, 8)); mx = fmaxf(mx, __shfl_xor(mx, 16)); mx = fmaxf(mx, __shfl_xor(mx, 32));
        const float ex = expf(lg - mx); float sum = ex;
        sum += __shfl_xor(sum, 4); sum += __shfl_xor(sum, 8); sum += __shfl_xor(sum, 16); sum += __shfl_xor(sum, 32);
        if ((lane & 3) == 0) c.AFF()[(size_t)row * 16 + eid] = ex / sum;
    }
}

__device__ __forceinline__ int block_excl_scan(int v, int* sc, int tid, int& total) {
    const int lane = tid & 63, w = tid >> 6; int x = v;
#pragma unroll
    for (int o = 1; o < 64; o <<= 1) { const int y = __shfl_up(x, o); if (lane >= o) x += y; }
    if (lane == 63) sc[w] = x;
    __syncthreads();
    int woff = 0, tot = 0;
#pragma unroll
    for (int i = 0; i < NWAVES; ++i) { const int t = sc[i]; woff += (i < w) ? t : 0; tot += t; }
    __syncthreads();
    total = tot; return woff + x - v;
}
__device__ __forceinline__ void ph_topk(const Ctx& c, int l) {
    unsigned* keys = (unsigned*)c.lds; unsigned* hist = keys + 4096; unsigned* misc = hist + 256; int* scs = (int*)(misc + 16);
    const int ntask = l == 0 ? 64 : 32, tid = c.tid;
    for (int task = blockIdx.x; task < ntask; task += gridDim.x) {
        const int s = task >> 5, b = (task >> 4) & 1, e = task & 15;
        const int n = s ? CTX : SEQ, cap = s ? 32 : 512, base_row = s ? ML + b * CTX : b * SEQ, slot_base = s ? 1024 + b * 32 : b * 512;
        __syncthreads();
        for (int i = tid; i < n; i += NTHREADS) keys[i] = __float_as_uint(c.AFF()[(size_t)(base_row + i) * 16 + e]);
        if (tid == 0) { misc[0] = 0u; misc[1] = (unsigned)cap; }
        unsigned prefix = 0u, mask = 0u;
        for (int shift = 24; shift >= 0; shift -= 8) {
            if (tid < 256) hist[tid] = 0u;
            __syncthreads();
            for (int i = tid; i < n; i += NTHREADS) { const unsigned k = keys[i]; if ((k & mask) == prefix) atomicAdd(&hist[(k >> shift) & 255u], 1u); }
            __syncthreads();
            if (tid < 64) { const unsigned kk = misc[1]; const unsigned h0 = hist[4 * tid], h1 = hist[4 * tid + 1], h2 = hist[4 * tid + 2], h3 = hist[4 * tid + 3];
                const unsigned s4 = h0 + h1 + h2 + h3; unsigned suf = s4;
#pragma unroll
                for (int o = 1; o < 64; o <<= 1) { const unsigned y = __shfl_down(suf, o); if (tid + o < 64) suf += y; }
                const unsigned above = suf - s4;
                if (above < kk && kk <= suf) { unsigned cum = above; int bin;
                    if (cum + h3 >= kk) bin = 3; else { cum += h3; if (cum + h2 >= kk) bin = 2; else { cum += h2; if (cum + h1 >= kk) bin = 1; else { cum += h1; bin = 0; } } }
                    misc[0] = prefix | ((unsigned)(4 * tid + bin) << shift); misc[1] = kk - cum; } }
            __syncthreads();
            prefix = misc[0]; mask |= 255u << shift;
        }
        const unsigned thr = prefix; const int need = (int)misc[1];
        const int ipt = n >= NTHREADS ? n / NTHREADS : 1, i0 = tid * ipt;
        int cg = 0, ce = 0;
        if (i0 < n) for (int i = 0; i < ipt; ++i) { const unsigned k = keys[i0 + i]; cg += k > thr; ce += k == thr; }
        int G, Etot;
        int og = block_excl_scan(cg, scs, tid, G);
        int oe = block_excl_scan(ce, scs, tid, Etot);
        if (i0 < n) for (int i = 0; i < ipt; ++i) { const unsigned k = keys[i0 + i]; int slot = -1;
            if (k > thr) slot = og++; else if (k == thr) { if (oe < need) slot = G + oe; ++oe; }
            c.SLOTOF()[(size_t)e * MROWS + base_row + i0 + i] = slot >= 0 ? slot_base + slot : -1;
            if (slot >= 0) { c.IDX()[e * ESLOT + slot_base + slot] = base_row + i0 + i; c.GATEV()[e * ESLOT + slot_base + slot] = __uint_as_float(k); } }
    }
}

__device__ __forceinline__ void ph_gather(const Ctx& c, int l) {
    const int nsl = l == 0 ? 1088 : 1024, ntask = NE * nsl;
    const bool f8 = ((F8MASK) >> l) & 1;
    for (int task = c.gw; task < ntask; task += c.ngw) { const int e = task / nsl, slot = task % nsl; const int tok = c.IDX()[e * ESLOT + slot];
        if (!f8) { const u4* src = (const u4*)(c.NX() + (size_t)tok * D); u4* dst = (u4*)(c.AMOE() + ((size_t)e * ESLOT + slot) * D);
#pragma unroll
            for (int j = 0; j < 4; ++j) dst[c.lane + 64 * j] = src[c.lane + 64 * j]; }
        else { const u4* src = (const u4*)(c.NX() + (size_t)tok * D) + 4 * c.lane;
            const u4 r0 = src[0], r1 = src[1], r2 = src[2], r3 = src[3];
            u4 o0, o1;
            o0.x = pk4_fp8(bf2f(r0.x & 0xffffu), bf2f(r0.x >> 16), bf2f(r0.y & 0xffffu), bf2f(r0.y >> 16)); o0.y = pk4_fp8(bf2f(r0.z & 0xffffu), bf2f(r0.z >> 16), bf2f(r0.w & 0xffffu), bf2f(r0.w >> 16));
            o0.z = pk4_fp8(bf2f(r1.x & 0xffffu), bf2f(r1.x >> 16), bf2f(r1.y & 0xffffu), bf2f(r1.y >> 16)); o0.w = pk4_fp8(bf2f(r1.z & 0xffffu), bf2f(r1.z >> 16), bf2f(r1.w & 0xffffu), bf2f(r1.w >> 16));
            o1.x = pk4_fp8(bf2f(r2.x & 0xffffu), bf2f(r2.x >> 16), bf2f(r2.y & 0xffffu), bf2f(r2.y >> 16)); o1.y = pk4_fp8(bf2f(r2.z & 0xffffu), bf2f(r2.z >> 16), bf2f(r2.w & 0xffffu), bf2f(r2.w >> 16));
            o1.z = pk4_fp8(bf2f(r3.x & 0xffffu), bf2f(r3.x >> 16), bf2f(r3.y & 0xffffu), bf2f(r3.y >> 16)); o1.w = pk4_fp8(bf2f(r3.z & 0xffffu), bf2f(r3.z >> 16), bf2f(r3.w & 0xffffu), bf2f(r3.w >> 16));
            u4* dst = (u4*)((unsigned char*)c.AMOE() + ((size_t)e * ESLOT + slot) * D) + 2 * c.lane;
            dst[0] = o0; dst[1] = o1; } }
}

__device__ __forceinline__ void ph_final(const Ctx& c) {
    const int lane = c.lane;
    for (int row = c.gw; row < ML; row += c.ngw) {
        const float* xr = c.HX() + (size_t)row * D;
        f4 v[8]; float ss = 0.f;
#pragma unroll
        for (int j = 0; j < 8; ++j) v[j] = *(const f4*)(xr + 4 * lane + 256 * j);
        moe_combine_row(c, 1, row, lane, v);
#pragma unroll
        for (int j = 0; j < 8; ++j) ss += v[j].x * v[j].x + v[j].y * v[j].y + v[j].z * v[j].z + v[j].w * v[j].w;
        ss = wave_sum(ss);
        const float rstd = 1.0f / sqrtf(ss * (1.0f / D) + 1e-6f);
#pragma unroll
        for (int j = 0; j < 8; ++j) { const int col = 4 * lane + 256 * j; *(f4*)(c.out() + (size_t)row * D + col) = v[j] * rstd * *(const f4*)(c.final_norm_w() + col); }
    }
#if defined(TPROBE)
    if (TPROBE >= 0) { __syncthreads(); if (blockIdx.x == 0 && c.tid == 0) { asm volatile("s_waitcnt vmcnt(0)" ::: "memory"); c.out()[0] = 20480.0f * (float)(c.ctl()[CW_TP + 64 * TPROBE] >> 11); } }
#endif
}

typedef short bf16x8 __attribute__((ext_vector_type(8)));
#define RAW_BAR() do { asm volatile("s_waitcnt lgkmcnt(0)" ::: "memory"); __builtin_amdgcn_s_barrier(); asm volatile("" ::: "memory"); } while (0)
#define MFMA16(a, b, c) __builtin_amdgcn_mfma_f32_16x16x32_bf16((a), (b), (c), 0, 0, 0)
__device__ __forceinline__ bf16x8 ldfrag(const LAS unsigned char* base, int stride, int row0, int ks, int lane) {
    return *(const LAS bf16x8*)(base + (row0 + (lane & 15)) * stride + ks * 64 + (lane >> 4) * 16);
}
__device__ __forceinline__ int blk_row0(int b, int blk) { return blk < 4 ? ML + b * CTX + blk * 64 : b * SEQ + (blk - 4) * 64; }
__device__ __forceinline__ int scan_blk(int s, int dir) { return s < 4 ? (dir ? 3 - s : s) : (dir ? 71 - s : s); }

__device__ __forceinline__ void gla_tiles_unit(const Ctx& c, int lsel, int ud);
__device__ __forceinline__ void ph_gdn_chunk(const Ctx& c, int l) {
    LAS unsigned char* L = (LAS unsigned char*)c.lds;
    constexpr int O_D = 0, O_MO = 8192, O_A = 26624, O_G = 45056, O_R1 = 47104, O_SOL = 83968;
    const float* GQ = c.GQKV(); const float* GG = c.GGB();
    LAS float* gcf = (LAS float*)(L + O_G); LAS float* gcb = gcf + 64; LAS float* btf = gcf + 128; LAS float* btb = gcf + 192; LAS float* egf = gcf + 256; LAS float* egb = gcf + 320;
    __syncthreads();
    { const int tid = c.tid;
    for (int i = tid; i < 73728 / 16; i += NTHREADS) *(LAS u4*)(L + O_SOL + i * 16) = (u4){0u, 0u, 0u, 0u}; }
    int* qsh = (int*)(c.lds + MISC_OFF + 64);
    unsigned* qhead = c.ctl() + CW_CHQ + 64 * (l + 2 * c.rep);
    int nxt = 0; if (c.tid == 0) nxt = (int)atomicAdd(qhead, 1u);
    for (;;) {
        __syncthreads();
        if (c.tid == 0) *qsh = nxt;
        __syncthreads();
        const int unit = __builtin_amdgcn_readfirstlane(*qsh);
        if (unit >= 544 + 1088) break;
        if (c.tid == 0) nxt = (int)atomicAdd(qhead, 1u);
        if (unit >= 544) { const int uu = unit - 544, bhq = (uu >> 1) / 68, blq = (uu >> 1) % 68; gla_tiles_unit(c, l, (bhq * UDS + blq) * 2 + (uu & 1)); continue; }
        const int bh = unit / 68, blk = unit % 68, b = bh >> 2, h = bh & 3, row0 = blk_row0(b, blk);
        int tid = c.tid; asm volatile("" : "+v"(tid));
        const int lane = tid & 63, w = __builtin_amdgcn_readfirstlane(tid >> 6);
        for (int idx = tid; idx < 2048; idx += NTHREADS) { const int t = idx >> 5, d4 = (idx & 31) * 4; const float* src = GQ + (size_t)(row0 + t) * 1536 + h * 128 + d4;
            const f4 qv = *(const f4*)src, kv = *(const f4*)(src + 512);
            u2 qo, ko; qo.x = pk2(qv.x, qv.y); qo.y = pk2(qv.z, qv.w); ko.x = pk2(kv.x, kv.y); ko.y = pk2(kv.z, kv.w);
            *(LAS u2*)(L + O_R1 + t * 272 + d4 * 2) = ko; *(LAS u2*)(L + O_R1 + 17408 + t * 272 + d4 * 2) = qo; }
        if (w == 0) { const float* gp = GG + (size_t)(row0 + lane) * 16; float a = gp[h], bq = gp[4 + h];
#pragma unroll
            for (int o = 1; o < 64; o <<= 1) { const float y = __shfl_up(a, o); if (lane >= o) a += y; const float z = __shfl_down(bq, o); if (lane + o < 64) bq += z; }
            gcf[lane] = a; gcb[lane] = bq; btf[lane] = gp[8 + h]; btb[lane] = gp[12 + h]; egf[lane] = __expf(a); egb[lane] = __expf(bq); }
        const int sdir = tid >> 8, scol = tid & 255;
        const float* rp = GQ + (size_t)row0 * 1536 + (scol < 128 ? 1024 + h * 128 + scol : 512 + h * 128 + (scol - 128));
        __syncthreads();
        {
            const int which = w >> 2, tt = w & 3;
            const LAS unsigned char* Ab = L + O_R1 + (which ? 17408 : 0);
            const int t = tt * 16 + (lane & 15); const float gft = gcf[t], gbt = gcb[t], bft = btf[t], bbt = btb[t];
            bf16x8 ga[4], gb[4][4];
#pragma unroll
            for (int ks = 0; ks < 4; ++ks) { ga[ks] = ldfrag(Ab, 272, tt * 16, ks, lane);
#pragma unroll
                for (int st = 0; st < 4; ++st) gb[st][ks] = ldfrag(L + O_R1, 272, st * 16, ks, lane); }
            __builtin_amdgcn_sched_barrier(0);
#pragma unroll
            for (int st = 0; st < 4; ++st) {
                f32x4 acc = {0.f, 0.f, 0.f, 0.f};
#pragma unroll
                for (int ks = 0; ks < 4; ++ks) acc = MFMA16(gb[st][ks], ga[ks], acc);
                const int s0 = st * 16 + (lane >> 4) * 4;
                if (which == 0) { float mf[4], mb[4];
#pragma unroll
                    for (int j = 0; j < 4; ++j) { const int s = s0 + j; mf[j] = s < t ? bft * acc[j] * __expf(gft - gcf[s]) : 0.f; mb[j] = s > t ? bbt * acc[j] * __expf(gbt - gcb[s]) : 0.f; }
                    if (st == tt) { *(LAS f4*)(L + O_D + ((tt * 16 + (lane & 15)) * 16 + (lane >> 4) * 4) * 4) = (f4){mf[0], mf[1], mf[2], mf[3]};
                                    *(LAS f4*)(L + O_D + 4096 + ((tt * 16 + (lane & 15)) * 16 + (lane >> 4) * 4) * 4) = (f4){mb[0], mb[1], mb[2], mb[3]};
#pragma unroll
                                    for (int j = 0; j < 4; ++j) { mf[j] = 0.f; mb[j] = 0.f; } }
                    u2 of, ob; of.x = pk2(mf[0], mf[1]); of.y = pk2(mf[2], mf[3]); ob.x = pk2(mb[0], mb[1]); ob.y = pk2(mb[2], mb[3]);
                    *(LAS u2*)(L + O_MO + t * 144 + s0 * 2) = of; *(LAS u2*)(L + O_MO + 9216 + t * 144 + s0 * 2) = ob; }
                else { float vf[4], vb[4];
#pragma unroll
                    for (int j = 0; j < 4; ++j) { const int s = s0 + j; vf[j] = s <= t ? acc[j] * __expf(gft - gcf[s]) : 0.f; vb[j] = s >= t ? acc[j] * __expf(gbt - gcb[s]) : 0.f; }
                    u2 of, ob; of.x = pk2(vf[0], vf[1]); of.y = pk2(vf[2], vf[3]); ob.x = pk2(vb[0], vb[1]); ob.y = pk2(vb[2], vb[3]);
                    *(LAS u2*)(L + O_A + t * 144 + s0 * 2) = of; *(LAS u2*)(L + O_A + 9216 + t * 144 + s0 * 2) = ob; }
            }
        }
        __syncthreads();
        {
            const LAS float* btx = sdir ? btb : btf; const LAS float* egx = sdir ? egb : egf;
            LAS unsigned char* sp = L + O_SOL + (sdir * 256 + scol) * 144;
            const int mdir = w >> 2, mq = w & 3;
float rhn[16];
            { const int q0 = sdir ? 3 : 0;
#pragma unroll
                for (int ii = 0; ii < 16; ++ii) rhn[ii] = rp[(size_t)(16 * q0 + ii) * 1536]; }
#define GDN_ROUND(RR) { constexpr int R = RR; \
                constexpr int qf = R, qb = 3 - R; \
                if constexpr (R > 0) { \
                    const int q = mdir ? qb : qf; \
                    const LAS unsigned char* Mo = L + O_MO + mdir * 9216; const LAS unsigned char* So = L + O_SOL + mdir * 36864; \
                    const bf16x8 m0 = ldfrag(Mo, 144, q * 16, 0, lane), m1 = ldfrag(Mo, 144, q * 16, 1, lane); \
                    _Pragma("unroll") for (int ct = 0; ct < 4; ++ct) { const int ctile = mq * 4 + ct; f32x4 acc = {0.f, 0.f, 0.f, 0.f}; \
                        acc = MFMA16(m0, ldfrag(So, 144, ctile * 16, 0, lane), acc); acc = MFMA16(m1, ldfrag(So, 144, ctile * 16, 1, lane), acc); \
                        *(LAS f32x4*)(L + O_R1 + ((mdir * 256 + ctile * 16 + (lane & 15)) * 16 + (lane >> 4) * 4) * 4) = acc; } \
                    __syncthreads(); \
                } \
                const int q = sdir ? qb : qf; \
                float x[16]; \
                _Pragma("unroll") for (int ii = 0; ii < 16; ++ii) { const int t = 16 * q + ii; float v = rhn[ii] * btx[t]; if (scol >= 128) v *= egx[t]; x[ii] = v; } \
                if constexpr (R < 3) { const int qn = sdir ? qb - 1 : qf + 1; _Pragma("unroll") for (int ii = 0; ii < 16; ++ii) rhn[ii] = rp[(size_t)(16 * qn + ii) * 1536]; } \
                if constexpr (R > 0) { const LAS f4* cb = (const LAS f4*)(L + O_R1 + (sdir * 256 + scol) * 64); \
                    _Pragma("unroll") for (int i4 = 0; i4 < 4; ++i4) { const f4 cv = cb[i4]; x[4 * i4] -= cv.x; x[4 * i4 + 1] -= cv.y; x[4 * i4 + 2] -= cv.z; x[4 * i4 + 3] -= cv.w; } } \
                const LAS float* Dp = (const LAS float*)(L + O_D + sdir * 4096) + q * 256; \
                if (sdir == 0) { \
                    _Pragma("unroll") for (int ii = 1; ii < 16; ++ii) { float a = x[ii]; \
                        _Pragma("unroll") for (int j4 = 0; j4 < 16; j4 += 4) if (j4 < ii) { const f4 m = *(const LAS f4*)(Dp + ii * 16 + j4); \
                            _Pragma("unroll") for (int jj = 0; jj < 4; ++jj) if (j4 + jj < ii) a -= m[jj] * x[j4 + jj]; } \
                        x[ii] = a; } \
                } else { \
                    _Pragma("unroll") for (int ii = 14; ii >= 0; --ii) { float a = x[ii]; \
                        _Pragma("unroll") for (int j4 = 0; j4 < 16; j4 += 4) if (j4 + 3 > ii) { const f4 m = *(const LAS f4*)(Dp + ii * 16 + j4); \
                            _Pragma("unroll") for (int jj = 0; jj < 4; ++jj) if (j4 + jj > ii) a -= m[jj] * x[j4 + jj]; } \
                        x[ii] = a; } \
                } \
                u4 o0, o1; o0.x = pk2(x[0], x[1]); o0.y = pk2(x[2], x[3]); o0.z = pk2(x[4], x[5]); o0.w = pk2(x[6], x[7]); o1.x = pk2(x[8], x[9]); o1.y = pk2(x[10], x[11]); o1.z = pk2(x[12], x[13]); o1.w = pk2(x[14], x[15]); \
                *(LAS u4*)(sp + q * 32) = o0; *(LAS u4*)(sp + q * 32 + 16) = o1; \
                __syncthreads(); \
            }
            GDN_ROUND(0) GDN_ROUND(1) GDN_ROUND(2) GDN_ROUND(3)
#undef GDN_ROUND
        }
        for (int idx = tid; idx < 4096; idx += NTHREADS) { const int dir = idx >> 11, t = (idx >> 5) & 63, d4 = (idx & 31) * 4;
            const f4 kv = *(const f4*)(GQ + (size_t)(row0 + t) * 1536 + 512 + h * 128 + d4);
            const float sc = dir ? __expf(gcb[0] - gcb[t]) : __expf(gcf[63] - gcf[t]);
            LAS bf16* dst = (LAS bf16*)(L + O_R1 + dir * 18432) + t;
            dst[(d4 + 0) * 72] = (bf16)f2bf(kv.x * sc); dst[(d4 + 1) * 72] = (bf16)f2bf(kv.y * sc); dst[(d4 + 2) * 72] = (bf16)f2bf(kv.z * sc); dst[(d4 + 3) * 72] = (bf16)f2bf(kv.w * sc); }
        __syncthreads();
        {
            const int dir = w >> 2, wq = w & 3, ud = (bh * UDS + blk) * 2 + dir;
            const LAS unsigned char* Aa = L + O_A + dir * 9216; const LAS unsigned char* SolU = L + O_SOL + dir * 256 * 144; const LAS unsigned char* SolW = SolU + 128 * 144;
            const LAS unsigned char* Kd = L + O_R1 + dir * 18432;
            const LAS float* egx = dir ? egb : egf;
            const bf16x8 a0 = ldfrag(Aa, 144, wq * 16, 0, lane), a1 = ldfrag(Aa, 144, wq * 16, 1, lane);
            const int t = wq * 16 + (lane & 15); const float eg = egx[t];
            bf16* qp = c.GDQP() + (size_t)ud * 8192 + ((size_t)(wq * 4) * 64 + (lane & 15) + 16 * (lane >> 5)) * 8 + ((lane >> 4) & 1) * 4; bf16* o0 = c.GDO0() + ((size_t)ud * 64 + t) * 128 + (lane >> 4) * 4;
            const float* qsrc = GQ + (size_t)(row0 + t) * 1536 + h * 128 + (lane >> 4) * 4;
            const bf16x8 kd[2][2] = {{ldfrag(Kd, 144, (2 * wq) * 16, 0, lane), ldfrag(Kd, 144, (2 * wq) * 16, 1, lane)}, {ldfrag(Kd, 144, (2 * wq + 1) * 16, 0, lane), ldfrag(Kd, 144, (2 * wq + 1) * 16, 1, lane)}};
            {
                bf16x8 fw[8][2];
#pragma unroll
                for (int nt = 0; nt < 8; ++nt) { fw[nt][0] = ldfrag(SolW, 144, nt * 16, 0, lane); fw[nt][1] = ldfrag(SolW, 144, nt * 16, 1, lane); }
                __builtin_amdgcn_sched_barrier(0);
#pragma unroll
                for (int nt = 0; nt < 8; ++nt) { f32x4 acc = {0.f, 0.f, 0.f, 0.f};
                    acc = MFMA16(fw[nt][0], a0, acc); acc = MFMA16(fw[nt][1], a1, acc);
                    const f4 qv = *(const f4*)(qsrc + nt * 16);
                    u2 o; o.x = pk2(qv.x * eg - acc[0], qv.y * eg - acc[1]); o.y = pk2(qv.z * eg - acc[2], qv.w * eg - acc[3]);
                    *(u2*)(qp + ((nt >> 1) * 64 + 32 * (nt & 1)) * 8) = o; }
#pragma unroll
                for (int dt2 = 0; dt2 < 2; ++dt2) { const int dtile = 2 * wq + dt2;
                    bf16* ap = c.GDAP() + (size_t)ud * 16384 + ((size_t)(dtile * 4) * 64 + (lane & 15) + 16 * (lane >> 5)) * 8 + ((lane >> 4) & 1) * 4;
#pragma unroll
                    for (int nt = 0; nt < 8; ++nt) { f32x4 acc = {0.f, 0.f, 0.f, 0.f};
                        acc = MFMA16(fw[nt][0], kd[dt2][0], acc); acc = MFMA16(fw[nt][1], kd[dt2][1], acc);
                        u2 o; o.x = pk2(-acc[0], -acc[1]); o.y = pk2(-acc[2], -acc[3]); *(u2*)(ap + ((nt >> 1) * 64 + 32 * (nt & 1)) * 8) = o; } }
            }
            {
                bf16x8 fu[8][2];
                __builtin_amdgcn_sched_barrier(0);
#pragma unroll
                for (int nt = 0; nt < 8; ++nt) { fu[nt][0] = ldfrag(SolU, 144, nt * 16, 0, lane); fu[nt][1] = ldfrag(SolU, 144, nt * 16, 1, lane); }
                __builtin_amdgcn_sched_barrier(0);
#pragma unroll
                for (int nt = 0; nt < 8; ++nt) { f32x4 acc = {0.f, 0.f, 0.f, 0.f};
                    acc = MFMA16(fu[nt][0], a0, acc); acc = MFMA16(fu[nt][1], a1, acc);
                    u2 ob; ob.x = pk2(acc[0], acc[1]); ob.y = pk2(acc[2], acc[3]); *(u2*)(o0 + nt * 16) = ob; }
#pragma unroll
                for (int dt2 = 0; dt2 < 2; ++dt2) { const int dtile = 2 * wq + dt2;
                    bf16* bm = c.GDBM() + ((size_t)ud * 128 + (lane & 15)) * 128 + dtile * 16 + (lane >> 4) * 4;
#pragma unroll
                    for (int nt = 0; nt < 8; ++nt) { f32x4 acc = {0.f, 0.f, 0.f, 0.f};
                        acc = MFMA16(kd[dt2][0], fu[nt][0], acc); acc = MFMA16(kd[dt2][1], fu[nt][1], acc);
                        u2 bb; bb.x = pk2(acc[0], acc[1]); bb.y = pk2(acc[2], acc[3]); *(u2*)(bm + (size_t)nt * 16 * 128) = bb; } }
            }
            if ((tid & 255) == 0) c.GDGL()[ud] = dir ? egb[0] : egf[63];
        }
    }
}

struct GdnSet { bf16x8 fa[4]; u2 bm[2]; float gl; };
__device__ __forceinline__ f32x4 bf4_to_f32(u2 v) { return (f32x4){bf2f(v.x & 0xffffu), bf2f(v.x >> 16), bf2f(v.y & 0xffffu), bf2f(v.y >> 16)}; }
template <int MODE> __device__ __forceinline__ void gdn_scan2(const Ctx& c, int b, int h, int dir, int eq) {
    LAS unsigned char* L = (LAS unsigned char*)c.lds;
    constexpr int O_ST = 0, STB = 32 * 272;
    int tid = c.tid; asm volatile("" : "+v"(tid));
    const int lane = tid & 63, w = __builtin_amdgcn_readfirstlane(tid >> 6);
    f32x4 S[2];
    S[0] = (f32x4){0.f, 0.f, 0.f, 0.f}; S[1] = S[0];
    __syncthreads();
    for (int i = tid; i < 2 * STB / 16; i += NTHREADS) *(LAS u4*)(L + O_ST + i * 16) = (u4){0u, 0u, 0u, 0u};
    const int udb = (b * 4 + h) * UDS;
    const int gst_off = ((eq * 2 * 4 + (w >> 1)) * 64 + (lane & 15) + 16 * ((w & 1) * 2 + (lane >> 5))) * 8 + ((lane >> 4) & 1) * 4;
    { bf16* g0 = c.GDST() + (size_t)((udb + scan_blk(0, dir)) * 2 + dir) * 16384 + gst_off; *(u2*)g0 = (u2){0u, 0u}; *(u2*)(g0 + 4 * 64 * 8) = (u2){0u, 0u}; }
    GdnSet s0, s1, s2, s3, s4;
    int vzero = 0; asm volatile("" : "+v"(vzero));
#define GDN_LOAD(SET, sn) { const int udn = (udb + scan_blk((sn), dir)) * 2 + dir; \
        const bf16* ga = c.GDAP() + (size_t)udn * 16384 + ((size_t)(w * 4) * 64 + lane) * 8; \
        _Pragma("unroll") for (int ks = 0; ks < 4; ++ks) SET.fa[ks] = *(const bf16x8*)(ga + ks * 512); \
        const bf16* bmn = c.GDBM() + ((size_t)udn * 128 + eq * 32 + (lane & 15)) * 128 + w * 16 + (lane >> 4) * 4; \
        SET.bm[0] = *(const u2*)bmn; SET.bm[1] = *(const u2*)(bmn + 16 * 128); \
        SET.gl = c.GDGL()[udn + vzero]; }
#define GDN_STEP(s, SET) { const int buf = (s) & 1; \
        S[0] = S[0] * SET.gl + bf4_to_f32(SET.bm[0]); S[1] = S[1] * SET.gl + bf4_to_f32(SET.bm[1]); \
        RAW_BAR(); \
        const LAS unsigned char* ST = L + O_ST + buf * STB; \
        bf16x8 fs[2][4]; \
        _Pragma("unroll") for (int ks = 0; ks < 4; ++ks) { fs[0][ks] = ldfrag(ST, 272, 0, ks, lane); fs[1][ks] = ldfrag(ST, 272, 16, ks, lane); } \
        __builtin_amdgcn_sched_barrier(0); asm volatile("s_waitcnt lgkmcnt(0)" ::: "memory"); __builtin_amdgcn_sched_barrier(0); \
        _Pragma("unroll") for (int ks = 0; ks < 4; ++ks) { S[0] = MFMA16(SET.fa[ks], fs[0][ks], S[0]); S[1] = MFMA16(SET.fa[ks], fs[1][ks], S[1]); } \
        if (MODE == 0 || MODE == 2) GDN_LOAD(SET, ((s) + 5 < 68 ? (s) + 5 : 67)) \
        { bf16* gn = c.GDST() + (size_t)((udb + scan_blk(((s) + 1 < 68 ? (s) + 1 : 67), dir)) * 2 + dir) * 16384 + gst_off; \
          _Pragma("unroll") for (int et = 0; et < 2; ++et) { u2 o; o.x = pk2(S[et][0], S[et][1]); o.y = pk2(S[et][2], S[et][3]); \
            *(LAS u2*)(L + O_ST + (buf ^ 1) * STB + (et * 16 + (lane & 15)) * 272 + (w * 16 + (lane >> 4) * 4) * 2) = o; \
            if ((MODE == 0 || MODE == 3) && (s) + 1 < 68) *(u2*)(gn + et * 4 * 64 * 8) = o; } } }
    GDN_LOAD(s0, 0) GDN_LOAD(s1, 1) GDN_LOAD(s2, 2) GDN_LOAD(s3, 3) GDN_LOAD(s4, 4)
    for (int s = 0; s < 65; s += 5) { GDN_STEP(s, s0) GDN_STEP(s + 1, s1) GDN_STEP(s + 2, s2) GDN_STEP(s + 3, s3) GDN_STEP(s + 4, s4) }
    GDN_STEP(65, s0) GDN_STEP(66, s1) GDN_STEP(67, s2)
#undef GDN_LOAD
#undef GDN_STEP
}

__device__ __forceinline__ void gdn_out_unit(const Ctx& c, int l, int b, int h, int blk) {
    int tid = c.tid; asm volatile("" : "+v"(tid));
    const int lane = tid & 63, w = __builtin_amdgcn_readfirstlane(tid >> 6);
    const int tt = w & 3, ehh = w >> 2, t = tt * 16 + (lane & 15), row = blk_row0(b, blk) + t;
    float* red = (float*)c.lds;
    f32x4 acc[4];
#pragma unroll
    for (int i = 0; i < 4; ++i) acc[i] = (f32x4){0.f, 0.f, 0.f, 0.f};
#pragma unroll
    for (int dir = 0; dir < 2; ++dir) { const size_t ud = (size_t)(((b * 4 + h) * UDS + blk) * 2 + dir);
        const bf16* gq = c.GDQP() + ud * 8192 + ((size_t)(tt * 4) * 64 + lane) * 8;
        bf16x8 qf[4], sf[4][4]; u2 o0v[4];
#pragma unroll
        for (int ks = 0; ks < 4; ++ks) qf[ks] = *(const bf16x8*)(gq + ks * 512);
#pragma unroll
        for (int e4 = 0; e4 < 4; ++e4) { const int etile = ehh * 4 + e4; const bf16* gs = c.GDST() + ud * 16384 + ((size_t)(etile * 4) * 64 + lane) * 8;
            o0v[e4] = *(const u2*)(c.GDO0() + (ud * 64 + t) * 128 + etile * 16 + (lane >> 4) * 4);
#pragma unroll
            for (int ks = 0; ks < 4; ++ks) sf[e4][ks] = *(const bf16x8*)(gs + ks * 512); }
        __builtin_amdgcn_sched_barrier(0);
#pragma unroll
        for (int e4 = 0; e4 < 4; ++e4) { acc[e4] += bf4_to_f32(o0v[e4]);
#pragma unroll
            for (int ks = 0; ks < 4; ++ks) acc[e4] = MFMA16(sf[e4][ks], qf[ks], acc[e4]); }
        __builtin_amdgcn_sched_barrier(0); }
    float ss = 0.f;
#pragma unroll
    for (int e4 = 0; e4 < 4; ++e4) ss += acc[e4][0] * acc[e4][0] + acc[e4][1] * acc[e4][1] + acc[e4][2] * acc[e4][2] + acc[e4][3] * acc[e4][3];
    ss += __shfl_xor(ss, 16); ss += __shfl_xor(ss, 32);
    __syncthreads();
    if (lane < 16) red[ehh * 64 + t] = ss;
    __syncthreads();
    const float rstd = 1.0f / sqrtf((red[t] + red[64 + t]) * (1.0f / 128.f) + 1e-6f);
    const float* nw = c.gdn_norm_w() + l * 128;
#pragma unroll
    for (int e4 = 0; e4 < 4; ++e4) { const int e0 = (ehh * 4 + e4) * 16 + (lane >> 4) * 4;
        const u2 zr = *(const u2*)(c.P() + (size_t)row * NP + PC_GDZ + h * 128 + e0); const f32x4 z = bf4_to_f32(zr); const f4 nv = *(const f4*)(nw + e0);
        u2 o; o.x = pk2(acc[e4][0] * rstd * nv.x * silu_f(z[0]), acc[e4][1] * rstd * nv.y * silu_f(z[1])); o.y = pk2(acc[e4][2] * rstd * nv.z * silu_f(z[2]), acc[e4][3] * rstd * nv.w * silu_f(z[3]));
        *(u2*)(c.CAT() + (size_t)row * D + 1536 + h * 128 + e0) = o; }
}
__device__ __forceinline__ void gla_out_unit(const Ctx& c, int l, int b, int h, int blk);
__device__ __forceinline__ void ph_combine2(const Ctx& c, int l) {
    const int nb = l == 0 ? 68 : 64, nunit = 8 * nb;
    for (int u = blockIdx.x; u < 2 * nunit; u += gridDim.x) { const int kind = u >= nunit, uu = kind ? u - nunit : u, bh = uu / nb, blk = (uu % nb) + (68 - nb);
        if (kind == 0) gdn_out_unit(c, l, bh >> 2, bh & 3, blk); else gla_out_unit(c, l, bh >> 2, bh & 3, blk); }
}

__device__ __forceinline__ void gla_scan2(const Ctx& c, int b, int h, int dir, int eh) {
    LAS unsigned char* L = (LAS unsigned char*)c.lds;
    constexpr int O_QT = 0, O_KT = 9216, O_KH = 18432, O_VT = 27648, O_ATT = 36864, O_ST = 46080, O_CP = 64512, O_DEC = O_CP + 2048;
    const int tid = c.tid, lane = c.lane, w = c.wave, d = tid & 63, part = tid >> 6;
    LAS float* CP = (LAS float*)(L + O_CP); LAS float* DEC = (LAS float*)(L + O_DEC);
    const float* LQp = c.LQ(); const float* LKp = c.LK(); const float* LAp = c.LA() + (size_t)dir * MROWS * 256; const bf16* Pp = c.P();
    f32x4 S[2];
    S[0] = (f32x4){0.f, 0.f, 0.f, 0.f}; S[1] = S[0];
    __syncthreads();
    for (int i = tid; i < 9216 / 16; i += NTHREADS) *(LAS u4*)(L + O_ST + i * 16) = (u4){0u, 0u, 0u, 0u};
    float la[8], qv[8], kv[8]; unsigned vv[8];
    { const int row0 = blk_row0(b, scan_blk(0, dir));
#pragma unroll
        for (int ii = 0; ii < 8; ++ii) { const int i = part * 8 + ii, row = row0 + (dir ? 63 - i : i);
            la[ii] = LAp[(size_t)row * 256 + h * 64 + d]; qv[ii] = LQp[(size_t)row * 256 + h * 64 + d]; kv[ii] = LKp[(size_t)row * 256 + h * 64 + d]; vv[ii] = Pp[(size_t)row * NP + PC_GLV + h * 128 + eh * 64 + d]; } }
    for (int s = 0; s < 68; ++s) {
        const int blk = scan_blk(s, dir), row0 = blk_row0(b, blk), buf = s & 1;
        float p[8]; float run = 0.f;
#pragma unroll
        for (int ii = 0; ii < 8; ++ii) { run += la[ii]; p[ii] = run; }
        CP[part * 64 + d] = run;
        RAW_BAR();
        float off = 0.f, tot = 0.f;
#pragma unroll
        for (int pp = 0; pp < 8; ++pp) { const float xx = CP[pp * 64 + d]; tot += xx; off += (pp < part) ? xx : 0.f; }
        unsigned kh[8];
#pragma unroll
        for (int ii = 0; ii < 8; ++ii) { const float cum = off + p[ii]; const int i = part * 8 + ii;
            *(LAS bf16*)(L + O_QT + i * 144 + d * 2) = (bf16)f2bf(qv[ii] * __expf(cum)); *(LAS bf16*)(L + O_KT + i * 144 + d * 2) = (bf16)f2bf(kv[ii] * __expf(-cum)); kh[ii] = f2bf(kv[ii] * __expf(tot - cum)); }
        { u4 o; o.x = kh[0] | (kh[1] << 16); o.y = kh[2] | (kh[3] << 16); o.z = kh[4] | (kh[5] << 16); o.w = kh[6] | (kh[7] << 16); *(LAS u4*)(L + O_KH + d * 144 + part * 16) = o;
          u4 v; v.x = vv[0] | (vv[1] << 16); v.y = vv[2] | (vv[3] << 16); v.z = vv[4] | (vv[5] << 16); v.w = vv[6] | (vv[7] << 16); *(LAS u4*)(L + O_VT + d * 144 + part * 16) = v; }
        if (part == 0) DEC[d] = __expf(tot);
        if (s + 1 < 68) { const int rown = blk_row0(b, scan_blk(s + 1, dir));
#pragma unroll
            for (int ii = 0; ii < 8; ++ii) { const int i = part * 8 + ii, row = rown + (dir ? 63 - i : i);
                la[ii] = LAp[(size_t)row * 256 + h * 64 + d]; qv[ii] = LQp[(size_t)row * 256 + h * 64 + d]; kv[ii] = LKp[(size_t)row * 256 + h * 64 + d]; vv[ii] = Pp[(size_t)row * NP + PC_GLV + h * 128 + eh * 64 + d]; } }
        RAW_BAR();
        const int tt = w & 3, wh = w >> 2, ti = tt * 16 + (lane & 15);
#pragma unroll
        for (int i2 = 0; i2 < 2; ++i2) { const int st = 2 * wh + i2; f32x4 acc = {0.f, 0.f, 0.f, 0.f};
#pragma unroll
            for (int ks = 0; ks < 2; ++ks) acc = MFMA16(ldfrag(L + O_KT, 144, st * 16, ks, lane), ldfrag(L + O_QT, 144, tt * 16, ks, lane), acc);
            const int s0 = st * 16 + (lane >> 4) * 4;
            u2 o; o.x = pk2(s0 + 0 <= ti ? acc[0] : 0.f, s0 + 1 <= ti ? acc[1] : 0.f); o.y = pk2(s0 + 2 <= ti ? acc[2] : 0.f, s0 + 3 <= ti ? acc[3] : 0.f);
            *(LAS u2*)(L + O_ATT + ti * 144 + s0 * 2) = o; }
        RAW_BAR();
        { const int trow = row0 + (dir ? 63 - ti : ti); float* og = c.OGLA() + ((size_t)dir * MROWS + trow) * 512 + h * 128 + eh * 64 + (lane >> 4) * 4;
            const LAS unsigned char* ST = L + O_ST + buf * 9216;
#pragma unroll
            for (int i2 = 0; i2 < 2; ++i2) { const int et = 2 * wh + i2; f32x4 acc = {0.f, 0.f, 0.f, 0.f};
#pragma unroll
                for (int ks = 0; ks < 2; ++ks) acc = MFMA16(ldfrag(L + O_VT, 144, et * 16, ks, lane), ldfrag(L + O_ATT, 144, tt * 16, ks, lane), acc);
#pragma unroll
                for (int ks = 0; ks < 2; ++ks) acc = MFMA16(ldfrag(ST, 144, et * 16, ks, lane), ldfrag(L + O_QT, 144, tt * 16, ks, lane), acc);
                *(f32x4*)(og + et * 16) = acc; }
            const f4 dec = *(const LAS f4*)(DEC + tt * 16 + (lane >> 4) * 4);
#pragma unroll
            for (int i2 = 0; i2 < 2; ++i2) { const int et = 2 * wh + i2; S[i2] = S[i2] * dec;
#pragma unroll
                for (int ks = 0; ks < 2; ++ks) S[i2] = MFMA16(ldfrag(L + O_KH, 144, tt * 16, ks, lane), ldfrag(L + O_VT, 144, et * 16, ks, lane), S[i2]);
                u2 o; o.x = pk2(S[i2][0], S[i2][1]); o.y = pk2(S[i2][2], S[i2][3]);
                *(LAS u2*)(L + O_ST + (buf ^ 1) * 9216 + (et * 16 + (lane & 15)) * 144 + (tt * 16 + (lane >> 4) * 4) * 2) = o; } }
    }
}

__device__ __forceinline__ void gla_tiles_unit(const Ctx& c, int lsel, int ud) {
    LAS unsigned char* L = (LAS unsigned char*)c.lds;
    constexpr int O_QT = 0, O_KT = 9216, O_KH = 18432, O_VT = 27648, O_CP = 46080;
    int tid = c.tid; asm volatile("" : "+v"(tid));
    const int d = tid & 63, part = tid >> 6;
    const int dir = ud & 1, blk = (ud >> 1) % UDS, bh = (ud >> 1) / UDS, b = bh >> 2, h = bh & 3, row0 = blk_row0(b, blk);
    LAS float* CP = (LAS float*)(L + O_CP);
    const bf16* Pp = c.P();
    float la[8], qv[8], kv[8];
    { const float* gwp = c.gla_gate_w() + ((size_t)(lsel * 2 + dir) * 16) * 256 + h * 64 + d; const float gbias = c.gla_gate_b()[(size_t)(lsel * 2 + dir) * 256 + h * 64 + d];
        float gwv[16];
#pragma unroll
        for (int r = 0; r < 16; ++r) gwv[r] = gwp[(size_t)r * 256];
        const bool latent = blk >= 4; const int half = d >> 5, fi = d & 15; const bool lo = (d & 16) == 0;
        unsigned qraw[8], kraw[8];
#pragma unroll
        for (int ii = 0; ii < 8; ++ii) { const int i = part * 8 + ii, row = row0 + (dir ? 63 - i : i);
            qraw[ii] = Pp[(size_t)row * NP + PC_GLQ + h * 64 + d]; kraw[ii] = Pp[(size_t)row * NP + PC_GLK + h * 64 + d]; }
#pragma unroll
        for (int ii = 0; ii < 8; ++ii) { const int i = part * 8 + ii, tk = dir ? 63 - i : i, row = row0 + tk;
            float q = bf2f(qraw[ii]), k = bf2f(kraw[ii]);
            const float qo = __shfl_xor(q, 16), ko = __shfl_xor(k, 16);
            if (latent) { const int t = (blk - 4) * 64 + tk, pos = half ? (t & 63) : (t >> 6); const float cs = c.ROPE()[(pos * 16 + fi) * 2], sn = c.ROPE()[(pos * 16 + fi) * 2 + 1];
                q = lo ? q * cs - qo * sn : q * cs + qo * sn; k = lo ? k * cs - ko * sn : k * cs + ko * sn; }
            qv[ii] = q * 0.125f; kv[ii] = k;
            const float* ps = c.PS() + (size_t)row * 64 + dir * 16; float z = gbias;
#pragma unroll
            for (int r = 0; r < 16; ++r) z += ps[r] * gwv[r];
            la[ii] = logsigmoid_f(z) * 0.0625f; } }
    unsigned vv[16];
    { const int e = tid & 127, qtr = tid >> 7;
#pragma unroll
        for (int ii = 0; ii < 16; ++ii) { const int i = qtr * 16 + ii, row = row0 + (dir ? 63 - i : i); vv[ii] = Pp[(size_t)row * NP + PC_GLV + h * 128 + e]; } }
    float p[8]; float run = 0.f;
#pragma unroll
    for (int ii = 0; ii < 8; ++ii) { run += la[ii]; p[ii] = run; }
    __syncthreads();
    CP[part * 64 + d] = run;
    __syncthreads();
    float off = 0.f, tot = 0.f;
#pragma unroll
    for (int pp = 0; pp < 8; ++pp) { const float xx = CP[pp * 64 + d]; tot += xx; off += (pp < part) ? xx : 0.f; }
    unsigned kh[8];
#pragma unroll
    for (int ii = 0; ii < 8; ++ii) { const float cum = off + p[ii]; const int i = part * 8 + ii;
        *(LAS bf16*)(L + O_QT + i * 144 + d * 2) = (bf16)f2bf(qv[ii] * __expf(cum)); *(LAS bf16*)(L + O_KT + i * 144 + d * 2) = (bf16)f2bf(kv[ii] * __expf(-cum)); kh[ii] = f2bf(kv[ii] * __expf(tot - cum)); }
    { u4 o; o.x = kh[0] | (kh[1] << 16); o.y = kh[2] | (kh[3] << 16); o.z = kh[4] | (kh[5] << 16); o.w = kh[6] | (kh[7] << 16); *(LAS u4*)(L + O_KH + d * 144 + part * 16) = o; }
    { const int e = tid & 127, qtr = tid >> 7; u4 v0, v1;
        v0.x = vv[0] | (vv[1] << 16); v0.y = vv[2] | (vv[3] << 16); v0.z = vv[4] | (vv[5] << 16); v0.w = vv[6] | (vv[7] << 16);
        v1.x = vv[8] | (vv[9] << 16); v1.y = vv[10] | (vv[11] << 16); v1.z = vv[12] | (vv[13] << 16); v1.w = vv[14] | (vv[15] << 16);
        *(LAS u4*)(L + O_VT + e * 144 + qtr * 32) = v0; *(LAS u4*)(L + O_VT + e * 144 + qtr * 32 + 16) = v1; }
    if (part == 0) c.GLDEC()[(size_t)ud * 64 + d] = __expf(tot);
    __syncthreads();
    { const int f = tid >> 6, lp = tid & 63, r = (f >> 1) * 16 + (lp & 15), kc = (f & 1) * 4 + (lp >> 4);
        *(u4*)(c.GLQT() + (size_t)ud * 4096 + tid * 8) = *(const LAS u4*)(L + O_QT + r * 144 + kc * 16);
        *(u4*)(c.GLKT() + (size_t)ud * 4096 + tid * 8) = *(const LAS u4*)(L + O_KT + r * 144 + kc * 16);
        *(u4*)(c.GLKH() + (size_t)ud * 4096 + tid * 8) = *(const LAS u4*)(L + O_KH + r * 144 + kc * 16);
#pragma unroll
        for (int hh = 0; hh < 2; ++hh) { const int j = tid + 512 * hh, f2 = j >> 6, r2 = (f2 >> 1) * 16 + (lp & 15), kc2 = (f2 & 1) * 4 + (lp >> 4);
            *(u4*)(c.GLVT() + (size_t)ud * 8192 + j * 8) = *(const LAS u4*)(L + O_VT + r2 * 144 + kc2 * 16); } }
}

struct GlaSet { bf16x8 vt[2][2], kh[2]; f4 dec; };
__device__ __forceinline__ void gla_scan3(const Ctx& c, int b, int h, int dir, int eh) {
    int tid = c.tid; asm volatile("" : "+v"(tid));
    const int lane = tid & 63, w = __builtin_amdgcn_readfirstlane(tid >> 6);
    const int tt = w & 3, wh = w >> 2;
    f32x4 S[2];
    S[0] = (f32x4){0.f, 0.f, 0.f, 0.f}; S[1] = S[0];
    const int udb = (b * 4 + h) * UDS;
    const int gst_off = (((eh * 4 + 2 * wh) * 2 + (tt >> 1)) * 64 + (lane & 15) + 16 * ((tt & 1) * 2 + (lane >> 5))) * 8 + ((lane >> 4) & 1) * 4;
    { bf16* g0 = c.GLST() + (size_t)((udb + scan_blk(0, dir)) * 2 + dir) * 8192 + gst_off; *(u2*)g0 = (u2){0u, 0u}; *(u2*)(g0 + 2 * 64 * 8) = (u2){0u, 0u}; }
    GlaSet s0, s1, s2, s3, s4;
#define GLA_LOAD(SET, sn) { const size_t udn = (size_t)((udb + scan_blk((sn), dir)) * 2 + dir); \
        _Pragma("unroll") for (int ks = 0; ks < 2; ++ks) { \
            SET.kh[ks] = *(const bf16x8*)(c.GLKH() + udn * 4096 + ((tt * 2 + ks) * 64 + lane) * 8); \
            _Pragma("unroll") for (int i2 = 0; i2 < 2; ++i2) SET.vt[i2][ks] = *(const bf16x8*)(c.GLVT() + udn * 8192 + (((eh * 4 + 2 * wh + i2) * 2 + ks) * 64 + lane) * 8); } \
        SET.dec = *(const f4*)(c.GLDEC() + udn * 64 + tt * 16 + (lane >> 4) * 4); }
#define GLA_STEP(s, SET) { \
        _Pragma("unroll") for (int i2 = 0; i2 < 2; ++i2) { S[i2] = S[i2] * SET.dec; S[i2] = MFMA16(SET.kh[0], SET.vt[i2][0], S[i2]); S[i2] = MFMA16(SET.kh[1], SET.vt[i2][1], S[i2]); } \
        GLA_LOAD(SET, ((s) + 5 < 68 ? (s) + 5 : 67)) \
        if ((s) + 1 < 68) { bf16* gn = c.GLST() + (size_t)((udb + scan_blk((s) + 1, dir)) * 2 + dir) * 8192 + gst_off; \
            _Pragma("unroll") for (int i2 = 0; i2 < 2; ++i2) { u2 o; o.x = pk2(S[i2][0], S[i2][1]); o.y = pk2(S[i2][2], S[i2][3]); *(u2*)(gn + i2 * 2 * 64 * 8) = o; } } }
    GLA_LOAD(s0, 0) GLA_LOAD(s1, 1) GLA_LOAD(s2, 2) GLA_LOAD(s3, 3) GLA_LOAD(s4, 4)
    for (int s = 0; s < 65; s += 5) { GLA_STEP(s, s0) GLA_STEP(s + 1, s1) GLA_STEP(s + 2, s2) GLA_STEP(s + 3, s3) GLA_STEP(s + 4, s4) }
    GLA_STEP(65, s0) GLA_STEP(66, s1) GLA_STEP(67, s2)
#undef GLA_LOAD
#undef GLA_STEP
}

__device__ __forceinline__ void gla_out_unit(const Ctx& c, int l, int b, int h, int blk) {
    LAS unsigned char* L = (LAS unsigned char*)c.lds;
    constexpr int O_ATT = 0, O_O = 9216, OST = 132;
    int tid = c.tid; asm volatile("" : "+v"(tid));
    const int lane = tid & 63, w = __builtin_amdgcn_readfirstlane(tid >> 6);
    const int tt = w & 3, ehh = w >> 2, ti = tt * 16 + (lane & 15), row0 = blk_row0(b, blk);
    LAS float* Ob = (LAS float*)(L + O_O);
#pragma unroll 1
    for (int dir = 0; dir < 2; ++dir) { const size_t ud = (size_t)(((b * 4 + h) * UDS + blk) * 2 + dir);
        const bf16x8 q0 = *(const bf16x8*)(c.GLQT() + ud * 4096 + ((tt * 2 + 0) * 64 + lane) * 8), q1 = *(const bf16x8*)(c.GLQT() + ud * 4096 + ((tt * 2 + 1) * 64 + lane) * 8);
        __syncthreads();
        bf16x8 vf[4][2], sf[4][2];
#pragma unroll
        for (int e4 = 0; e4 < 4; ++e4) { const int etile = ehh * 4 + e4;
            const bf16* gv = c.GLVT() + ud * 8192 + ((size_t)(etile * 2) * 64 + lane) * 8; const bf16* gs = c.GLST() + ud * 8192 + ((size_t)(etile * 2) * 64 + lane) * 8;
            vf[e4][0] = *(const bf16x8*)gv; vf[e4][1] = *(const bf16x8*)(gv + 512); sf[e4][0] = *(const bf16x8*)gs; sf[e4][1] = *(const bf16x8*)(gs + 512); }
        if (ehh == 0) {
            bf16x8 kf[4][2];
#pragma unroll
            for (int st = 0; st < 4; ++st) { kf[st][0] = *(const bf16x8*)(c.GLKT() + ud * 4096 + ((st * 2 + 0) * 64 + lane) * 8); kf[st][1] = *(const bf16x8*)(c.GLKT() + ud * 4096 + ((st * 2 + 1) * 64 + lane) * 8); }
#pragma unroll
            for (int st = 0; st < 4; ++st) { f32x4 acc = {0.f, 0.f, 0.f, 0.f};
                acc = MFMA16(kf[st][0], q0, acc); acc = MFMA16(kf[st][1], q1, acc);
                const int s0i = st * 16 + (lane >> 4) * 4;
                u2 o; o.x = pk2(s0i + 0 <= ti ? acc[0] : 0.f, s0i + 1 <= ti ? acc[1] : 0.f); o.y = pk2(s0i + 2 <= ti ? acc[2] : 0.f, s0i + 3 <= ti ? acc[3] : 0.f);
                *(LAS u2*)(L + O_ATT + ti * 144 + s0i * 2) = o; } }
        __syncthreads();
        const bf16x8 at0 = ldfrag(L + O_ATT, 144, tt * 16, 0, lane), at1 = ldfrag(L + O_ATT, 144, tt * 16, 1, lane);
        const int tok = dir ? 63 - ti : ti;
#pragma unroll
        for (int e4 = 0; e4 < 4; ++e4) { const int etile = ehh * 4 + e4; f32x4 acc = {0.f, 0.f, 0.f, 0.f};
            acc = MFMA16(vf[e4][0], at0, acc); acc = MFMA16(vf[e4][1], at1, acc);
            acc = MFMA16(sf[e4][0], q0, acc); acc = MFMA16(sf[e4][1], q1, acc);
            LAS float* op = Ob + tok * OST + etile * 16 + (lane >> 4) * 4;
            if (dir == 0) *(LAS f32x4*)op = acc; else { const f32x4 prev = *(LAS f32x4*)op; *(LAS f32x4*)op = prev + acc; } }
    }
    __syncthreads();
    const float* nw = c.gla_norm_w() + l * 128;
    unsigned grv[8];
#pragma unroll
    for (int i = 0; i < 8; ++i) grv[i] = *(const unsigned*)(c.P() + (size_t)(row0 + w * 8 + i) * NP + PC_GLG + h * 128 + 2 * lane);
    const float nw0 = nw[2 * lane], nw1 = nw[2 * lane + 1];
#pragma unroll
    for (int i = 0; i < 8; ++i) { const int tok = w * 8 + i, row = row0 + tok;
        const float o0 = Ob[tok * OST + 2 * lane], o1 = Ob[tok * OST + 2 * lane + 1];
        const float ss = wave_sum(o0 * o0 + o1 * o1);
        const float rstd = 1.0f / sqrtf(ss * (1.0f / 128.f) + 1e-6f);
        const unsigned gr = grv[i];
        *(unsigned*)(c.CAT() + (size_t)row * D + 1024 + h * 128 + 2 * lane) = pk2(o0 * rstd * nw0 * silu_f(bf2f(gr & 0xffffu)), o1 * rstd * nw1 * silu_f(bf2f(gr >> 16))); }
}

__device__ __forceinline__ void ph_scan_na2(const Ctx& c, int l) {
    for (int bt = blockIdx.x; bt < 64; bt += gridDim.x) { const int kind = bt >> 5, dir = (bt >> 4) & 1, b = (bt >> 3) & 1, h = (bt >> 1) & 3, eh = bt & 1;
        if (kind == 0) gla_scan2(c, b, h, dir, eh); else gdn_scan2<0>(c, b, h, dir, eh); }
    __syncthreads();
    const int ntask = ML * 16 + (l == 0 ? MC * 16 : 0), nchunk = ntask / 512;
    int* sh = (int*)(c.lds + MISC_OFF + 64);
    for (;;) {
        __syncthreads();
        if (c.tid == 0) *sh = (int)atomicAdd(c.ctl() + CW_NAQ + 64 * (l + 2 * c.rep), 1u);
        __syncthreads();
        const int ch = *sh;
        if (ch >= nchunk) break;
        for (int i = 0; i < 64; ++i) na_task(c, l, ch * 512 + c.wave * 64 + i, c.lane);
    }
}

__device__ __forceinline__ void na_unit(const Ctx& c, int l, int unit) {
    LAS unsigned char* L = (LAS unsigned char*)c.lds;
    constexpr int VST = 1936, O_VT = 0, O_RPB = 64 * VST + 64, O_KC = O_RPB + 1984, KST = 144, CTXC = 704;
    static_assert(O_KC + 256 * KST <= MISC_OFF, "NA LDS map");
    int tid = c.tid; asm volatile("" : "+v"(tid));
    const int lane = tid & 63, w = __builtin_amdgcn_readfirstlane(tid >> 6);
    const int ql = lane & 15, kg = lane >> 4;
    const bool lat = unit < 512;
    int b, h, r0 = 0, rs0 = 0, nlr = 0, half = 0;
    if (lat) { b = unit >> 8; h = (unit >> 4) & 15; r0 = (unit & 15) * 4; rs0 = min(max(r0 - 4, 0), 56); nlr = min(max(r0 - 1, 0), 56) + 8 - rs0; }
    else { const int u = unit - 512; b = u >> 5; h = (u >> 1) & 15; half = u & 1; }
    const bf16* P = c.P();
    LAS float* RPB = (LAS float*)(L + O_RPB);
    const int g = w & 3;
    int r = lat ? r0 + (w >> 2) : 0;
    int qrow0 = lat ? b * SEQ + r * 64 + 16 * g : ML + b * CTX + half * 128 + w * 16;
    bf16x8 qf0, qf1;
    { const bf16* qp = P + (size_t)(qrow0 + ql) * NP + PC_NAQ + h * 64 + kg * 8; qf0 = *(const bf16x8*)qp; qf1 = *(const bf16x8*)(qp + 32); }
    { const int npl = nlr * 32, npairs = npl + 128;
        u4 va[8], vb[8], kc[4];
#pragma unroll
        for (int it = 0; it < 8; ++it) { const int id = tid + NTHREADS * it, dc = id & 7, pi = id >> 3;
            if (pi < npairs) { const int row = pi < npl ? b * SEQ + rs0 * 64 + 2 * pi : ML + b * CTX + 2 * (pi - npl);
                const bf16* vp = P + (size_t)row * NP + PC_NAV + h * 64 + dc * 8; va[it] = *(const u4*)vp; vb[it] = *(const u4*)(vp + NP); } }
#pragma unroll
        for (int it = 0; it < 4; ++it) { const int id = tid + NTHREADS * it; kc[it] = *(const u4*)(P + (size_t)(ML + b * CTX + (id >> 3)) * NP + PC_NAK + h * 64 + (id & 7) * 8); }
#pragma unroll
        for (int it = 0; it < 8; ++it) { const int id = tid + NTHREADS * it, dc = id & 7, pi = id >> 3;
            if (pi < npairs) { const int col = pi < npl ? 2 * pi : CTXC + 2 * (pi - npl); const u4 a = va[it], bb = vb[it];
                LAS unsigned char* dst = L + O_VT + (dc * 8) * VST + col * 2;
                *(LAS unsigned*)(dst + 0 * VST) = (a.x & 0xffffu) | (bb.x << 16); *(LAS unsigned*)(dst + 1 * VST) = (a.x >> 16) | (bb.x & 0xffff0000u);
                *(LAS unsigned*)(dst + 2 * VST) = (a.y & 0xffffu) | (bb.y << 16); *(LAS unsigned*)(dst + 3 * VST) = (a.y >> 16) | (bb.y & 0xffff0000u);
                *(LAS unsigned*)(dst + 4 * VST) = (a.z & 0xffffu) | (bb.z << 16); *(LAS unsigned*)(dst + 5 * VST) = (a.z >> 16) | (bb.z & 0xffff0000u);
                *(LAS unsigned*)(dst + 6 * VST) = (a.w & 0xffffu) | (bb.w << 16); *(LAS unsigned*)(dst + 7 * VST) = (a.w >> 16) | (bb.w & 0xffff0000u); } }
#pragma unroll
        for (int it = 0; it < 4; ++it) { const int id = tid + NTHREADS * it; *(LAS u4*)(L + O_KC + (id >> 3) * KST + (id & 7) * 16) = kc[it]; }
        if (lat) for (int i = tid; i < 465; i += NTHREADS) RPB[i] = c.na_rpb()[(size_t)(l * 16 + h) * 465 + i] * 1.44269504f; }
    __syncthreads();
#define NA_LOADK(CH, RS) { _Pragma("unroll") for (int tl = 0; tl < 8; ++tl) { const int krow = b * SEQ + ((RS) + 4 * (CH) + (tl >> 1)) * 64 + c0 + 16 * (tl & 1); \
        const unsigned char* kb = (const unsigned char*)(P + (size_t)krow * NP + PC_NAK + h * 64);     \
        kf[tl][0] = *(const bf16x8*)(kb + loff); kf[tl][1] = *(const bf16x8*)(kb + loff + 64); } }
#define NA_QK_G() { _Pragma("unroll") for (int tl = 0; tl < 8; ++tl) { f32x4 acc = {0.f, 0.f, 0.f, 0.f}; acc = MFMA16(kf[tl][0], qf0, acc); acc = MFMA16(kf[tl][1], qf1, acc); S[tl] = acc; } }
#define NA_QK_L(CH) { _Pragma("unroll") for (int hb = 0; hb < 4; ++hb) { bf16x8 kl[2][2]; \
        __builtin_amdgcn_sched_barrier(0); \
        _Pragma("unroll") for (int t4 = 0; t4 < 2; ++t4) { const LAS unsigned char* kp = L + O_KC + (((CH) - 2) * 128 + (hb * 2 + t4) * 16 + ql) * KST + kg * 16; \
            kl[t4][0] = *(const LAS bf16x8*)kp; kl[t4][1] = *(const LAS bf16x8*)(kp + 64); } \
        __builtin_amdgcn_sched_barrier(0); \
        _Pragma("unroll") for (int t4 = 0; t4 < 2; ++t4) { f32x4 acc = {0.f, 0.f, 0.f, 0.f}; acc = MFMA16(kl[t4][0], qf0, acc); acc = MFMA16(kl[t4][1], qf1, acc); S[hb * 2 + t4] = acc; } } }
#define NA_CHUNK(CH, AFTER_QK) { f32x4 S[8]; \
        if ((CH) < 2) NA_QK_G() else NA_QK_L(CH) \
        __builtin_amdgcn_sched_barrier(0); \
        AFTER_QK \
        __builtin_amdgcn_sched_barrier(0); \
        float cm = -INFINITY; \
        _Pragma("unroll") for (int tl = 0; tl < 8; ++tl) _Pragma("unroll") for (int jj = 0; jj < 4; ++jj) { float sv; \
            if ((CH) < 2) { const float bv = rpl[(4 * (CH) + (tl >> 1)) * 31 + 16 * (tl & 1) + jj]; sv = __builtin_fmaf(S[tl][jj], 0.18033688f, vld[(tl & 1) * 4 + jj] ? bv : -INFINITY); } \
            else sv = S[tl][jj] * 0.18033688f; \
            S[tl][jj] = sv; cm = fmaxf(cm, sv); } \
        cm = fmaxf(cm, __shfl_xor(cm, 16)); cm = fmaxf(cm, __shfl_xor(cm, 32)); \
        const float mn = fmaxf(m, cm), alpha = __builtin_amdgcn_exp2f(m - mn); m = mn; \
        lsum *= alpha; \
        _Pragma("unroll") for (int dt = 0; dt < 4; ++dt) O[dt] = O[dt] * alpha; \
        bf16x8 pfr[4]; \
        _Pragma("unroll") for (int s4 = 0; s4 < 4; ++s4) { float p[8]; \
            _Pragma("unroll") for (int jj = 0; jj < 4; ++jj) { p[jj] = __builtin_amdgcn_exp2f(S[2 * s4][jj] - m); p[4 + jj] = __builtin_amdgcn_exp2f(S[2 * s4 + 1][jj] - m); lsum += p[jj] + p[4 + jj]; } \
            u4 pw; pw.x = pk2(p[0], p[1]); pw.y = pk2(p[2], p[3]); pw.z = pk2(p[4], p[5]); pw.w = pk2(p[6], p[7]); \
            pfr[s4] = __builtin_bit_cast(bf16x8, pw); } \
        _Pragma("unroll") for (int sh = 0; sh < 2; ++sh) { bf16x8 vfr[2][4]; \
            __builtin_amdgcn_sched_barrier(0); \
            _Pragma("unroll") for (int s2 = 0; s2 < 2; ++s2) { const int s4 = 2 * sh + s2; \
                const int colA = ((CH) < 2) ? (rs - rs0 + 4 * (CH) + s4) * 64 + c0 + 4 * kg : CTXC + ((CH) - 2) * 128 + 32 * s4 + 4 * kg; \
                _Pragma("unroll") for (int dt = 0; dt < 4; ++dt) { const LAS unsigned char* vp = L + O_VT + (dt * 16 + ql) * VST + colA * 2; \
                    const u2 va = *(const LAS u2*)vp, vb = *(const LAS u2*)(vp + 32); \
                    u4 vw; vw.x = va.x; vw.y = va.y; vw.z = vb.x; vw.w = vb.y; vfr[s2][dt] = __builtin_bit_cast(bf16x8, vw); } } \
            __builtin_amdgcn_sched_barrier(0); \
            _Pragma("unroll") for (int s2 = 0; s2 < 2; ++s2) _Pragma("unroll") for (int dt = 0; dt < 4; ++dt) O[dt] = MFMA16(vfr[s2][dt], pfr[2 * sh + s2], O[dt]); } \
        __builtin_amdgcn_sched_barrier(0); }
#define NA_FINISH() { lsum += __shfl_xor(lsum, 16); lsum += __shfl_xor(lsum, 32); const float inv = 1.0f / lsum; \
        bf16* op = c.CAT() + (size_t)(qrow0 + ql) * D + h * 64 + 4 * kg; \
        _Pragma("unroll") for (int dt = 0; dt < 4; ++dt) { u2 o; o.x = pk2(O[dt][0] * inv, O[dt][1] * inv); o.y = pk2(O[dt][2] * inv, O[dt][3] * inv); *(u2*)(op + dt * 16) = o; } }
    if (lat) {
        const int c0 = min(max(16 * g - 8, 0), 32), cq = 16 * g + ql, cs = min(max(cq - 8, 0), 48);
        bool vld[8];
#pragma unroll
        for (int i = 0; i < 8; ++i) vld[i] = (unsigned)(c0 + 16 * (i >> 2) + 4 * kg + (i & 3) - cs) < 16u;
        bf16x8 kf[8][2];
        int rs = min(max(r - 4, 0), 56);
        const unsigned loff = (unsigned)(ql * NP + kg * 8) * 2u;
        NA_LOADK(0, rs)
#define NA_TASK(FIRST) { \
            const LAS float* rpl = RPB + ((rs - r + 7) * 31 + (c0 + 4 * kg - cq + 15)); \
            const int rsn = min(max(r - 2, 0), 56); \
            float m = -INFINITY, lsum = 0.f; \
            f32x4 O[4]; \
            _Pragma("unroll") for (int dt = 0; dt < 4; ++dt) O[dt] = (f32x4){0.f, 0.f, 0.f, 0.f}; \
            NA_CHUNK(2, ) \
            NA_CHUNK(0, NA_LOADK(1, rs)) \
            NA_CHUNK(3, ) \
            NA_CHUNK(1, if (FIRST) { NA_LOADK(0, rsn) const bf16* qp = P + (size_t)(qrow0 + 128 + ql) * NP + PC_NAQ + h * 64 + kg * 8; qf0 = *(const bf16x8*)qp; qf1 = *(const bf16x8*)(qp + 32); }) \
            NA_FINISH() \
            r += 2; rs = rsn; qrow0 += 128; }
        NA_TASK(1)
        NA_TASK(0)
#undef NA_TASK
    } else {
        const int rs = 0, c0 = 0; const LAS float* rpl = RPB; const bool vld[8] = {true, true, true, true, true, true, true, true};
        float m = -INFINITY, lsum = 0.f;
        f32x4 O[4];
#pragma unroll
        for (int dt = 0; dt < 4; ++dt) O[dt] = (f32x4){0.f, 0.f, 0.f, 0.f};
        bf16x8 kf[8][2];
        NA_CHUNK(2, ) NA_CHUNK(3, )
        NA_FINISH()
    }
#undef NA_LOADK
#undef NA_QK_G
#undef NA_QK_L
#undef NA_CHUNK
#undef NA_FINISH
}
#ifndef TPROBE
#define TPROBE -1
#endif
#define TP_MARK(k) do { if (TPROBE >= 0 && l == 0 && c.tid == 0) atomicMax(c.ctl() + CW_TP + 64 * (k), (unsigned)(wall_clock64() - tp0)); } while (0)
__device__ __forceinline__ void ph_scan_na3(const Ctx& c, int l) {
    const unsigned long long tp0 = TPROBE >= 0 ? wall_clock64() : 0ull;
    for (int bt = blockIdx.x; bt < 96; bt += gridDim.x) { const int kind = bt >= 32, bq = kind ? bt - 32 : bt;
        const int dir = kind ? (bq >> 5) & 1 : (bq >> 4) & 1, b = kind ? (bq >> 4) & 1 : (bq >> 3) & 1, h = kind ? (bq >> 2) & 3 : (bq >> 1) & 3, eh = kind ? bq & 3 : bq & 1;
        if (kind == 0) { gla_scan3(c, b, h, dir, eh); __syncthreads(); TP_MARK(0); }
        else { gdn_scan2<0>(c, b, h, dir, eh); __syncthreads(); TP_MARK(1); } }
    const int nunit = 512 + (l == 0 ? 64 : 0);
    int* sh = (int*)(c.lds + MISC_OFF + 64);
    unsigned* qhead = c.ctl() + CW_NAQ + 64 * (l + 2 * c.rep);
    int nxt = 0; if (c.tid == 0) nxt = (int)atomicAdd(qhead, 1u);
    for (;;) {
        __syncthreads();
        if (c.tid == 0) *sh = nxt;
        __syncthreads();
        const int u = __builtin_amdgcn_readfirstlane(*sh);
        if (u >= nunit) break;
        if (c.tid == 0) nxt = (int)atomicAdd(qhead, 1u);
        if (TPROBE == 3 && l == 0 && u == 0) { const unsigned long long t1 = wall_clock64(); na_unit(c, l, u); __syncthreads(); if (c.tid == 0) atomicMax(c.ctl() + CW_TP + 64 * 3, (unsigned)(wall_clock64() - t1)); }
#ifndef NO_NA
        else na_unit(c, l, u);
#endif
    }
    TP_MARK(2);
}
constexpr int NPH_LAYER = 12, NPHASES = 2 + 2 * NPH_LAYER;
__global__ void __launch_bounds__(NTHREADS, 2) fwd(Params p) {
    extern __shared__ __attribute__((aligned(16))) unsigned char lds[];
    Ctx cb;
    cb.lds = lds; cb.tid = threadIdx.x; cb.lane = cb.tid & 63; cb.wave = __builtin_amdgcn_readfirstlane(cb.tid >> 6);
    cb.gw = blockIdx.x * NWAVES + cb.wave; cb.ngw = gridDim.x * NWAVES;
    cb.kp = (KParams)__builtin_amdgcn_kernarg_segment_ptr(); cb.ws = p.ws;
    LAS unsigned char* ldsl = (LAS unsigned char*)lds;
    volatile LAS unsigned* MISC = (volatile LAS unsigned*)(ldsl + MISC_OFF);
    if (cb.tid < 64) MISC[cb.tid] = 0u;
    __syncthreads();
    const int lo = p.ph_lo, hi = p.ph_hi;
    XcdBarrier bar; bar.bar = cb.ctl() + CW_BAR; bar.x = 0; bar.st = MISC;
    if (hi - lo > 1) bar = xcd_barrier_post(cb.ctl() + CW_BAR, MISC);
#ifndef REPMASK
#define REPMASK 0
#endif
#ifndef PHMASK
#define PHMASK 0xffff
#endif
#define RUN(ty, k, ...) do { if constexpr (((PHMASK) >> (ty)) & 1) { if (lo <= (k) && (k) < hi) for (int rep_ = 0; rep_ < ((((REPMASK) >> (ty)) & 1) ? 2 : 1); ++rep_) { Ctx c = cb; c.rep = rep_; asm volatile("" : "+s"(c.ws)); asm volatile("" : "+s"(c.kp)); asm volatile("" : "+v"(c.tid)); c.lane = c.tid & 63; c.wave = __builtin_amdgcn_readfirstlane(c.tid >> 6); c.gw = blockIdx.x * NWAVES + c.wave; __VA_ARGS__; if ((k) + 1 < hi || rep_ == 0 && ((((REPMASK) >> (ty)) & 1))) xcd_barrier(bar); } } } while (0)
    RUN(0, 0, ph_prologue(c));
    for (int l = 0; l < 2; ++l) {
        const int pb = 1 + NPH_LAYER * l;
        RUN(1, pb + 0, ph_norm1(c, l));
        RUN(2, pb + 1, { pg8::Gemm g{c.NX(), c.WIN() + (size_t)l * NP * D, MROWS, NP, D}; pg8::StaticOrder S; S.init(MROWS, NP, (int)gridDim.x, (int)blockIdx.x); EpiP E{c.P(), c.PS()};
                      pg8::gemm_phase<EpiP, pg8::StaticOrder>(ldsl, g, S, E, nullptr); });
        RUN(3, pb + 2, ph_prep(c, l));
        RUN(4, pb + 3, ph_gdn_chunk(c, l));
        RUN(5, pb + 4, ph_scan_na3(c, l));
        RUN(6, pb + 5, ph_combine2(c, l));
        RUN(7, pb + 6, { pg8::Gemm g{c.CAT(), c.WOUT() + (size_t)l * D * D, MROWS, D, D}; pg8::StaticOrder S; S.init(l == 0 ? MROWS : ML, D, (int)gridDim.x, (int)blockIdx.x); EpiResid E{c.x(), c.ctxin(), c.MOD(), c.HX(), l};
                      pg8::gemm_phase<EpiResid, pg8::StaticOrder>(ldsl, g, S, E, nullptr); });
        RUN(8, pb + 7, ph_norm2_router(c, l));
        RUN(9, pb + 8, ph_topk(c, l));
        RUN(10, pb + 9, ph_gather(c, l));
        RUN(11, pb + 10, { MoeOrder S{l == 0 ? 5 : 4, 16, (int)gridDim.x, (int)blockIdx.x};
                      if (!(((F8MASK) >> l) & 1)) { pg8::Gemm g{c.AMOE(), c.WGU() + (size_t)l * NE * 4096 * D, NE * ESLOT, NE * 4096, D}; EpiSwiglu E{c.HID()};
                          pg8::gemm_phase<EpiSwiglu, MoeOrder>(ldsl, g, S, E, nullptr); }
                      else { pg8::Gemm g{c.AMOE(), c.WGU() + (size_t)l * NE * 4096 * D, NE * ESLOT, NE * 4096, D / 2}; EpiSwiglu8 E{(unsigned char*)c.HID()};
                          pg8::gemm_phase<EpiSwiglu8, MoeOrder, false, true>(ldsl, g, S, E, nullptr); } });
        RUN(12, pb + 11, { MoeOrder S{l == 0 ? 5 : 4, 8, (int)gridDim.x, (int)blockIdx.x}; EpiY E{c.Y()};
                      if (!(((F8MASK) >> l) & 1)) { pg8::Gemm g{c.HID(), c.WDN() + (size_t)l * NE * D * FF, NE * ESLOT, NE * D, FF};
                          pg8::gemm_phase<EpiY, MoeOrder>(ldsl, g, S, E, nullptr); }
                      else { pg8::Gemm g{c.HID(), c.WDN() + (size_t)l * NE * D * FF, NE * ESLOT, NE * D, FF / 2};
                          pg8::gemm_phase<EpiY, MoeOrder, false, true>(ldsl, g, S, E, nullptr); } });
    }
    RUN(13, NPHASES - 1, ph_final(c));
#undef RUN
}

extern "C" void kernel_launch(void* const* d_in, const int* in_sizes, int n_in, void* d_out, int out_size, void* d_ws, size_t ws_size, hipStream_t stream) {
    static int grid = 0;
    if (grid == 0) {
        if (n_in != 23 || ws_size < WS_END) { fprintf(stderr, "kernel_launch: need 23 inputs and %zu bytes of workspace (got %d, %zu)\n", (size_t)WS_END, n_in, ws_size); grid = -1; return; }
        int dev = 0, cus = 0, per_cu = 0;
        if (hipGetDevice(&dev) != hipSuccess || hipDeviceGetAttribute(&cus, hipDeviceAttributeMultiprocessorCount, dev) != hipSuccess) { grid = -1; return; }
        if (hipFuncSetAttribute((const void*)fwd, hipFuncAttributeMaxDynamicSharedMemorySize, LDS_BYTES) != hipSuccess) { fprintf(stderr, "kernel_launch: hipFuncSetAttribute failed\n"); grid = -1; return; }
        if (hipOccupancyMaxActiveBlocksPerMultiprocessor(&per_cu, (const void*)fwd, NTHREADS, LDS_BYTES) != hipSuccess || per_cu < 1) { fprintf(stderr, "kernel_launch: occupancy query says %d\n", per_cu); per_cu = 1; }
        grid = cus;
    }
    if (grid <= 0) return;
    hipMemsetAsync((char*)d_ws + WS_CTL, 0, CTL_BYTES, stream);
    Params p; memset(&p, 0, sizeof(p));
    for (int i = 0; i < 23; ++i) p.in[i] = (GASP const float*)d_in[i];
    p.out = (GASP float*)d_out; p.ws = (GASP unsigned char*)d_ws;
#if ONE_LAUNCH
    p.ph_lo = 0; p.ph_hi = NPHASES;
    hipLaunchKernelGGL(fwd, dim3(grid), dim3(NTHREADS), LDS_BYTES, stream, p);
#else
    for (int k = 0; k < NPHASES; ++k) { p.ph_lo = k; p.ph_hi = k + 1; hipLaunchKernelGGL(fwd, dim3(grid), dim3(NTHREADS), LDS_BYTES, stream, p); }
#endif
}
```

```cpp
#include <hip/hip_runtime.h>
#include <cstdio>
#include <cstdint>
#include <cstring>

#ifndef F8MASK
#define F8MASK 3
#endif
#ifndef L2PROBE
#define L2PROBE 0
#endif
#ifndef SUBREP
#define SUBREP 0
#endif
#ifndef ONE_LAUNCH
#define ONE_LAUNCH 1
#endif

#define LAS __attribute__((address_space(3)))
typedef unsigned short bf16;
typedef float f4 __attribute__((ext_vector_type(4)));
typedef unsigned u4 __attribute__((ext_vector_type(4)));
typedef unsigned u2 __attribute__((ext_vector_type(2)));

constexpr int D = 2048, NB = 2, SEQ = 4096, CTX = 256;
constexpr int ML = NB * SEQ, MC = NB * CTX, MROWS = ML + MC;
constexpr int INW = 6704, NP = 6912;
constexpr int NE = 16, FF = 2048, ESLOT = 1280;
constexpr int MODW = 6 * D;
constexpr int PC_NAQ = 0, PC_NAK = 1024, PC_NAV = 2048, PC_GLQ = 3072, PC_GLK = 3328, PC_GLV = 3584, PC_GLG = 4096, PC_GDQ = 4608, PC_GDZ = 6144, PC_SMALL = 6656;
constexpr int NTHREADS = 512, NWAVES = 8;
constexpr int LDS_BYTES = 163840, MISC_OFF = LDS_BYTES - 256;

constexpr size_t al256(size_t x) { return (x + 255) & ~(size_t)255; }
constexpr size_t WS_CTL = 0, CTL_BYTES = 1u << 20;
constexpr size_t WS_MOD = WS_CTL + CTL_BYTES;
constexpr size_t WS_ROPE = al256(WS_MOD + (size_t)2 * 3 * MODW * 4);
constexpr size_t WS_WIN = al256(WS_ROPE + 64 * 16 * 2 * 4);
constexpr size_t WS_WOUT = al256(WS_WIN + (size_t)2 * NP * D * 2);
constexpr size_t WS_WGU = al256(WS_WOUT + (size_t)2 * D * D * 2);
constexpr size_t WS_WDN = al256(WS_WGU + (size_t)2 * NE * 2 * FF * D * 2);
constexpr size_t WS_HX = al256(WS_WDN + (size_t)2 * NE * D * FF * 2);
constexpr size_t WS_NX = al256(WS_HX + (size_t)MROWS * D * 4);
constexpr size_t WS_P = al256(WS_NX + (size_t)MROWS * D * 2);
constexpr size_t WS_PS = al256(WS_P + (size_t)MROWS * NP * 2);
constexpr size_t WS_GQKV = al256(WS_PS + (size_t)MROWS * 64 * 4);
constexpr size_t WS_GGB = al256(WS_GQKV + (size_t)MROWS * 1536 * 4);
constexpr size_t WS_LQ = al256(WS_GGB + (size_t)MROWS * 16 * 4);
constexpr size_t WS_LK = al256(WS_LQ + (size_t)MROWS * 256 * 4);
constexpr size_t WS_LA = al256(WS_LK + (size_t)MROWS * 256 * 4);
constexpr size_t WS_OGLA = al256(WS_LA + (size_t)2 * MROWS * 256 * 4);
constexpr size_t WS_OGDN = al256(WS_OGLA + (size_t)2 * MROWS * 512 * 4);
constexpr size_t WS_CAT = al256(WS_OGDN + (size_t)2 * MROWS * 512 * 4);
constexpr size_t WS_AFF = al256(WS_CAT + (size_t)MROWS * D * 2);
constexpr size_t WS_IDX = al256(WS_AFF + (size_t)MROWS * 16 * 4);
constexpr size_t WS_GATE = al256(WS_IDX + (size_t)NE * ESLOT * 4);
constexpr size_t WS_AMOE = al256(WS_GATE + (size_t)NE * ESLOT * 4);
constexpr size_t WS_HID = al256(WS_AMOE + (size_t)NE * ESLOT * D * 2);
constexpr int UDS = 69;
constexpr int NUD = 2 * 4 * UDS * 2;
constexpr size_t WS_GDQP = al256(WS_HID + (size_t)NE * ESLOT * FF * 2);
constexpr size_t WS_GDO0 = al256(WS_GDQP + (size_t)NUD * 64 * 128 * 2);
constexpr size_t WS_GDAP = al256(WS_GDO0 + (size_t)NUD * 64 * 128 * 4);
constexpr size_t WS_GDBM = al256(WS_GDAP + (size_t)NUD * 128 * 128 * 2);
constexpr size_t WS_GDGL = al256(WS_GDBM + (size_t)NUD * 128 * 128 * 4);
constexpr size_t WS_GLQT = al256(WS_GDGL + (size_t)NUD * 4);
constexpr size_t WS_GLKT = al256(WS_GLQT + (size_t)NUD * 4096 * 2);
constexpr size_t WS_GLKH = al256(WS_GLKT + (size_t)NUD * 4096 * 2);
constexpr size_t WS_GLVT = al256(WS_GLKH + (size_t)NUD * 4096 * 2);
constexpr size_t WS_GLDEC = al256(WS_GLVT + (size_t)NUD * 8192 * 2);
constexpr size_t WS_GDST = al256(WS_GLDEC + (size_t)NUD * 64 * 4);
constexpr size_t WS_GLST = al256(WS_GDST + (size_t)NUD * 16384 * 2);
constexpr size_t WS_SLOTOF = al256(WS_GLST + (size_t)NUD * 8192 * 2);
constexpr size_t WS_Y = al256(WS_SLOTOF + (size_t)NE * MROWS * 4);
constexpr size_t WS_END = al256(WS_Y + (size_t)NE * ESLOT * D * 2);
constexpr int CW_BAR = 1024;
constexpr int CW_PROQ = 7040;
constexpr int CW_TP = 9216;
constexpr int CW_CHQ = 7680;
constexpr int CW_NAQ = 8192;

__device__ __forceinline__ float bf2f(unsigned b) { return __uint_as_float(b << 16); }
__device__ __forceinline__ unsigned f2bf(float f) { unsigned u = __float_as_uint(f); return (u + 0x7fffu + ((u >> 16) & 1u)) >> 16; }
typedef __bf16 bf2_t __attribute__((ext_vector_type(2)));
typedef float f2_t __attribute__((ext_vector_type(2)));
__device__ __forceinline__ unsigned pk2(float lo, float hi) { const bf2_t r = __builtin_convertvector((f2_t){lo, hi}, bf2_t); return __builtin_bit_cast(unsigned, r); }
__device__ __forceinline__ float wave_sum(float v) {
#pragma unroll
    for (int o = 1; o < 64; o <<= 1) v += __shfl_xor(v, o);
    return v;
}
__device__ __forceinline__ float wave_max(float v) {
#pragma unroll
    for (int o = 1; o < 64; o <<= 1) v = fmaxf(v, __shfl_xor(v, o));
    return v;
}
__device__ __forceinline__ float silu_f(float x) { return x * __builtin_amdgcn_rcpf(1.f + __expf(-x)); }
__device__ __forceinline__ float softplus_f(float x) { return x > 20.f ? x : log1pf(__expf(x)); }
__device__ __forceinline__ float logsigmoid_f(float z) { return fminf(z, 0.f) - __logf(1.f + __expf(-fabsf(z))); }
#define LDS_WAIT() asm volatile("s_waitcnt lgkmcnt(0)" ::: "memory")
#define XB_TMO      128
#define XB_XCNT(j)  (256  + 64 * (j))
#define XB_XSUB(j)  (1280 + 64 * (j))
#define XB_XGEN(j)  (2304 + 64 * (j))
#define XB_TOP      3328
#define XB_TOPGEN   3392
#define XCD_BAR_WORDS 3456
#define XB_SPIN_CAP (1u << 20)

__device__ __forceinline__ unsigned xb_ld(unsigned* p)              { return __hip_atomic_load(p, __ATOMIC_RELAXED, __HIP_MEMORY_SCOPE_AGENT); }
__device__ __forceinline__ unsigned xb_add(unsigned* p, unsigned v) { return __hip_atomic_fetch_add(p, v, __ATOMIC_RELAXED, __HIP_MEMORY_SCOPE_AGENT); }
__device__ __forceinline__ unsigned xb_xcc_id() { return (unsigned)__builtin_amdgcn_s_getreg((3 << 11) | 20) & 0xFu; }
#define XB_SPIN(cond, bar) do { unsigned _sp = 0; while (cond) { __builtin_amdgcn_s_sleep(1); \
    if ((++_sp & 255u) == 0u) { if (xb_ld(&(bar)[XB_TMO])) break; if (_sp > XB_SPIN_CAP) { atomicAdd(&(bar)[XB_TMO], 1u); break; } } } } while (0)

struct XcdBarrier {
    unsigned* bar; unsigned x;
    volatile LAS unsigned* st;
};

__device__ __forceinline__ XcdBarrier xcd_barrier_post(unsigned* bar, volatile LAS unsigned* st) {
    XcdBarrier b; b.bar = bar; b.x = xb_xcc_id(); b.st = st;
    if (threadIdx.x == 0) (void)xb_add(&bar[XB_XCNT(b.x)], 1u);
    return b;
}
__device__ __forceinline__ void xcd_barrier_complete(unsigned* bar, unsigned x, unsigned& nloc, unsigned& nx) {
    const unsigned G = gridDim.x * gridDim.y * gridDim.z;
    unsigned sum, cnt, mine, sp = 0u;
    for (;;) {
        sum = 0u; cnt = 0u; mine = 0u;
#pragma unroll
        for (unsigned j = 0; j < 16; ++j) { const unsigned c = xb_ld(&bar[XB_XCNT(j)]); sum += c; cnt += (c > 0u) ? 1u : 0u; mine = (j == x) ? c : mine; }
        if (sum == G) break;
        __builtin_amdgcn_s_sleep(1);
        if ((++sp & 255u) == 0u) { if (xb_ld(&bar[XB_TMO])) break; if (sp > XB_SPIN_CAP) { atomicAdd(&bar[XB_TMO], 1u); break; } }
    }
    nloc = mine > 0u ? mine : 1u; nx = cnt > 0u ? cnt : 1u;
}

__device__ __forceinline__ void xcd_barrier(const XcdBarrier& b) {
    asm volatile("s_waitcnt vmcnt(0)" ::: "memory");
    __syncthreads();
    if (threadIdx.x == 0) {
        unsigned* bar = b.bar;
        __builtin_amdgcn_s_waitcnt(0);
        unsigned nloc = b.st[0], nx = b.st[1];
        if (nloc == 0u) { xcd_barrier_complete(bar, b.x, nloc, nx); b.st[0] = nloc; b.st[1] = nx; }
        const unsigned old = xb_add(&bar[XB_XSUB(b.x)], 1u);
        const unsigned gen = old / nloc;
        if (old + 1u == (gen + 1u) * nloc) {
            __builtin_amdgcn_fence(__ATOMIC_RELEASE, "agent");
            asm volatile("s_waitcnt vmcnt(0)" ::: "memory");
            const unsigned og = xb_add(&bar[XB_TOP], 1u);
            const unsigned tg = og / nx;
            if (og + 1u == (tg + 1u) * nx) xb_add(&bar[XB_TOPGEN], 1u);
            else XB_SPIN(xb_ld(&bar[XB_TOPGEN]) == tg, bar);
            __builtin_amdgcn_fence(__ATOMIC_ACQUIRE, "agent");
            xb_add(&bar[XB_XGEN(b.x)], 1u);
            asm volatile("s_waitcnt vmcnt(0)" ::: "memory");
        } else {
            XB_SPIN(xb_ld(&bar[XB_XGEN(b.x)]) == gen, bar);
            __builtin_amdgcn_fence(__ATOMIC_ACQUIRE, "agent");
            asm volatile("s_waitcnt vmcnt(0)" ::: "memory");
        }
    }
    __syncthreads();
}

namespace pg8 {
#define PG8_LAS __attribute__((address_space(3)))
typedef unsigned short bf16_t;
typedef short bf16x8 __attribute__((ext_vector_type(8)));
typedef float f32x4 __attribute__((ext_vector_type(4)));
typedef unsigned u32x4 __attribute__((ext_vector_type(4)));
constexpr int BM = 256, BK = 64, HALF = 128, HTB = HALF * BK * 2  , STAGE_BYTES = 8 * HTB, NXCD = 8, WGM = 8;

__host__ __device__ __forceinline__ int lds_byte(int r, int c) { const int st = (r >> 4) * 2 + (c >> 5), rr = r & 15, cc = c & 31, ob = rr * 64 + cc * 2; return st * 1024 + (ob ^ (((ob >> 9) & 1) << 5)); }
__host__ __device__ __forceinline__ void stage_rc(int b, int& R, int& C) { const int st = b / 1024, sb = b % 1024, swz = sb ^ (((sb >> 9) & 1) << 5); R = (st >> 1) * 16 + swz / 64; C = (st & 1) * 32 + (swz % 64) / 2; }
__host__ __device__ __forceinline__ int perm32(int rho) { const int n = rho >> 4, i = rho & 15; return 8 * (i >> 2) + 4 * n + (i & 3); }

struct Unit { int pm, pn; };
struct Gemm { const bf16_t* A; const bf16_t* Bt; int M, N, K; };
struct StaticOrder {
    int nM, nN, nwg, G, c;
    __host__ __device__ void init(int M, int N, int G_, int c_) { nM = M / BM; nN = N / BM; nwg = nM * nN; G = G_; c = c_; }
    __host__ __device__ bool next(int i, Unit& u) const {
        const long L = (long)i * G + c; if (L >= nwg) return false;
        int wgid = (int)L; { const int q = nwg / NXCD, r = nwg % NXCD, xcd = wgid % NXCD, off = wgid / NXCD; wgid = (xcd < r ? xcd * (q + 1) : r * (q + 1) + (xcd - r) * q) + off; }
        const int nig = WGM * nN, gid = wgid / nig, fm = gid * WGM, gsz = (nM - fm) < WGM ? (nM - fm) : WGM;
        u.pm = fm + ((wgid % nig) % gsz); u.pn = (wgid % nig) / gsz; return true;
    }
    __device__ __forceinline__ void a_ready(const Unit&) const {}
    __device__ __forceinline__ void done(const Unit&) const {}
};
__device__ __forceinline__ unsigned cvt_pk_bf16(float lo, float hi) { unsigned r; asm volatile("v_cvt_pk_bf16_f32 %0, %1, %2" : "=v"(r) : "v"(lo), "v"(hi)); return r; }

typedef int v8i32 __attribute__((ext_vector_type(8)));
typedef int v4i32 __attribute__((ext_vector_type(4)));
constexpr int F8_WSCALE_LOG2 = 6;
template <class Epi, class Sched, bool STAMP = false, bool F8 = false>
__device__ __forceinline__ void gemm_phase(PG8_LAS unsigned char* lds, const Gemm g, const Sched& S, const Epi& E, unsigned long long* stamps) {
    int tid_ = threadIdx.x; asm volatile("" : "+v"(tid_));
    const int tid = tid_, wid = __builtin_amdgcn_readfirstlane(tid >> 6), lane = tid & 63, wr = wid >> 2, wc = wid & 3, fr = lane & 15, fq = lane >> 4;
    const int K = g.K, nt = K / BK;
    const int f8_sw = 127 - F8_WSCALE_LOG2, f8_s1 = 127;
    int ts_lo = 0, ts_hi = 0, nts = 0; const unsigned long long rt_entry = STAMP ? (unsigned long long)wall_clock64() : 0ull;
#define PG8_STAMP() do { if (STAMP && wid == 0 && nts < 64) { const unsigned long long _c = (unsigned long long)clock64(); \
        ts_lo = (lane == nts) ? (int)(unsigned)_c : ts_lo; ts_hi = (lane == nts) ? (int)(unsigned)(_c >> 32) : ts_hi; ++nts; } } while (0)
    PG8_STAMP();
    unsigned voffA[2], voffB[2];
#pragma unroll
    for (int i = 0; i < 2; ++i) { int R, C; stage_rc(tid * 16 + i * 8192, R, C); const int Rb = Epi::PERM ? ((R & ~31) + perm32(R & 31)) : R;
        voffA[i] = (unsigned)(R * K + C) * 2u; voffB[i] = (unsigned)(Rb * K + C) * 2u; }
    const size_t kstep = (size_t)(BK * 2);
    const size_t hstep = (size_t)HALF * K * 2;
    const size_t tstep = 2 * hstep;
    const unsigned ldsw = (unsigned)wid * 1024u;
    const int aoff = lds_byte(wr * 64 + fr, fq * 8), boff = lds_byte(wc * 32 + fr, fq * 8);
#define PG8_SA(b, h) (((b) * 2 + (h)) * HTB)
#define PG8_SB(b, h) ((4 + (b) * 2 + (h)) * HTB)
#define PG8_STAGE(bufoff, gbase, voff) do { _Pragma("unroll") for (int _i = 0; _i < 2; ++_i) \
        __builtin_amdgcn_global_load_lds((const unsigned*)((const char*)(gbase) + (voff)[_i]), (PG8_LAS unsigned*)(lds + (bufoff) + ldsw + _i * 8192), 16, 0, 0); } while (0)
#define PG8_LDA(dst, b, h) do { _Pragma("unroll") for (int m = 0; m < 4; ++m) _Pragma("unroll") for (int k = 0; k < 2; ++k) dst[m][k] = *(const PG8_LAS bf16x8*)(lds + PG8_SA(b, h) + aoff + m * 2048 + k * 1024); } while (0)
#define PG8_LDB(dst, b, h) do { _Pragma("unroll") for (int n = 0; n < 2; ++n) _Pragma("unroll") for (int k = 0; k < 2; ++k) dst[n][k] = *(const PG8_LAS bf16x8*)(lds + PG8_SB(b, h) + boff + n * 2048 + k * 1024); } while (0)
#define PG8_MMA(ai, bj, At, Bt) do { __builtin_amdgcn_s_setprio(1); \
        if constexpr (!F8) { _Pragma("unroll") for (int m = 0; m < 4; ++m) _Pragma("unroll") for (int n = 0; n < 2; ++n) _Pragma("unroll") for (int k = 0; k < 2; ++k) \
            acc[ai][bj][m][n] = __builtin_amdgcn_mfma_f32_16x16x32_bf16(Bt[n][k], At[m][k], acc[ai][bj][m][n], 0, 0, 0); } \
        else { _Pragma("unroll") for (int m = 0; m < 4; ++m) _Pragma("unroll") for (int n = 0; n < 2; ++n) \
            asm volatile("v_mfma_scale_f32_16x16x128_f8f6f4 %0, %1, %2, %0, %3, %4 op_sel_hi:[0,0,0]" : "+v"(acc[ai][bj][m][n]) \
                : "v"(__builtin_shufflevector(__builtin_bit_cast(v4i32, Bt[n][0]), __builtin_bit_cast(v4i32, Bt[n][1]), 0, 1, 2, 3, 4, 5, 6, 7)), \
                  "v"(__builtin_shufflevector(__builtin_bit_cast(v4i32, At[m][0]), __builtin_bit_cast(v4i32, At[m][1]), 0, 1, 2, 3, 4, 5, 6, 7)), "v"(f8_sw), "v"(f8_s1)); } \
        __builtin_amdgcn_s_setprio(0); } while (0)
#define PG8_WAIT_V(n) asm volatile("s_waitcnt vmcnt(" #n ")" ::: "memory")
#define PG8_WAIT_L(n) asm volatile("s_waitcnt lgkmcnt(" #n ")" ::: "memory")
#define PG8_BAR __builtin_amdgcn_s_barrier()
#define PG8_SCHED __builtin_amdgcn_sched_barrier(0)
    Unit cur, nxt; int ui = 0;
    if (!S.next(0, cur)) return;
    f32x4 acc[2][2][4][2];
#pragma unroll
    for (int a = 0; a < 2; ++a)
#pragma unroll
        for (int b = 0; b < 2; ++b)
#pragma unroll
            for (int m = 0; m < 4; ++m)
#pragma unroll
                for (int n = 0; n < 2; ++n) acc[a][b][m][n] = (f32x4){0.f, 0.f, 0.f, 0.f};
    bf16x8 At[4][2], B0[2][2], B1[2][2];
    const char* cA = (const char*)g.A + (size_t)cur.pm * tstep; const char* cB = (const char*)g.Bt + (size_t)cur.pn * tstep;
    S.a_ready(cur);
    PG8_STAGE(PG8_SB(0, 0), cB, voffB); PG8_STAGE(PG8_SA(0, 0), cA, voffA); PG8_STAGE(PG8_SB(0, 1), cB + hstep, voffB); PG8_STAGE(PG8_SA(0, 1), cA + hstep, voffA);
    if (wr == 1) PG8_BAR;
    PG8_WAIT_V(4); PG8_BAR;
    PG8_STAGE(PG8_SB(1, 0), cB + kstep, voffB); PG8_STAGE(PG8_SA(1, 0), cA + kstep, voffA); PG8_STAGE(PG8_SB(1, 1), cB + hstep + kstep, voffB);
    PG8_WAIT_V(6); PG8_BAR;
    PG8_STAMP();
    for (;;) {
        const bool has_next = S.next(ui + 1, nxt);
        const char* nA = has_next ? (const char*)g.A + (size_t)nxt.pm * tstep : cA; const char* nB = has_next ? (const char*)g.Bt + (size_t)nxt.pn * tstep : cB;
        for (int t = 0; t < nt; t += 2) {
            const bool last = (t == nt - 2);
            const char* a1 = cA + (size_t)(t + 1) * kstep;
            const char* a2 = last ? nA : cA + (size_t)(t + 2) * kstep; const char* b2 = last ? nB : cB + (size_t)(t + 2) * kstep;
            const char* a3 = a2 + kstep; const char* b3 = b2 + kstep;
            if (last && has_next) S.a_ready(nxt);
            PG8_LDB(B0, 0, 0); PG8_SCHED; PG8_LDA(At, 0, 0); PG8_STAGE(PG8_SA(1, 1), a1 + hstep, voffA);
            PG8_WAIT_L(8); PG8_BAR; PG8_WAIT_L(0); PG8_MMA(0, 0, At, B0); PG8_BAR; PG8_SCHED;
            PG8_LDB(B1, 0, 1); PG8_STAGE(PG8_SB(0, 0), b2, voffB);
            PG8_BAR; PG8_WAIT_L(0); PG8_MMA(0, 1, At, B1); PG8_BAR;
            PG8_LDA(At, 0, 1); PG8_STAGE(PG8_SA(0, 0), a2, voffA);
            PG8_BAR; PG8_WAIT_L(0); PG8_MMA(1, 0, At, B0); PG8_BAR; PG8_SCHED;
            PG8_STAGE(PG8_SB(0, 1), b2 + hstep, voffB);
            PG8_WAIT_V(6); PG8_BAR; PG8_MMA(1, 1, At, B1); PG8_BAR;
            PG8_LDB(B0, 1, 0); PG8_SCHED; PG8_LDA(At, 1, 0); PG8_STAGE(PG8_SA(0, 1), a2 + hstep, voffA);
            PG8_WAIT_L(8); PG8_BAR; PG8_WAIT_L(0); PG8_MMA(0, 0, At, B0); PG8_BAR; PG8_SCHED;
            PG8_LDB(B1, 1, 1); PG8_STAGE(PG8_SB(1, 0), b3, voffB);
            PG8_BAR; PG8_WAIT_L(0); PG8_MMA(0, 1, At, B1); PG8_BAR;
            PG8_LDA(At, 1, 1); PG8_STAGE(PG8_SA(1, 0), a3, voffA);
            PG8_BAR; PG8_WAIT_L(0); PG8_MMA(1, 0, At, B0); PG8_BAR; PG8_SCHED;
            PG8_STAGE(PG8_SB(1, 1), b3 + hstep, voffB);
            PG8_WAIT_V(6); PG8_BAR; PG8_MMA(1, 1, At, B1); PG8_BAR;
        }
        PG8_STAMP();
        if constexpr (F8) asm volatile("s_nop 15\n\ts_nop 15" ::: "memory");
        if constexpr (!Epi::AFTER_DRAIN) { E(acc, cur, wr, wc, fr, fq); S.done(cur); }
        PG8_STAMP();
        if (!has_next) break;
#pragma unroll
        for (int a = 0; a < 2; ++a)
#pragma unroll
            for (int b = 0; b < 2; ++b)
#pragma unroll
                for (int m = 0; m < 4; ++m)
#pragma unroll
                    for (int n = 0; n < 2; ++n) acc[a][b][m][n] = (f32x4){0.f, 0.f, 0.f, 0.f};
        cur = nxt; cA = nA; cB = nB; ++ui;
    }
    PG8_WAIT_V(0);
    if (wr == 0) PG8_BAR;
    PG8_BAR;
    if constexpr (Epi::AFTER_DRAIN) { E.fused(acc, cur, wr, wc, fr, fq, lds, wid, lane); S.done(cur); }
    PG8_STAMP();
    if (STAMP && wid == 0) { stamps[lane] = lane < nts ? (((unsigned long long)(unsigned)ts_hi << 32) | (unsigned)ts_lo) : 0ull;
        if (lane == 62) stamps[62] = rt_entry; if (lane == 63) stamps[63] = (unsigned long long)wall_clock64(); }
#undef PG8_STAMP
#undef PG8_SA
#undef PG8_SB
#undef PG8_STAGE
#undef PG8_LDA
#undef PG8_LDB
#undef PG8_MMA
#undef PG8_WAIT_V
#undef PG8_WAIT_L
#undef PG8_BAR
#undef PG8_SCHED
}
}

#include <cstdio>
#include <ctime>

#define GASP __attribute__((address_space(1)))
struct Params { GASP const float* in[23]; GASP float* out; GASP unsigned char* ws; int ph_lo, ph_hi; };
typedef const __attribute__((address_space(4))) Params* KParams;
struct Ctx {
    unsigned char* lds; GASP unsigned char* ws; KParams kp;
    int tid, lane, wave, gw, ngw, rep;
    __device__ __forceinline__ const float* x() const { return (const float*)kp->in[0]; }
    __device__ __forceinline__ const float* cvec() const { return (const float*)kp->in[1]; }
    __device__ __forceinline__ const float* ctxin() const { return (const float*)kp->in[2]; }
    __device__ __forceinline__ const float* c_ctx() const { return (const float*)kp->in[3]; }
    __device__ __forceinline__ const float* w_ada() const { return (const float*)kp->in[4]; }
    __device__ __forceinline__ const float* b_ada() const { return (const float*)kp->in[5]; }
    __device__ __forceinline__ const float* norm_mix_w() const { return (const float*)kp->in[6]; }
    __device__ __forceinline__ const float* norm_ffn_w() const { return (const float*)kp->in[7]; }
    __device__ __forceinline__ const float* w_in() const { return (const float*)kp->in[8]; }
    __device__ __forceinline__ const float* w_out() const { return (const float*)kp->in[9]; }
    __device__ __forceinline__ const float* na_rpb() const { return (const float*)kp->in[10]; }
    __device__ __forceinline__ const float* gla_gate_w() const { return (const float*)kp->in[11]; }
    __device__ __forceinline__ const float* gla_gate_b() const { return (const float*)kp->in[12]; }
    __device__ __forceinline__ const float* gla_norm_w() const { return (const float*)kp->in[13]; }
    __device__ __forceinline__ const float* gdn_conv_w() const { return (const float*)kp->in[14]; }
    __device__ __forceinline__ const float* gdn_a_log() const { return (const float*)kp->in[15]; }
    __device__ __forceinline__ const float* gdn_dt_bias() const { return (const float*)kp->in[16]; }
    __device__ __forceinline__ const float* gdn_norm_w() const { return (const float*)kp->in[17]; }
    __device__ __forceinline__ const float* w_router() const { return (const float*)kp->in[18]; }
    __device__ __forceinline__ const float* w_exp_gate() const { return (const float*)kp->in[19]; }
    __device__ __forceinline__ const float* w_exp_up() const { return (const float*)kp->in[20]; }
    __device__ __forceinline__ const float* w_exp_down() const { return (const float*)kp->in[21]; }
    __device__ __forceinline__ const float* final_norm_w() const { return (const float*)kp->in[22]; }
    __device__ __forceinline__ float* out() const { return (float*)kp->out; }
    __device__ __forceinline__ float* MOD() const { return (float*)(ws + WS_MOD); }
    __device__ __forceinline__ float* ROPE() const { return (float*)(ws + WS_ROPE); }
    __device__ __forceinline__ float* HX() const { return (float*)(ws + WS_HX); }
    __device__ __forceinline__ float* PS() const { return (float*)(ws + WS_PS); }
    __device__ __forceinline__ float* GQKV() const { return (float*)(ws + WS_GQKV); }
    __device__ __forceinline__ bf16* GQKVb() const { return (bf16*)(ws + WS_GQKV); }
    __device__ __forceinline__ float* GGB() const { return (float*)(ws + WS_GGB); }
    __device__ __forceinline__ float* LQ() const { return (float*)(ws + WS_LQ); }
    __device__ __forceinline__ float* LK() const { return (float*)(ws + WS_LK); }
    __device__ __forceinline__ float* LA() const { return (float*)(ws + WS_LA); }
    __device__ __forceinline__ float* OGLA() const { return (float*)(ws + WS_OGLA); }
    __device__ __forceinline__ float* OGDN() const { return (float*)(ws + WS_OGDN); }
    __device__ __forceinline__ float* AFF() const { return (float*)(ws + WS_AFF); }
    __device__ __forceinline__ float* GATEV() const { return (float*)(ws + WS_GATE); }
    __device__ __forceinline__ bf16* WIN() const { return (bf16*)(ws + WS_WIN); }
    __device__ __forceinline__ bf16* WOUT() const { return (bf16*)(ws + WS_WOUT); }
    __device__ __forceinline__ bf16* WGU() const { return (bf16*)(ws + WS_WGU); }
    __device__ __forceinline__ bf16* WDN() const { return (bf16*)(ws + WS_WDN); }
    __device__ __forceinline__ bf16* NX() const { return (bf16*)(ws + WS_NX); }
    __device__ __forceinline__ bf16* P() const { return (bf16*)(ws + WS_P); }
    __device__ __forceinline__ bf16* CAT() const { return (bf16*)(ws + WS_CAT); }
    __device__ __forceinline__ bf16* AMOE() const { return (bf16*)(ws + WS_AMOE); }
    __device__ __forceinline__ bf16* HID() const { return (bf16*)(ws + WS_HID); }
    __device__ __forceinline__ int* IDX() const { return (int*)(ws + WS_IDX); }
    __device__ __forceinline__ unsigned* ctl() const { return (unsigned*)(ws + WS_CTL); }
    __device__ __forceinline__ int* SLOTOF() const { return (int*)(ws + WS_SLOTOF); }
    __device__ __forceinline__ bf16* Y() const { return (bf16*)(ws + WS_Y); }
    __device__ __forceinline__ bf16* GLQT() const { return (bf16*)(ws + WS_GLQT); }
    __device__ __forceinline__ bf16* GLKT() const { return (bf16*)(ws + WS_GLKT); }
    __device__ __forceinline__ bf16* GLKH() const { return (bf16*)(ws + WS_GLKH); }
    __device__ __forceinline__ bf16* GLVT() const { return (bf16*)(ws + WS_GLVT); }
    __device__ __forceinline__ float* GLDEC() const { return (float*)(ws + WS_GLDEC); }
    __device__ __forceinline__ bf16* GDST() const { return (bf16*)(ws + WS_GDST); }
    __device__ __forceinline__ bf16* GLST() const { return (bf16*)(ws + WS_GLST); }
    __device__ __forceinline__ bf16* GDQP() const { return (bf16*)(ws + WS_GDQP); }
    __device__ __forceinline__ bf16* GDO0() const { return (bf16*)(ws + WS_GDO0); }
    __device__ __forceinline__ bf16* GDAP() const { return (bf16*)(ws + WS_GDAP); }
    __device__ __forceinline__ bf16* GDBM() const { return (bf16*)(ws + WS_GDBM); }
    __device__ __forceinline__ float* GDGL() const { return (float*)(ws + WS_GDGL); }
};
__device__ __forceinline__ int modrow(int row) { return row < ML ? (row >> 12) : 2; }
__device__ __forceinline__ const float* src_row_ptr(const Ctx& c, int l, int row) {
    if (l == 0) return row < ML ? c.x() + (size_t)row * D : c.ctxin() + (size_t)(row - ML) * D;
    return c.HX() + (size_t)row * D;
}

__device__ __forceinline__ void transpose_item(const float* W, int ldw, int k0, int sn0, int nvalid, bf16* dst, int K, float* scr, int lane) {
    { const int c4 = lane & 7, rr = lane >> 3; const float* wp = W + (size_t)(k0 + rr) * ldw + sn0 + 4 * c4; const bool ok = 4 * c4 < nvalid;
        f4 v[8];
#pragma unroll
        for (int i = 0; i < 8; ++i) v[i] = ok ? *(const f4*)(wp + (size_t)(8 * i) * ldw) : (f4){0.f, 0.f, 0.f, 0.f};
#pragma unroll
        for (int i = 0; i < 8; ++i) { float* sp = scr + (rr + 8 * i) * 33 + 4 * c4; sp[0] = v[i].x; sp[1] = v[i].y; sp[2] = v[i].z; sp[3] = v[i].w; } }
    LDS_WAIT();
    const int cc = lane & 7;
#pragma unroll
    for (int j = 0; j < 4; ++j) { const int n = (lane >> 3) + 8 * j; const float* s = scr + (8 * cc) * 33 + n;
        u4 o; o.x = pk2(s[0 * 33], s[1 * 33]); o.y = pk2(s[2 * 33], s[3 * 33]); o.z = pk2(s[4 * 33], s[5 * 33]); o.w = pk2(s[6 * 33], s[7 * 33]);
        *(u4*)(dst + (size_t)n * K + 8 * cc) = o; }
    LDS_WAIT();
}
__device__ __forceinline__ float sat_fp8(float x) { return __builtin_amdgcn_fmed3f(x, -448.0f, 448.0f); }
__device__ __forceinline__ unsigned pk4_fp8(float a, float b, float cc, float d) { unsigned w = 0u; w = __builtin_amdgcn_cvt_pk_fp8_f32(sat_fp8(a), sat_fp8(b), w, false); w = __builtin_amdgcn_cvt_pk_fp8_f32(sat_fp8(cc), sat_fp8(d), w, true); return w; }
__device__ __forceinline__ void transpose_item8(const float* W, int ldw, int k0, int sn0, unsigned char* dst, int K8, float* scr, int lane) {
    { const int c4 = lane & 7, rr = lane >> 3; const float* wp = W + (size_t)(k0 + rr) * ldw + sn0 + 4 * c4;
        f4 v[8];
#pragma unroll
        for (int i = 0; i < 8; ++i) v[i] = *(const f4*)(wp + (size_t)(8 * i) * ldw);
#pragma unroll
        for (int i = 0; i < 8; ++i) { float* sp = scr + (rr + 8 * i) * 33 + 4 * c4; sp[0] = v[i].x; sp[1] = v[i].y; sp[2] = v[i].z; sp[3] = v[i].w; } }
    LDS_WAIT();
    const int cc = lane & 7; constexpr float SC = (float)(1 << pg8::F8_WSCALE_LOG2);
#pragma unroll
    for (int j = 0; j < 4; ++j) { const int n = (lane >> 3) + 8 * j; const float* s = scr + (8 * cc) * 33 + n;
        u2 o; o.x = pk4_fp8(s[0 * 33] * SC, s[1 * 33] * SC, s[2 * 33] * SC, s[3 * 33] * SC); o.y = pk4_fp8(s[4 * 33] * SC, s[5 * 33] * SC, s[6 * 33] * SC, s[7 * 33] * SC);
        *(u2*)(dst + (size_t)n * K8 + 8 * cc) = o; }
    LDS_WAIT();
}
__device__ __forceinline__ void ph_prologue(const Ctx& c) {
    float* S3 = (float*)c.lds;
    float* scr = (float*)(c.lds + 32768 + c.wave * 8704);
    for (int i = c.tid; i < 3 * D; i += NTHREADS) { const int r = i / D, k = i % D; const float v = r < 2 ? c.cvec()[r * D + k] : c.c_ctx()[k]; S3[i] = silu_f(v); }
    __syncthreads();
    constexpr int N_MOD = 2 * (MODW / 32);
    constexpr int N_ROPE = 16;
    constexpr int N_WIN = 2 * 32 * 210, N_WOUT = 2 * 32 * 64, N_EXP = 96 * 2048;
    constexpr int NITEMS = N_MOD + N_ROPE + N_WIN + N_WOUT + N_EXP;
    const int lane = c.lane;
    constexpr int NGRABS = N_MOD + (NITEMS - N_MOD + 7) / 8;
    for (;;) {
      int g = 0; if (lane == 0) g = (int)atomicAdd(c.ctl() + CW_PROQ, 1u);
      g = __builtin_amdgcn_readfirstlane(g);
      if (g >= NGRABS) break;
      const int it0 = g < N_MOD ? g : N_MOD + (g - N_MOD) * 8, it1 = g < N_MOD ? g + 1 : (it0 + 8 < NITEMS ? it0 + 8 : NITEMS);
      for (int it = it0; it < it1; ++it) {
        int r = it;
        if (r < N_MOD) {
            const int l = r / (MODW / 32), cb = r % (MODW / 32), kg = lane >> 3, cl = lane & 7, col = cb * 32 + 4 * cl;
            const float* wp = c.w_ada() + (size_t)l * D * MODW + col;
            f4 a0 = {0.f, 0.f, 0.f, 0.f}, a1 = a0, a2 = a0;
#pragma unroll 8
            for (int i = 0; i < 256; ++i) { const int k = kg + 8 * i; const f4 w = *(const f4*)(wp + (size_t)k * MODW); a0 += S3[k] * w; a1 += S3[D + k] * w; a2 += S3[2 * D + k] * w; }
#pragma unroll
            for (int q = 0; q < 4; ++q) {
#pragma unroll
                for (int o = 8; o < 64; o <<= 1) { a0[q] += __shfl_xor(a0[q], o); a1[q] += __shfl_xor(a1[q], o); a2[q] += __shfl_xor(a2[q], o); } }
            if (kg == 0) { const f4 bb = *(const f4*)(c.b_ada() + (size_t)l * MODW + col);
                *(f4*)(c.MOD() + (size_t)(l * 3 + 0) * MODW + col) = a0 + bb; *(f4*)(c.MOD() + (size_t)(l * 3 + 1) * MODW + col) = a1 + bb; *(f4*)(c.MOD() + (size_t)(l * 3 + 2) * MODW + col) = a2 + bb; }
            continue; }
        r -= N_MOD;
        if (r < N_ROPE) { const int en = r * 64 + lane, pos = en >> 4, i = en & 15; const float f = powf(10000.f, -(float)i / 16.f), ang = (float)pos * f;
            c.ROPE()[en * 2] = cosf(ang); c.ROPE()[en * 2 + 1] = sinf(ang); continue; }
        r -= N_ROPE;
        if (r < N_WIN) { const int l = r / (32 * 210), q = r % (32 * 210), kb = q / 210, nb = q % 210, n0 = nb * 32;
            int sn0, nv = 32;
            if (n0 < 4608) sn0 = n0; else if (n0 < 6656) sn0 = n0 + 32; else if (n0 < 6688) sn0 = 4608 + (n0 - 6656); else { sn0 = 6688; nv = 16; }
            transpose_item(c.w_in() + (size_t)l * D * INW, INW, kb * 64, sn0, nv, c.WIN() + ((size_t)l * NP + n0) * D + kb * 64, D, scr, lane); continue; }
        r -= N_WIN;
        if (r < N_WOUT) { const int l = r / 2048, q = r % 2048, kb = q / 64, nb = q % 64;
            transpose_item(c.w_out() + (size_t)l * D * D, D, kb * 64, nb * 32, 32, c.WOUT() + ((size_t)l * D + nb * 32) * D + kb * 64, D, scr, lane); continue; }
        r -= N_WOUT;
        { const int mtx = r / 2048, q = r % 2048, kb = q / 64, nb = q % 64; const int ty = mtx / 32, le = mtx % 32;
            const bool f8 = ((F8MASK) >> (le >> 4)) & 1;
            if (ty < 2) { const float* W = (ty == 0 ? c.w_exp_gate() : c.w_exp_up()) + (size_t)le * D * FF;
                const int drow = (nb >> 2) * 256 + ty * 128 + (nb & 3) * 32;
                if (!f8) transpose_item(W, FF, kb * 64, nb * 32, 32, c.WGU() + ((size_t)le * 4096 + drow) * D + kb * 64, D, scr, lane);
                else transpose_item8(W, FF, kb * 64, nb * 32, (unsigned char*)(c.WGU() + (size_t)(le >> 4) * NE * 4096 * D) + ((size_t)(le & 15) * 4096 + drow) * D + kb * 64, D, scr, lane); }
            else { const float* W = c.w_exp_down() + (size_t)le * FF * D;
                if (!f8) transpose_item(W, D, kb * 64, nb * 32, 32, c.WDN() + ((size_t)le * D + nb * 32) * FF + kb * 64, FF, scr, lane);
                else transpose_item8(W, D, kb * 64, nb * 32, (unsigned char*)(c.WDN() + (size_t)(le >> 4) * NE * D * FF) + ((size_t)(le & 15) * D + nb * 32) * FF + kb * 64, FF, scr, lane); } }
    }
    }
}


__device__ __forceinline__ void moe_combine_row(const Ctx& c, int lm, int row, int lane, f4 (&v)[8]) {
    f4 acc[8];
#pragma unroll
    for (int j = 0; j < 8; ++j) acc[j] = (f4){0.f, 0.f, 0.f, 0.f};
    const int* so = c.SLOTOF() + row;
    const int sl = lane < NE ? so[(size_t)lane * MROWS] : -1;
    unsigned mask = (unsigned)__ballot(sl >= 0) & 0xffffu;
    while (mask) {
        const int e0 = __builtin_ctz(mask); mask &= mask - 1u;
        const bool h1 = mask != 0u; const int e1 = h1 ? __builtin_ctz(mask) : e0; if (h1) mask &= mask - 1u;
        const bool h2 = mask != 0u; const int e2 = h2 ? __builtin_ctz(mask) : e0; if (h2) mask &= mask - 1u;
        const int s0 = __builtin_amdgcn_readlane(sl, e0), s1 = __builtin_amdgcn_readlane(sl, e1), s2 = __builtin_amdgcn_readlane(sl, e2);
        const float g0 = c.GATEV()[e0 * ESLOT + s0], g1r = c.GATEV()[e1 * ESLOT + s1], g2r = c.GATEV()[e2 * ESLOT + s2];
        const bf16* y0 = c.Y() + ((size_t)e0 * ESLOT + s0) * D + 4 * lane; const bf16* y1 = c.Y() + ((size_t)e1 * ESLOT + s1) * D + 4 * lane; const bf16* y2 = c.Y() + ((size_t)e2 * ESLOT + s2) * D + 4 * lane;
        u2 r0[8], r1[8], r2[8];
#pragma unroll
        for (int j = 0; j < 8; ++j) { r0[j] = *(const u2*)(y0 + 256 * j); r1[j] = *(const u2*)(y1 + 256 * j); r2[j] = *(const u2*)(y2 + 256 * j); }
        const float g1 = h1 ? g1r : 0.f, g2 = h2 ? g2r : 0.f;
#pragma unroll
        for (int j = 0; j < 8; ++j) {
            acc[j].x += g0 * bf2f(r0[j].x & 0xffffu); acc[j].y += g0 * bf2f(r0[j].x >> 16); acc[j].z += g0 * bf2f(r0[j].y & 0xffffu); acc[j].w += g0 * bf2f(r0[j].y >> 16);
            acc[j].x += g1 * bf2f(r1[j].x & 0xffffu); acc[j].y += g1 * bf2f(r1[j].x >> 16); acc[j].z += g1 * bf2f(r1[j].y & 0xffffu); acc[j].w += g1 * bf2f(r1[j].y >> 16);
            acc[j].x += g2 * bf2f(r2[j].x & 0xffffu); acc[j].y += g2 * bf2f(r2[j].x >> 16); acc[j].z += g2 * bf2f(r2[j].y & 0xffffu); acc[j].w += g2 * bf2f(r2[j].y >> 16); }
    }
    const float* g2 = c.MOD() + (size_t)(lm * 3 + modrow(row)) * MODW + 5 * D + 4 * lane;
#pragma unroll
    for (int j = 0; j < 8; ++j) v[j] += *(const f4*)(g2 + 256 * j) * acc[j];
}

__device__ __forceinline__ void ph_norm1(const Ctx& c, int l) {
    const int lane = c.lane;
    for (int row = c.gw; row < MROWS; row += c.ngw) {
        const float* xr = src_row_ptr(c, l, row);
        f4 v[8]; float ss = 0.f;
#pragma unroll
        for (int j = 0; j < 8; ++j) v[j] = *(const f4*)(xr + 4 * lane + 256 * j);
        if (l > 0) { moe_combine_row(c, l - 1, row, lane, v); float* hw = c.HX() + (size_t)row * D;
#pragma unroll
            for (int j = 0; j < 8; ++j) *(f4*)(hw + 4 * lane + 256 * j) = v[j]; }
#pragma unroll
        for (int j = 0; j < 8; ++j) ss += v[j].x * v[j].x + v[j].y * v[j].y + v[j].z * v[j].z + v[j].w * v[j].w;
        ss = wave_sum(ss);
        const float rstd = 1.0f / sqrtf(ss * (1.0f / D) + 1e-6f);
        const float* nw = c.norm_mix_w() + (size_t)l * D; const float* md = c.MOD() + (size_t)(l * 3 + modrow(row)) * MODW;
        bf16* orow = c.NX() + (size_t)row * D;
#pragma unroll
        for (int j = 0; j < 8; ++j) { const int col = 4 * lane + 256 * j; const f4 w = *(const f4*)(nw + col), sh = *(const f4*)(md + col), sc = *(const f4*)(md + D + col);
            const f4 y = v[j] * rstd * w * (1.0f + sc) + sh; u2 o; o.x = pk2(y.x, y.y); o.y = pk2(y.z, y.w); *(u2*)(orow + col) = o; }
    }
}

using pg8::f32x4; using pg8::u32x4; using pg8::Unit;
struct EpiP {
    static constexpr bool PERM = true, AFTER_DRAIN = false;
    bf16* P; float* PS;
    __device__ __forceinline__ void operator()(const f32x4 (&acc)[2][2][4][2], const Unit& u, int wr, int wc, int fr, int fq) const {
        const int row0 = u.pm * 256 + wr * 64 + fr, col0 = u.pn * 256 + wc * 32 + 8 * fq;
#pragma unroll
        for (int ai = 0; ai < 2; ++ai)
#pragma unroll
            for (int m = 0; m < 4; ++m) { const int row = row0 + ai * 128 + m * 16; bf16* rowp = P + (size_t)row * NP + col0;
#pragma unroll
                for (int bj = 0; bj < 2; ++bj) { const f32x4 v0 = acc[ai][bj][m][0], v1 = acc[ai][bj][m][1];
                    u32x4 w; w.x = pg8::cvt_pk_bf16(v0[0], v0[1]); w.y = pg8::cvt_pk_bf16(v0[2], v0[3]); w.z = pg8::cvt_pk_bf16(v1[0], v1[1]); w.w = pg8::cvt_pk_bf16(v1[2], v1[3]);
                    *(u32x4*)(rowp + bj * 128) = w; }
                if (u.pn == 26 && wc < 2) { float* ps = PS + (size_t)row * 64 + wc * 32 + 8 * fq; *(f32x4*)ps = acc[ai][0][m][0]; *(f32x4*)(ps + 4) = acc[ai][0][m][1]; } }
    }
};
struct EpiResid {
    static constexpr bool PERM = false, AFTER_DRAIN = false;
    const float *x, *ctxin, *MOD; float* HX; int l;
    __device__ __forceinline__ void operator()(const f32x4 (&acc)[2][2][4][2], const Unit& u, int wr, int wc, int fr, int fq) const {
#pragma unroll
        for (int ai = 0; ai < 2; ++ai)
#pragma unroll
            for (int m = 0; m < 4; ++m) { const int row = u.pm * 256 + ai * 128 + wr * 64 + m * 16 + fr; float* dst = HX + (size_t)row * D;
                const float* src = (l == 0) ? (row < ML ? x + (size_t)row * D : ctxin + (size_t)(row - ML) * D) : dst;
                const float* g1 = MOD + (size_t)(l * 3 + modrow(row)) * MODW + 2 * D;
#pragma unroll
                for (int bj = 0; bj < 2; ++bj)
#pragma unroll
                    for (int n = 0; n < 2; ++n) { const int col = u.pn * 256 + bj * 128 + wc * 32 + n * 16 + 4 * fq;
                        *(f32x4*)(dst + col) = *(const f32x4*)(src + col) + *(const f32x4*)(g1 + col) * acc[ai][bj][m][n]; } }
    }
};
struct EpiSwiglu {
    static constexpr bool PERM = true, AFTER_DRAIN = false;
    bf16* HID;
    __device__ __forceinline__ void operator()(const f32x4 (&acc)[2][2][4][2], const Unit& u, int wr, int wc, int fr, int fq) const {
        const int row0 = u.pm * 256 + wr * 64 + fr, col0 = (u.pn & 15) * 128 + wc * 32 + 8 * fq;
#pragma unroll
        for (int ai = 0; ai < 2; ++ai)
#pragma unroll
            for (int m = 0; m < 4; ++m) { bf16* rowp = HID + (size_t)(row0 + ai * 128 + m * 16) * FF + col0;
                float h[8];
#pragma unroll
                for (int n = 0; n < 2; ++n)
#pragma unroll
                    for (int i = 0; i < 4; ++i) { const float g = acc[ai][0][m][n][i], up = acc[ai][1][m][n][i]; h[n * 4 + i] = silu_f(g) * up; }
                u32x4 w; w.x = pg8::cvt_pk_bf16(h[0], h[1]); w.y = pg8::cvt_pk_bf16(h[2], h[3]); w.z = pg8::cvt_pk_bf16(h[4], h[5]); w.w = pg8::cvt_pk_bf16(h[6], h[7]);
                *(u32x4*)rowp = w; }
    }
};
struct EpiSwiglu8 {
    static constexpr bool PERM = true, AFTER_DRAIN = false;
    unsigned char* HID8;
    __device__ __forceinline__ void operator()(const f32x4 (&acc)[2][2][4][2], const Unit& u, int wr, int wc, int fr, int fq) const {
        const int row0 = u.pm * 256 + wr * 64 + fr, col0 = (u.pn & 15) * 128 + wc * 32 + 8 * fq;
#pragma unroll
        for (int ai = 0; ai < 2; ++ai)
#pragma unroll
            for (int m = 0; m < 4; ++m) { unsigned char* rowp = HID8 + (size_t)(row0 + ai * 128 + m * 16) * FF + col0;
                float h[8];
#pragma unroll
                for (int n = 0; n < 2; ++n)
#pragma unroll
                    for (int i = 0; i < 4; ++i) { const float g = acc[ai][0][m][n][i], up = acc[ai][1][m][n][i]; h[n * 4 + i] = silu_f(g) * up; }
                u2 w; w.x = pk4_fp8(h[0], h[1], h[2], h[3]); w.y = pk4_fp8(h[4], h[5], h[6], h[7]);
                *(u2*)rowp = w; }
    }
};
struct EpiY {
    static constexpr bool PERM = true, AFTER_DRAIN = false;
    bf16* Yp;
    __device__ __forceinline__ void operator()(const f32x4 (&acc)[2][2][4][2], const Unit& u, int wr, int wc, int fr, int fq) const {
        const int row0 = u.pm * 256 + wr * 64 + fr, col0 = (u.pn & 7) * 256 + wc * 32 + 8 * fq;
#pragma unroll
        for (int ai = 0; ai < 2; ++ai)
#pragma unroll
            for (int m = 0; m < 4; ++m) { bf16* rowp = Yp + (size_t)(row0 + ai * 128 + m * 16) * D + col0;
#pragma unroll
                for (int bj = 0; bj < 2; ++bj) { const f32x4 v0 = acc[ai][bj][m][0], v1 = acc[ai][bj][m][1];
                    u32x4 w; w.x = pg8::cvt_pk_bf16(v0[0], v0[1]); w.y = pg8::cvt_pk_bf16(v0[2], v0[3]); w.z = pg8::cvt_pk_bf16(v1[0], v1[1]); w.w = pg8::cvt_pk_bf16(v1[2], v1[3]);
                    *(u32x4*)(rowp + bj * 128) = w; } }
    }
};
struct MoeOrder {
    int MT, NT, G, c;
    __device__ __forceinline__ bool next(int i, Unit& u) const { const int per = MT * NT; int e, r;
        if ((G & 7) == 0) { const int Lx = i * (G >> 3) + (c >> 3); if (Lx >= 2 * per) return false; e = 2 * (c & 7) + Lx / per; r = Lx % per; }
        else { const int L = i * G + c; if (L >= NE * per) return false; e = L / per; r = L % per; }
        u.pm = e * 5 + (r % MT); u.pn = e * NT + (r / MT); return true; }
    __device__ __forceinline__ void a_ready(const Unit&) const {}
    __device__ __forceinline__ void done(const Unit&) const {}
};
struct RowOrder {
    int nM, nN, G, c;
    __device__ __forceinline__ bool next(int i, Unit& u) const { const int L = i * G + c; if (L >= nM * nN) return false; u.pm = L % nM; u.pn = L / nM; return true; }
    __device__ __forceinline__ void a_ready(const Unit&) const {}
    __device__ __forceinline__ void done(const Unit&) const {}
};

__device__ __forceinline__ void prep_pair_j(const Ctx& c, const float* cw, int row, int t, int T, int j, int lane) {
    const int cb = j * 512 + lane * 8;
    u4 raw[6];
#pragma unroll
    for (int q = 0; q < 6; ++q) { const int tt = t + q - 2; raw[q] = (tt >= 0 && tt < T) ? *(const u4*)(c.P() + (size_t)(row + q - 2) * NP + PC_GDQ + cb) : (u4){0u, 0u, 0u, 0u}; }
    float a0[8], a1[8];
#pragma unroll
    for (int i = 0; i < 8; ++i) { a0[i] = 0.f; a1[i] = 0.f; }
#pragma unroll
    for (int tap = 0; tap < 5; ++tap) { const f4 w0 = *(const f4*)(cw + tap * 1536 + cb), w1 = *(const f4*)(cw + tap * 1536 + cb + 4);
        const float wv[8] = {w0.x, w0.y, w0.z, w0.w, w1.x, w1.y, w1.z, w1.w};
        const u4 r0 = raw[tap], r1 = raw[tap + 1];
        const float x0[8] = {bf2f(r0.x & 0xffffu), bf2f(r0.x >> 16), bf2f(r0.y & 0xffffu), bf2f(r0.y >> 16), bf2f(r0.z & 0xffffu), bf2f(r0.z >> 16), bf2f(r0.w & 0xffffu), bf2f(r0.w >> 16)};
        const float x1[8] = {bf2f(r1.x & 0xffffu), bf2f(r1.x >> 16), bf2f(r1.y & 0xffffu), bf2f(r1.y >> 16), bf2f(r1.z & 0xffffu), bf2f(r1.z >> 16), bf2f(r1.w & 0xffffu), bf2f(r1.w >> 16)};
#pragma unroll
        for (int i = 0; i < 8; ++i) { a0[i] += wv[i] * x0[i]; a1[i] += wv[i] * x1[i]; } }
#pragma unroll
    for (int rr = 0; rr < 2; ++rr) { float* a = rr ? a1 : a0; float ss = 0.f;
#pragma unroll
        for (int i = 0; i < 8; ++i) { a[i] = silu_f(a[i]); ss += a[i] * a[i]; }
        if (j < 2) { ss += __shfl_xor(ss, 1); ss += __shfl_xor(ss, 2); ss += __shfl_xor(ss, 4); ss += __shfl_xor(ss, 8);
            const float sc = (1.0f / sqrtf(ss + 1e-6f)) * (j == 0 ? 0.08838834764831845f : 1.0f);
#pragma unroll
            for (int i = 0; i < 8; ++i) a[i] *= sc; }
        u4 ow; ow.x = pk2(a[0], a[1]); ow.y = pk2(a[2], a[3]); ow.z = pk2(a[4], a[5]); ow.w = pk2(a[6], a[7]);
        *(u4*)(c.GQKVb() + (size_t)(row + rr) * 1536 + cb) = ow; }
}
__device__ __forceinline__ void prep_gates(const Ctx& c, int l, int row, int lane) {
    if (lane < 16) { const int rr = lane >> 3, li = lane & 7; const float* ps = c.PS() + (size_t)(row + rr) * 64; const float av = ps[32 + li], bv = ps[40 + li];
        const float g = -expf(c.gdn_a_log()[l * 8 + li]) * softplus_f(av + c.gdn_dt_bias()[l * 8 + li]);
        c.GGB()[(size_t)(row + rr) * 16 + li] = g; c.GGB()[(size_t)(row + rr) * 16 + 8 + li] = 1.0f / (1.0f + expf(-bv)); }
}
__device__ __forceinline__ void ph_prep(const Ctx& c, int l) {
    const int lane = c.lane;
    const float* cw = c.gdn_conv_w() + (size_t)l * 5 * 1536;
    for (int p = blockIdx.x * 8 + c.wave; p < ML / 2; p += gridDim.x * 8) { const int row = 2 * p, t = row & (SEQ - 1);
#pragma unroll
        for (int j = 0; j < 3; ++j) prep_pair_j(c, cw, row, t, SEQ, j, lane);
        prep_gates(c, l, row, lane); }
    for (int q = c.wave * gridDim.x + blockIdx.x; q < 3 * (MC / 2); q += gridDim.x * 8) { const int p = q / 3, j = q - 3 * p, row = ML + 2 * p, t = (row - ML) & (CTX - 1);
        prep_pair_j(c, cw, row, t, CTX, j, lane);
        if (j == 0) prep_gates(c, l, row, lane); }
}

__device__ __forceinline__ int scan_row(int s, int b, int dir) { if (s < CTX) return ML + b * CTX + (dir ? CTX - 1 - s : s); const int u = s - CTX; return b * SEQ + (dir ? SEQ - 1 - u : u); }
__device__ __forceinline__ void gla_scan_task(const Ctx& c, int b, int h, int dir) {
    float* sq = (float*)c.lds; float* sk = sq + 2048; float* sa = sk + 2048; float* sv = sa + 2048;
    const int e = c.wave * 16 + (c.lane & 15), dg = c.lane >> 4, d0 = dg * 16;
    float S[16];
#pragma unroll
    for (int i = 0; i < 16; ++i) S[i] = 0.f;
    for (int cs = 0; cs < (CTX + SEQ) / 32; ++cs) {
        __syncthreads();
        for (int idx = c.tid; idx < 2048; idx += NTHREADS) { const int tk = idx >> 6, d = idx & 63, row = scan_row(cs * 32 + tk, b, dir);
            sq[idx] = c.LQ()[(size_t)row * 256 + h * 64 + d]; sk[idx] = c.LK()[(size_t)row * 256 + h * 64 + d]; sa[idx] = expf(c.LA()[((size_t)dir * MROWS + row) * 256 + h * 64 + d]); }
        for (int idx = c.tid; idx < 4096; idx += NTHREADS) { const int tk = idx >> 7, e2 = idx & 127, row = scan_row(cs * 32 + tk, b, dir);
            sv[idx] = bf2f(c.P()[(size_t)row * NP + PC_GLV + h * 128 + e2]); }
        __syncthreads();
        for (int tk = 0; tk < 32; ++tk) {
            const float ve = sv[tk * 128 + e]; float o = 0.f;
#pragma unroll
            for (int i = 0; i < 16; ++i) { const int d = tk * 64 + d0 + i; S[i] = sa[d] * S[i] + sk[d] * ve; o += sq[d] * S[i]; }
            o += __shfl_xor(o, 16); o += __shfl_xor(o, 32);
            if (dg == 0) c.OGLA()[((size_t)dir * MROWS + scan_row(cs * 32 + tk, b, dir)) * 512 + h * 128 + e] = o;
        }
    }
}
__device__ __forceinline__ void gdn_scan_task(const Ctx& c, int b, int h, int dir) {
    float* sq = (float*)c.lds; float* sk = sq + 4096; float* sv = sk + 4096; float* sg = sv + 4096; float* sb = sg + 32;
    const int e = c.wave * 16 + (c.lane & 15), dg = c.lane >> 4, d0 = dg * 32;
    float S[32];
#pragma unroll
    for (int i = 0; i < 32; ++i) S[i] = 0.f;
    for (int cs = 0; cs < (CTX + SEQ) / 32; ++cs) {
        __syncthreads();
        for (int idx = c.tid; idx < 4096; idx += NTHREADS) { const int tk = idx >> 7, d = idx & 127, row = scan_row(cs * 32 + tk, b, dir); const float* g = c.GQKV() + (size_t)row * 1536 + h * 128 + d;
            sq[idx] = g[0]; sk[idx] = g[512]; sv[idx] = g[1024]; }
        if (c.tid < 32) { const int row = scan_row(cs * 32 + c.tid, b, dir); sg[c.tid] = expf(c.GGB()[(size_t)row * 16 + dir * 4 + h]); sb[c.tid] = c.GGB()[(size_t)row * 16 + 8 + dir * 4 + h]; }
        __syncthreads();
        for (int tk = 0; tk < 32; ++tk) {
            float ks = 0.f;
#pragma unroll
            for (int i = 0; i < 32; ++i) ks += sk[tk * 128 + d0 + i] * S[i];
            ks += __shfl_xor(ks, 16); ks += __shfl_xor(ks, 32);
            const float eg = sg[tk], delta = sb[tk] * (sv[tk * 128 + e] - eg * ks);
            float o = 0.f;
#pragma unroll
            for (int i = 0; i < 32; ++i) { const int d = tk * 128 + d0 + i; S[i] = eg * S[i] + sk[d] * delta; o += sq[d] * S[i]; }
            o += __shfl_xor(o, 16); o += __shfl_xor(o, 32);
            if (dg == 0) c.OGDN()[((size_t)dir * MROWS + scan_row(cs * 32 + tk, b, dir)) * 512 + h * 128 + e] = o;
        }
    }
}
__device__ __forceinline__ void na_task(const Ctx& c, int l, int task, int lane) {
    const bool lat = task < ML * 16;
    const int tq = lat ? task : task - ML * 16;
    const int h = tq & 15, row = (tq >> 4) + (lat ? 0 : ML);
    const int b = lat ? (row >> 12) : ((row - ML) >> 8);
    const bf16* P = c.P();
    const float qv = bf2f(P[(size_t)row * NP + PC_NAQ + h * 64 + lane]) * 0.125f;
    int krow[6]; float sc[6];
#pragma unroll
    for (int i = 0; i < 4; ++i) { krow[2 + i] = ML + b * CTX + lane + 64 * i; sc[2 + i] = 0.f; }
    if (lat) { const int t = row & (SEQ - 1), r = t >> 6, cq = t & 63; const int rs = min(max(r - 4, 0), 56), cs = min(max(cq - 8, 0), 48);
#pragma unroll
        for (int i = 0; i < 2; ++i) { const int lk = lane + 64 * i, j = lk >> 4, cc = lk & 15; krow[i] = b * SEQ + (rs + j) * 64 + cs + cc;
            sc[i] = c.na_rpb()[((size_t)(l * 16 + h) * 15 + (rs + j - r + 7)) * 31 + (cs + cc - cq + 15)]; } }
    else { krow[0] = krow[2]; krow[1] = krow[2]; sc[0] = -INFINITY; sc[1] = -INFINITY; }
#pragma unroll
    for (int i = 0; i < 6; ++i) {
        if (i >= 2 || lat) { const bf16* kp = P + (size_t)krow[i] * NP + PC_NAK + h * 64; float s = 0.f;
#pragma unroll
            for (int m = 0; m < 8; ++m) { const u4 w = *(const u4*)(kp + 8 * m);
                s += __int_as_float(__builtin_amdgcn_readlane(__float_as_int(qv), 8 * m + 0)) * bf2f(w.x & 0xffffu); s += __int_as_float(__builtin_amdgcn_readlane(__float_as_int(qv), 8 * m + 1)) * bf2f(w.x >> 16);
                s += __int_as_float(__builtin_amdgcn_readlane(__float_as_int(qv), 8 * m + 2)) * bf2f(w.y & 0xffffu); s += __int_as_float(__builtin_amdgcn_readlane(__float_as_int(qv), 8 * m + 3)) * bf2f(w.y >> 16);
                s += __int_as_float(__builtin_amdgcn_readlane(__float_as_int(qv), 8 * m + 4)) * bf2f(w.z & 0xffffu); s += __int_as_float(__builtin_amdgcn_readlane(__float_as_int(qv), 8 * m + 5)) * bf2f(w.z >> 16);
                s += __int_as_float(__builtin_amdgcn_readlane(__float_as_int(qv), 8 * m + 6)) * bf2f(w.w & 0xffffu); s += __int_as_float(__builtin_amdgcn_readlane(__float_as_int(qv), 8 * m + 7)) * bf2f(w.w >> 16); }
            sc[i] += s; } }
    float mx = sc[0];
#pragma unroll
    for (int i = 1; i < 6; ++i) mx = fmaxf(mx, sc[i]);
    mx = wave_max(mx);
    float sum = 0.f;
#pragma unroll
    for (int i = 0; i < 6; ++i) { sc[i] = expf(sc[i] - mx); sum += sc[i]; }
    sum = wave_sum(sum);
    const float inv = 1.0f / sum;
    float o = 0.f;
    const bf16* vp = P + PC_NAV + h * 64 + lane;
#pragma unroll
    for (int i = 0; i < 6; ++i) {
        if (i >= 2 || lat) {
#pragma unroll 8
            for (int sl = 0; sl < 64; ++sl) { const float p = __int_as_float(__builtin_amdgcn_readlane(__float_as_int(sc[i]), sl)); const int kr = __builtin_amdgcn_readlane(krow[i], sl);
                o += p * bf2f(vp[(size_t)kr * NP]); } } }
    c.CAT()[(size_t)row * D + h * 64 + lane] = (bf16)f2bf(o * inv);
}
__device__ __forceinline__ void ph_scan_na(const Ctx& c, int l) {
    for (int bt = blockIdx.x; bt < 32; bt += gridDim.x) { const int kind = bt >> 4, dir = (bt >> 3) & 1, b = (bt >> 2) & 1, h = bt & 3;
        if (kind == 0) gla_scan_task(c, b, h, dir); else gdn_scan_task(c, b, h, dir); }
    __syncthreads();
    const int ntask = ML * 16 + (l == 0 ? MC * 16 : 0), nchunk = ntask / 512;
    int* sh = (int*)(c.lds + MISC_OFF + 64);
    for (;;) {
        __syncthreads();
        if (c.tid == 0) *sh = (int)atomicAdd(c.ctl() + CW_NAQ + 64 * (l + 2 * c.rep), 1u);
        __syncthreads();
        const int ch = *sh;
        if (ch >= nchunk) break;
        for (int i = 0; i < 64; ++i) na_task(c, l, ch * 512 + c.wave * 64 + i, c.lane);
    }
}

__device__ __forceinline__ void ph_combine(const Ctx& c, int l) {
    const int lane = c.lane; const int nrows = l == 0 ? MROWS : ML;
    for (int row = c.gw; row < nrows; row += c.ngw) {
#pragma unroll
        for (int which = 0; which < 1; ++which) {
            const float* O = which == 0 ? c.OGLA() : c.OGDN(); const float* nwp = (which == 0 ? c.gla_norm_w() : c.gdn_norm_w()) + l * 128 + (lane & 15) * 8;
            const int gcol = (which == 0 ? PC_GLG : PC_GDZ) + lane * 8;
            const f4 a0 = *(const f4*)(O + (size_t)row * 512 + lane * 8), a1 = *(const f4*)(O + (size_t)row * 512 + lane * 8 + 4);
            const f4 b0 = *(const f4*)(O + ((size_t)MROWS + row) * 512 + lane * 8), b1 = *(const f4*)(O + ((size_t)MROWS + row) * 512 + lane * 8 + 4);
            float o[8] = {a0.x + b0.x, a0.y + b0.y, a0.z + b0.z, a0.w + b0.w, a1.x + b1.x, a1.y + b1.y, a1.z + b1.z, a1.w + b1.w};
            float ss = 0.f;
#pragma unroll
            for (int i = 0; i < 8; ++i) ss += o[i] * o[i];
            ss += __shfl_xor(ss, 1); ss += __shfl_xor(ss, 2); ss += __shfl_xor(ss, 4); ss += __shfl_xor(ss, 8);
            const float rstd = 1.0f / sqrtf(ss * (1.0f / 128.f) + 1e-6f);
            const u4 graw = *(const u4*)(c.P() + (size_t)row * NP + gcol);
            const float g[8] = {bf2f(graw.x & 0xffffu), bf2f(graw.x >> 16), bf2f(graw.y & 0xffffu), bf2f(graw.y >> 16), bf2f(graw.z & 0xffffu), bf2f(graw.z >> 16), bf2f(graw.w & 0xffffu), bf2f(graw.w >> 16)};
            float y[8];
#pragma unroll
            for (int i = 0; i < 8; ++i) y[i] = o[i] * rstd * nwp[i] * silu_f(g[i]);
            u4 w; w.x = pk2(y[0], y[1]); w.y = pk2(y[2], y[3]); w.z = pk2(y[4], y[5]); w.w = pk2(y[6], y[7]);
            *(u4*)(c.CAT() + (size_t)row * D + 1024 + which * 512 + lane * 8) = w;
        }
    }
}

__device__ __forceinline__ float rs16(const float (&acc)[16], int lane) {
    float a8[8], a4[4], a2[2];
    { const bool hi = (lane & 32) != 0;
#pragma unroll
        for (int e = 0; e < 8; ++e) { const float send = hi ? acc[e] : acc[e + 8], keep = hi ? acc[e + 8] : acc[e]; a8[e] = keep + __shfl_xor(send, 32); } }
    { const bool hi = (lane & 16) != 0;
#pragma unroll
        for (int e = 0; e < 4; ++e) { const float send = hi ? a8[e] : a8[e + 4], keep = hi ? a8[e + 4] : a8[e]; a4[e] = keep + __shfl_xor(send, 16); } }
    { const bool hi = (lane & 8) != 0;
#pragma unroll
        for (int e = 0; e < 2; ++e) { const float send = hi ? a4[e] : a4[e + 2], keep = hi ? a4[e + 2] : a4[e]; a2[e] = keep + __shfl_xor(send, 8); } }
    float lg; { const bool hi = (lane & 4) != 0; const float send = hi ? a2[0] : a2[1], keep = hi ? a2[1] : a2[0]; lg = keep + __shfl_xor(send, 4); }
    lg += __shfl_xor(lg, 1); lg += __shfl_xor(lg, 2);
    return lg;
}
__device__ __forceinline__ void ph_norm2_router(const Ctx& c, int l) {
    constexpr int GSM = 17;
    const int gs = l == 0 ? 17 : 16, ngroups = 512;
    const int lane = c.lane, w = c.wave, c0 = w * 256 + 4 * lane;
    const int eid = ((lane >> 5) & 1) * 8 + ((lane >> 4) & 1) * 4 + ((lane >> 3) & 1) * 2 + ((lane >> 2) & 1);
    float* LB = (float*)c.lds;
    f4 Wl[16];
    { const float* wr = c.w_router() + (size_t)l * D * NE + (size_t)c0 * NE;
#pragma unroll
        for (int i = 0; i < 16; ++i) Wl[i] = *(const f4*)(wr + 4 * i); }
#define WRT(i, e) Wl[4 * (i) + ((e) >> 2)][(e) & 3]
    f4 ws[3], sh[3];
    { const f4 nw = *(const f4*)(c.norm_ffn_w() + (size_t)l * D + c0);
#pragma unroll
        for (int m = 0; m < 3; ++m) { const float* md = c.MOD() + (size_t)(l * 3 + m) * MODW; sh[m] = *(const f4*)(md + 3 * D + c0); const f4 sc = *(const f4*)(md + 4 * D + c0); ws[m] = nw * (1.0f + sc); } }
#pragma unroll
    for (int m = 0; m < 3; ++m) { float acc[16];
#pragma unroll
        for (int e = 0; e < 16; ++e) acc[e] = sh[m].x * WRT(0, e) + sh[m].y * WRT(1, e) + sh[m].z * WRT(2, e) + sh[m].w * WRT(3, e);
        const float t = rs16(acc, lane); if ((lane & 3) == 0) LB[(m * 8 + w) * 16 + eid] = t; }
    int kk = 0;
    for (int g = blockIdx.x; g < ngroups; g += gridDim.x, kk ^= 1) {
        float* LP = (float*)c.lds + 512 + kk * 2560;
        float* LS = LP + 2176;
        const int row0 = g * gs;
        f4 x[GSM];
#pragma unroll
        for (int r = 0; r < GSM; ++r) if (r < gs) x[r] = *(const f4*)(c.HX() + (size_t)(row0 + r) * D + c0);
#pragma unroll
        for (int r = 0; r < GSM; ++r) if (r < gs) { const int m = modrow(row0 + r); const f4 wsm = m == 0 ? ws[0] : (m == 1 ? ws[1] : ws[2]);
            const f4 xx = x[r], y = xx * wsm; float ss = xx.x * xx.x + xx.y * xx.y + xx.z * xx.z + xx.w * xx.w;
            float acc[16];
#pragma unroll
            for (int e = 0; e < 16; ++e) acc[e] = y.x * WRT(0, e) + y.y * WRT(1, e) + y.z * WRT(2, e) + y.w * WRT(3, e);
            const float t = rs16(acc, lane); ss = wave_sum(ss);
            if ((lane & 3) == 0) LP[(r * 8 + w) * 16 + eid] = t;
            if (lane == 0) LS[r * 8 + w] = ss; }
        __syncthreads();
        float rst = 0.f;
        if (lane < gs) { float sq = 0.f;
#pragma unroll
            for (int q = 0; q < 8; ++q) sq += LS[lane * 8 + q];
            rst = 1.0f / sqrtf(sq * (1.0f / D) + 1e-6f); }
#pragma unroll
        for (int r = 0; r < GSM; ++r) if (r < gs) { const int m = modrow(row0 + r); const f4 wsm = m == 0 ? ws[0] : (m == 1 ? ws[1] : ws[2]), shm = m == 0 ? sh[0] : (m == 1 ? sh[1] : sh[2]);
            const float rs = __int_as_float(__builtin_amdgcn_readlane(__float_as_int(rst), r));
            const f4 v = x[r] * wsm * rs + shm;
            if (((F8MASK) >> l) & 1) *(unsigned*)((unsigned char*)c.NX() + (size_t)(row0 + r) * D + c0) = pk4_fp8(v.x, v.y, v.z, v.w);
            else { u2 o; o.x = pk2(v.x, v.y); o.y = pk2(v.z, v.w); *(u2*)(c.NX() + (size_t)(row0 + r) * D + c0) = o; } }
        { const int r = c.tid >> 4, e = c.tid & 15, rc = r < gs ? r : gs - 1, row = row0 + rc, m = modrow(row);
            float sp = 0.f, sq = 0.f, bs = 0.f;
#pragma unroll
            for (int q = 0; q < 8; ++q) { sp += LP[(rc * 8 + q) * 16 + e]; sq += LS[rc * 8 + q]; bs += LB[(m * 8 + q) * 16 + e]; }
            const float lg = sp * (1.0f / sqrtf(sq * (1.0f / D) + 1e-6f)) + bs;
            float mx = lg; mx = fmaxf(mx, __shfl_xor(mx, 1)); mx = fmaxf(mx, __shfl_xor(mx, 2)); mx = fmaxf(mx, __shfl_xor(mx, 4)); mx = fmaxf(mx, __shfl_xor(mx, 8));
            const float ex = expf(lg - mx); float sum = ex;
            sum += __shfl_xor(sum, 1); sum += __shfl_xor(sum, 2); sum += __shfl_xor(sum, 4); sum += __shfl_xor(sum, 8);
            if (r < gs) c.AFF()[(size_t)e * MROWS + row] = ex / sum; }
    }
#undef WRT
}

__device__ __forceinline__ int block_excl_scan(int v, int* sc, int tid, int& total) {
    const int lane = tid & 63, w = tid >> 6; int x = v;
#pragma unroll
    for (int o = 1; o < 64; o <<= 1) { const int y = __shfl_up(x, o); if (lane >= o) x += y; }
    if (lane == 63) sc[w] = x;
    __syncthreads();
    int woff = 0, tot = 0;
#pragma unroll
    for (int i = 0; i < NWAVES; ++i) { const int t = sc[i]; woff += (i < w) ? t : 0; tot += t; }
    __syncthreads();
    total = tot; return woff + x - v;
}
__device__ __forceinline__ void ph_topk(const Ctx& c, int l) {
    unsigned* keys = (unsigned*)c.lds; unsigned* hist = keys + 4096; unsigned* misc = hist + 256; int* scs = (int*)(misc + 16);
    const int ntask = l == 0 ? 64 : 32, tid = c.tid;
    for (int task = blockIdx.x; task < ntask; task += gridDim.x) {
        const int s = task >> 5, b = (task >> 4) & 1, e = task & 15;
        const int n = s ? CTX : SEQ, cap = s ? 32 : 512, base_row = s ? ML + b * CTX : b * SEQ, slot_base = s ? 1024 + b * 32 : b * 512;
        __syncthreads();
        for (int i = tid; i < n; i += NTHREADS) keys[i] = __float_as_uint(c.AFF()[(size_t)e * MROWS + base_row + i]);
        if (tid == 0) { misc[0] = 0u; misc[1] = (unsigned)cap; }
        unsigned prefix = 0u, mask = 0u;
        for (int shift = 24; shift >= 0; shift -= 8) {
            if (tid < 256) hist[tid] = 0u;
            __syncthreads();
            for (int i = tid; i < n; i += NTHREADS) { const unsigned k = keys[i]; if ((k & mask) == prefix) atomicAdd(&hist[(k >> shift) & 255u], 1u); }
            __syncthreads();
            if (tid < 64) { const unsigned kk = misc[1]; const unsigned h0 = hist[4 * tid], h1 = hist[4 * tid + 1], h2 = hist[4 * tid + 2], h3 = hist[4 * tid + 3];
                const unsigned s4 = h0 + h1 + h2 + h3; unsigned suf = s4;
#pragma unroll
                for (int o = 1; o < 64; o <<= 1) { const unsigned y = __shfl_down(suf, o); if (tid + o < 64) suf += y; }
                const unsigned above = suf - s4;
                if (above < kk && kk <= suf) { unsigned cum = above; int bin;
                    if (cum + h3 >= kk) bin = 3; else { cum += h3; if (cum + h2 >= kk) bin = 2; else { cum += h2; if (cum + h1 >= kk) bin = 1; else { cum += h1; bin = 0; } } }
                    misc[0] = prefix | ((unsigned)(4 * tid + bin) << shift); misc[1] = kk - cum; } }
            __syncthreads();
            prefix = misc[0]; mask |= 255u << shift;
        }
        const unsigned thr = prefix; const int need = (int)misc[1];
        const int ipt = n >= NTHREADS ? n / NTHREADS : 1, i0 = tid * ipt;
        int cg = 0, ce = 0;
        if (i0 < n) for (int i = 0; i < ipt; ++i) { const unsigned k = keys[i0 + i]; cg += k > thr; ce += k == thr; }
        int G, Etot;
        int og = block_excl_scan(cg, scs, tid, G);
        int oe = block_excl_scan(ce, scs, tid, Etot);
        if (i0 < n) for (int i = 0; i < ipt; ++i) { const unsigned k = keys[i0 + i]; int slot = -1;
            if (k > thr) slot = og++; else if (k == thr) { if (oe < need) slot = G + oe; ++oe; }
            c.SLOTOF()[(size_t)e * MROWS + base_row + i0 + i] = slot >= 0 ? slot_base + slot : -1;
            if (slot >= 0) { c.IDX()[e * ESLOT + slot_base + slot] = base_row + i0 + i; c.GATEV()[e * ESLOT + slot_base + slot] = __uint_as_float(k); } }
    }
}

__device__ __forceinline__ void ph_gather(const Ctx& c, int l) {
    const int nsl = l == 0 ? 1088 : 1024, ntask = NE * nsl;
    const bool f8 = ((F8MASK) >> l) & 1;
    for (int task = c.gw; task < ntask; task += c.ngw) { const int e = task / nsl, slot = task % nsl; const int tok = c.IDX()[e * ESLOT + slot];
        if (!f8) { const u4* src = (const u4*)(c.NX() + (size_t)tok * D); u4* dst = (u4*)(c.AMOE() + ((size_t)e * ESLOT + slot) * D);
#pragma unroll
            for (int j = 0; j < 4; ++j) dst[c.lane + 64 * j] = src[c.lane + 64 * j]; }
        else { const u4* src = (const u4*)((const unsigned char*)c.NX() + (size_t)tok * D) + 2 * c.lane;
            const u4 r0 = src[0], r1 = src[1];
            u4* dst = (u4*)((unsigned char*)c.AMOE() + ((size_t)e * ESLOT + slot) * D) + 2 * c.lane;
            dst[0] = r0; dst[1] = r1; } }
}

__device__ __forceinline__ void ph_final(const Ctx& c) {
    const int lane = c.lane;
    for (int row = c.gw; row < ML; row += c.ngw) {
        const float* xr = c.HX() + (size_t)row * D;
        f4 v[8]; float ss = 0.f;
#pragma unroll
        for (int j = 0; j < 8; ++j) v[j] = *(const f4*)(xr + 4 * lane + 256 * j);
        moe_combine_row(c, 1, row, lane, v);
#pragma unroll
        for (int j = 0; j < 8; ++j) ss += v[j].x * v[j].x + v[j].y * v[j].y + v[j].z * v[j].z + v[j].w * v[j].w;
        ss = wave_sum(ss);
        const float rstd = 1.0f / sqrtf(ss * (1.0f / D) + 1e-6f);
#pragma unroll
        for (int j = 0; j < 8; ++j) { const int col = 4 * lane + 256 * j; *(f4*)(c.out() + (size_t)row * D + col) = v[j] * rstd * *(const f4*)(c.final_norm_w() + col); }
    }
#if defined(TPROBE)
    if (TPROBE >= 0) { __syncthreads(); if (blockIdx.x == 0 && c.tid == 0) { asm volatile("s_waitcnt vmcnt(0)" ::: "memory"); c.out()[0] = 20480.0f * (float)(c.ctl()[CW_TP + 64 * TPROBE] >> 11); } }
#endif
}

typedef short bf16x8 __attribute__((ext_vector_type(8)));
#define RAW_BAR() do { asm volatile("s_waitcnt lgkmcnt(0)" ::: "memory"); __builtin_amdgcn_s_barrier(); asm volatile("" ::: "memory"); } while (0)
#define MFMA16(a, b, c) __builtin_amdgcn_mfma_f32_16x16x32_bf16((a), (b), (c), 0, 0, 0)
__device__ __forceinline__ bf16x8 ldfrag(const LAS unsigned char* base, int stride, int row0, int ks, int lane) {
    return *(const LAS bf16x8*)(base + (row0 + (lane & 15)) * stride + ks * 64 + (lane >> 4) * 16);
}
__device__ __forceinline__ int blk_row0(int b, int blk) { return blk < 4 ? ML + b * CTX + blk * 64 : b * SEQ + (blk - 4) * 64; }
__device__ __forceinline__ int scan_blk(int s, int dir) { return s < 4 ? (dir ? 3 - s : s) : (dir ? 71 - s : s); }

__device__ __forceinline__ void gla_tiles_unit(const Ctx& c, int lsel, int ud);
__device__ __forceinline__ void ph_gdn_chunk(const Ctx& c, int l) {
    LAS unsigned char* L = (LAS unsigned char*)c.lds;
    constexpr int O_D = 0, O_MO = 8192, O_A = 26624, O_G = 45056, O_R1 = 47104, O_SOL = 83968;
    const bf16* GQ = c.GQKVb(); const float* GG = c.GGB();
    LAS float* gcf = (LAS float*)(L + O_G); LAS float* gcb = gcf + 64; LAS float* btf = gcf + 128; LAS float* btb = gcf + 192; LAS float* egf = gcf + 256; LAS float* egb = gcf + 320;
    __syncthreads();
    { const int tid = c.tid;
    for (int i = tid; i < 73728 / 16; i += NTHREADS) *(LAS u4*)(L + O_SOL + i * 16) = (u4){0u, 0u, 0u, 0u}; }
    int* qsh = (int*)(c.lds + MISC_OFF + 64);
    unsigned* qhead = c.ctl() + CW_CHQ + 64 * (l + 2 * c.rep);
    int nxt = 0; if (c.tid == 0) nxt = (int)atomicAdd(qhead, 1u);
    for (;;) {
        __syncthreads();
        if (c.tid == 0) *qsh = nxt;
        __syncthreads();
        const int unit = __builtin_amdgcn_readfirstlane(*qsh);
        if (unit >= 544 + 1088) break;
        if (unit >= 544 && c.tid == 0) nxt = (int)atomicAdd(qhead, 1u);
        if (unit >= 544) { const int uu = unit - 544, bhq = (uu >> 1) / 68, blq = (uu >> 1) % 68; gla_tiles_unit(c, l, (bhq * UDS + blq) * 2 + (uu & 1)); continue; }
        const int bh = unit / 68, blk = unit % 68, b = bh >> 2, h = bh & 3, row0 = blk_row0(b, blk);
        int tid = c.tid; asm volatile("" : "+v"(tid));
        const int lane = tid & 63, w = __builtin_amdgcn_readfirstlane(tid >> 6);
        for (int idx = tid; idx < 2048; idx += NTHREADS) { const int t = idx >> 5, d4 = (idx & 31) * 4; const bf16* src = GQ + (size_t)(row0 + t) * 1536 + h * 128 + d4;
            const u2 qo = *(const u2*)src, ko = *(const u2*)(src + 512);
            *(LAS u2*)(L + O_R1 + t * 272 + d4 * 2) = ko; *(LAS u2*)(L + O_R1 + 17408 + t * 272 + d4 * 2) = qo; }
        if (w == 0) { const float* gp = GG + (size_t)(row0 + lane) * 16; float a = gp[h], bq = gp[4 + h];
#pragma unroll
            for (int o = 1; o < 64; o <<= 1) { const float y = __shfl_up(a, o); if (lane >= o) a += y; const float z = __shfl_down(bq, o); if (lane + o < 64) bq += z; }
            gcf[lane] = a; gcb[lane] = bq; btf[lane] = gp[8 + h]; btb[lane] = gp[12 + h]; egf[lane] = __expf(a); egb[lane] = __expf(bq); }
        const int sdir = tid >> 8, scol = tid & 255;
        const bf16* rp = GQ + (size_t)row0 * 1536 + (scol < 128 ? 1024 + h * 128 + scol : 512 + h * 128 + (scol - 128));
        __syncthreads();
        {
            const int which = w >> 2, tt = w & 3;
            const LAS unsigned char* Ab = L + O_R1 + (which ? 17408 : 0);
            const int t = tt * 16 + (lane & 15); const float gft = gcf[t], gbt = gcb[t], bft = btf[t], bbt = btb[t];
            bf16x8 ga[4], gb[4][4];
#pragma unroll
            for (int ks = 0; ks < 4; ++ks) { ga[ks] = ldfrag(Ab, 272, tt * 16, ks, lane);
#pragma unroll
                for (int st = 0; st < 4; ++st) gb[st][ks] = ldfrag(L + O_R1, 272, st * 16, ks, lane); }
            __builtin_amdgcn_sched_barrier(0);
#pragma unroll
            for (int st = 0; st < 4; ++st) {
                f32x4 acc = {0.f, 0.f, 0.f, 0.f};
#pragma unroll
                for (int ks = 0; ks < 4; ++ks) acc = MFMA16(gb[st][ks], ga[ks], acc);
                const int s0 = st * 16 + (lane >> 4) * 4;
                if (which == 0) { float mf[4], mb[4];
#pragma unroll
                    for (int j = 0; j < 4; ++j) { const int s = s0 + j; mf[j] = s < t ? bft * acc[j] * __expf(gft - gcf[s]) : 0.f; mb[j] = s > t ? bbt * acc[j] * __expf(gbt - gcb[s]) : 0.f; }
                    if (st == tt) { *(LAS f4*)(L + O_D + ((tt * 16 + (lane & 15)) * 16 + (lane >> 4) * 4) * 4) = (f4){mf[0], mf[1], mf[2], mf[3]};
                                    *(LAS f4*)(L + O_D + 4096 + ((tt * 16 + (lane & 15)) * 16 + (lane >> 4) * 4) * 4) = (f4){mb[0], mb[1], mb[2], mb[3]};
#pragma unroll
                                    for (int j = 0; j < 4; ++j) { mf[j] = 0.f; mb[j] = 0.f; } }
                    u2 of, ob; of.x = pk2(mf[0], mf[1]); of.y = pk2(mf[2], mf[3]); ob.x = pk2(mb[0], mb[1]); ob.y = pk2(mb[2], mb[3]);
                    *(LAS u2*)(L + O_MO + t * 144 + s0 * 2) = of; *(LAS u2*)(L + O_MO + 9216 + t * 144 + s0 * 2) = ob; }
                else { float vf[4], vb[4];
#pragma unroll
                    for (int j = 0; j < 4; ++j) { const int s = s0 + j; vf[j] = s <= t ? acc[j] * __expf(gft - gcf[s]) : 0.f; vb[j] = s >= t ? acc[j] * __expf(gbt - gcb[s]) : 0.f; }
                    u2 of, ob; of.x = pk2(vf[0], vf[1]); of.y = pk2(vf[2], vf[3]); ob.x = pk2(vb[0], vb[1]); ob.y = pk2(vb[2], vb[3]);
                    *(LAS u2*)(L + O_A + t * 144 + s0 * 2) = of; *(LAS u2*)(L + O_A + 9216 + t * 144 + s0 * 2) = ob; }
            }
        }
        __syncthreads();
        {
            const LAS float* btx = sdir ? btb : btf; const LAS float* egx = sdir ? egb : egf;
            LAS unsigned char* sp = L + O_SOL + (sdir * 256 + scol) * 144;
            const int mdir = w >> 2, mq = w & 3;
float rhn[16];
            { const int q0 = sdir ? 3 : 0;
#pragma unroll
                for (int ii = 0; ii < 16; ++ii) rhn[ii] = bf2f(rp[(size_t)(16 * q0 + ii) * 1536]); }
#define GDN_ROUND(RR) { constexpr int R = RR; \
                constexpr int qf = R, qb = 3 - R; \
                if constexpr (R > 0) { \
                    const int q = mdir ? qb : qf; \
                    const LAS unsigned char* Mo = L + O_MO + mdir * 9216; const LAS unsigned char* So = L + O_SOL + mdir * 36864; \
                    const bf16x8 m0 = ldfrag(Mo, 144, q * 16, 0, lane), m1 = ldfrag(Mo, 144, q * 16, 1, lane); \
                    _Pragma("unroll") for (int ct = 0; ct < 4; ++ct) { const int ctile = mq * 4 + ct; f32x4 acc = {0.f, 0.f, 0.f, 0.f}; \
                        acc = MFMA16(m0, ldfrag(So, 144, ctile * 16, 0, lane), acc); acc = MFMA16(m1, ldfrag(So, 144, ctile * 16, 1, lane), acc); \
                        *(LAS f32x4*)(L + O_R1 + ((mdir * 256 + ctile * 16 + (lane & 15)) * 16 + (lane >> 4) * 4) * 4) = acc; } \
                    __syncthreads(); \
                } \
                const int q = sdir ? qb : qf; \
                float x[16]; \
                _Pragma("unroll") for (int ii = 0; ii < 16; ++ii) { const int t = 16 * q + ii; float v = rhn[ii] * btx[t]; if (scol >= 128) v *= egx[t]; x[ii] = v; } \
                if constexpr (R < 3) { const int qn = sdir ? qb - 1 : qf + 1; _Pragma("unroll") for (int ii = 0; ii < 16; ++ii) rhn[ii] = bf2f(rp[(size_t)(16 * qn + ii) * 1536]); } \
                if constexpr (R > 0) { const LAS f4* cb = (const LAS f4*)(L + O_R1 + (sdir * 256 + scol) * 64); \
                    _Pragma("unroll") for (int i4 = 0; i4 < 4; ++i4) { const f4 cv = cb[i4]; x[4 * i4] -= cv.x; x[4 * i4 + 1] -= cv.y; x[4 * i4 + 2] -= cv.z; x[4 * i4 + 3] -= cv.w; } } \
                const LAS float* Dp = (const LAS float*)(L + O_D + sdir * 4096) + q * 256; \
                if (sdir == 0) { \
                    _Pragma("unroll") for (int ii = 1; ii < 16; ++ii) { float a = x[ii]; \
                        _Pragma("unroll") for (int j4 = 0; j4 < 16; j4 += 4) if (j4 < ii) { const f4 m = *(const LAS f4*)(Dp + ii * 16 + j4); \
                            _Pragma("unroll") for (int jj = 0; jj < 4; ++jj) if (j4 + jj < ii) a -= m[jj] * x[j4 + jj]; } \
                        x[ii] = a; } \
                } else { \
                    _Pragma("unroll") for (int ii = 14; ii >= 0; --ii) { float a = x[ii]; \
                        _Pragma("unroll") for (int j4 = 0; j4 < 16; j4 += 4) if (j4 + 3 > ii) { const f4 m = *(const LAS f4*)(Dp + ii * 16 + j4); \
                            _Pragma("unroll") for (int jj = 0; jj < 4; ++jj) if (j4 + jj > ii) a -= m[jj] * x[j4 + jj]; } \
                        x[ii] = a; } \
                } \
                u4 o0, o1; o0.x = pk2(x[0], x[1]); o0.y = pk2(x[2], x[3]); o0.z = pk2(x[4], x[5]); o0.w = pk2(x[6], x[7]); o1.x = pk2(x[8], x[9]); o1.y = pk2(x[10], x[11]); o1.z = pk2(x[12], x[13]); o1.w = pk2(x[14], x[15]); \
                *(LAS u4*)(sp + q * 32) = o0; *(LAS u4*)(sp + q * 32 + 16) = o1; \
                __syncthreads(); \
            }
            GDN_ROUND(0) GDN_ROUND(1) GDN_ROUND(2) GDN_ROUND(3)
#undef GDN_ROUND
        }
        if (c.tid == 0) nxt = (int)atomicAdd(qhead, 1u);
        for (int idx = tid; idx < 4096; idx += NTHREADS) { const int dir = idx >> 11, t = (idx >> 5) & 63, d4 = (idx & 31) * 4;
            const u2 kr = *(const u2*)(GQ + (size_t)(row0 + t) * 1536 + 512 + h * 128 + d4); const f4 kv = {bf2f(kr.x & 0xffffu), bf2f(kr.x >> 16), bf2f(kr.y & 0xffffu), bf2f(kr.y >> 16)};
            const float sc = dir ? __expf(gcb[0] - gcb[t]) : __expf(gcf[63] - gcf[t]);
            LAS bf16* dst = (LAS bf16*)(L + O_R1 + dir * 18432) + t;
            dst[(d4 + 0) * 72] = (bf16)f2bf(kv.x * sc); dst[(d4 + 1) * 72] = (bf16)f2bf(kv.y * sc); dst[(d4 + 2) * 72] = (bf16)f2bf(kv.z * sc); dst[(d4 + 3) * 72] = (bf16)f2bf(kv.w * sc); }
        __syncthreads();
        {
            const int dir = w >> 2, wq = w & 3, ud = (bh * UDS + blk) * 2 + dir;
            const LAS unsigned char* Aa = L + O_A + dir * 9216; const LAS unsigned char* SolU = L + O_SOL + dir * 256 * 144; const LAS unsigned char* SolW = SolU + 128 * 144;
            const LAS unsigned char* Kd = L + O_R1 + dir * 18432;
            const LAS float* egx = dir ? egb : egf;
            const bf16x8 a0 = ldfrag(Aa, 144, wq * 16, 0, lane), a1 = ldfrag(Aa, 144, wq * 16, 1, lane);
            const int t = wq * 16 + (lane & 15); const float eg = egx[t];
            bf16* qp = c.GDQP() + (size_t)ud * 8192 + ((size_t)(wq * 4) * 64 + (lane & 15) + 16 * (lane >> 5)) * 8 + ((lane >> 4) & 1) * 4; bf16* o0 = c.GDO0() + ((size_t)ud * 64 + t) * 128 + (lane >> 4) * 4;
            const bf16* qsrc = GQ + (size_t)(row0 + t) * 1536 + h * 128 + (lane >> 4) * 4;
            const bf16x8 kd[2][2] = {{ldfrag(Kd, 144, (2 * wq) * 16, 0, lane), ldfrag(Kd, 144, (2 * wq) * 16, 1, lane)}, {ldfrag(Kd, 144, (2 * wq + 1) * 16, 0, lane), ldfrag(Kd, 144, (2 * wq + 1) * 16, 1, lane)}};
            {
                bf16x8 fw[8][2];
#pragma unroll
                for (int nt = 0; nt < 8; ++nt) { fw[nt][0] = ldfrag(SolW, 144, nt * 16, 0, lane); fw[nt][1] = ldfrag(SolW, 144, nt * 16, 1, lane); }
                __builtin_amdgcn_sched_barrier(0);
#pragma unroll
                for (int nt = 0; nt < 8; ++nt) { f32x4 acc = {0.f, 0.f, 0.f, 0.f};
                    acc = MFMA16(fw[nt][0], a0, acc); acc = MFMA16(fw[nt][1], a1, acc);
                    const u2 qr = *(const u2*)(qsrc + nt * 16); const f4 qv = {bf2f(qr.x & 0xffffu), bf2f(qr.x >> 16), bf2f(qr.y & 0xffffu), bf2f(qr.y >> 16)};
                    u2 o; o.x = pk2(qv.x * eg - acc[0], qv.y * eg - acc[1]); o.y = pk2(qv.z * eg - acc[2], qv.w * eg - acc[3]);
                    *(u2*)(qp + ((nt >> 1) * 64 + 32 * (nt & 1)) * 8) = o; }
#pragma unroll
                for (int dt2 = 0; dt2 < 2; ++dt2) { const int dtile = 2 * wq + dt2;
                    bf16* ap = c.GDAP() + (size_t)ud * 16384 + ((size_t)(dtile * 4) * 64 + (lane & 15) + 16 * (lane >> 5)) * 8 + ((lane >> 4) & 1) * 4;
#pragma unroll
                    for (int nt = 0; nt < 8; ++nt) { f32x4 acc = {0.f, 0.f, 0.f, 0.f};
                        acc = MFMA16(fw[nt][0], kd[dt2][0], acc); acc = MFMA16(fw[nt][1], kd[dt2][1], acc);
                        u2 o; o.x = pk2(-acc[0], -acc[1]); o.y = pk2(-acc[2], -acc[3]); *(u2*)(ap + ((nt >> 1) * 64 + 32 * (nt & 1)) * 8) = o; } }
            }
            {
                bf16x8 fu[8][2];
                __builtin_amdgcn_sched_barrier(0);
#pragma unroll
                for (int nt = 0; nt < 8; ++nt) { fu[nt][0] = ldfrag(SolU, 144, nt * 16, 0, lane); fu[nt][1] = ldfrag(SolU, 144, nt * 16, 1, lane); }
                __builtin_amdgcn_sched_barrier(0);
#pragma unroll
                for (int nt = 0; nt < 8; ++nt) { f32x4 acc = {0.f, 0.f, 0.f, 0.f};
                    acc = MFMA16(fu[nt][0], a0, acc); acc = MFMA16(fu[nt][1], a1, acc);
                    u2 ob; ob.x = pk2(acc[0], acc[1]); ob.y = pk2(acc[2], acc[3]); *(u2*)(o0 + nt * 16) = ob; }
#pragma unroll
                for (int dt2 = 0; dt2 < 2; ++dt2) { const int dtile = 2 * wq + dt2;
                    bf16* bm = c.GDBM() + ((size_t)ud * 128 + (lane & 15)) * 128 + dtile * 16 + (lane >> 4) * 4;
#pragma unroll
                    for (int nt = 0; nt < 8; ++nt) { f32x4 acc = {0.f, 0.f, 0.f, 0.f};
                        acc = MFMA16(kd[dt2][0], fu[nt][0], acc); acc = MFMA16(kd[dt2][1], fu[nt][1], acc);
                        u2 bb; bb.x = pk2(acc[0], acc[1]); bb.y = pk2(acc[2], acc[3]); *(u2*)(bm + (size_t)nt * 16 * 128) = bb; } }
            }
            if ((tid & 255) == 0) c.GDGL()[ud] = dir ? egb[0] : egf[63];
        }
    }
}

struct GdnSet { bf16x8 fa[4]; u2 bm[2]; float gl; };
__device__ __forceinline__ f32x4 bf4_to_f32(u2 v) { return (f32x4){bf2f(v.x & 0xffffu), bf2f(v.x >> 16), bf2f(v.y & 0xffffu), bf2f(v.y >> 16)}; }
template <int MODE> __device__ __forceinline__ void gdn_scan2(const Ctx& c, int b, int h, int dir, int eq) {
    LAS unsigned char* L = (LAS unsigned char*)c.lds;
    constexpr int O_ST = 0, STB = 32 * 272;
    int tid = c.tid; asm volatile("" : "+v"(tid));
    const int lane = tid & 63, w = __builtin_amdgcn_readfirstlane(tid >> 6);
    f32x4 S[2];
    S[0] = (f32x4){0.f, 0.f, 0.f, 0.f}; S[1] = S[0];
    __syncthreads();
    for (int i = tid; i < 2 * STB / 16; i += NTHREADS) *(LAS u4*)(L + O_ST + i * 16) = (u4){0u, 0u, 0u, 0u};
    const int udb = (b * 4 + h) * UDS;
    const int gst_off = ((eq * 2 * 4 + (w >> 1)) * 64 + (lane & 15) + 16 * ((w & 1) * 2 + (lane >> 5))) * 8 + ((lane >> 4) & 1) * 4;
    { bf16* g0 = c.GDST() + (size_t)((udb + scan_blk(0, dir)) * 2 + dir) * 16384 + gst_off; *(u2*)g0 = (u2){0u, 0u}; *(u2*)(g0 + 4 * 64 * 8) = (u2){0u, 0u}; }
    GdnSet s0, s1, s2, s3, s4;
    int vzero = 0; asm volatile("" : "+v"(vzero));
#define GDN_LOAD(SET, sn) { const int udn = (udb + scan_blk((sn), dir)) * 2 + dir; \
        const bf16* ga = c.GDAP() + (size_t)udn * 16384 + ((size_t)(w * 4) * 64 + lane) * 8; \
        _Pragma("unroll") for (int ks = 0; ks < 4; ++ks) SET.fa[ks] = *(const bf16x8*)(ga + ks * 512); \
        const bf16* bmn = c.GDBM() + ((size_t)udn * 128 + eq * 32 + (lane & 15)) * 128 + w * 16 + (lane >> 4) * 4; \
        SET.bm[0] = *(const u2*)bmn; SET.bm[1] = *(const u2*)(bmn + 16 * 128); \
        SET.gl = c.GDGL()[udn + vzero]; }
#define GDN_STEP(s, SET) { const int buf = (s) & 1; \
        S[0] = S[0] * SET.gl + bf4_to_f32(SET.bm[0]); S[1] = S[1] * SET.gl + bf4_to_f32(SET.bm[1]); \
        RAW_BAR(); \
        const LAS unsigned char* ST = L + O_ST + buf * STB; \
        bf16x8 fs[2][4]; \
        _Pragma("unroll") for (int ks = 0; ks < 4; ++ks) { fs[0][ks] = ldfrag(ST, 272, 0, ks, lane); fs[1][ks] = ldfrag(ST, 272, 16, ks, lane); } \
        __builtin_amdgcn_sched_barrier(0); asm volatile("s_waitcnt lgkmcnt(0)" ::: "memory"); __builtin_amdgcn_sched_barrier(0); \
        _Pragma("unroll") for (int ks = 0; ks < 4; ++ks) { S[0] = MFMA16(SET.fa[ks], fs[0][ks], S[0]); S[1] = MFMA16(SET.fa[ks], fs[1][ks], S[1]); } \
        if (MODE == 0 || MODE == 2) GDN_LOAD(SET, ((s) + 5 < 68 ? (s) + 5 : 67)) \
        { bf16* gn = c.GDST() + (size_t)((udb + scan_blk(((s) + 1 < 68 ? (s) + 1 : 67), dir)) * 2 + dir) * 16384 + gst_off; \
          _Pragma("unroll") for (int et = 0; et < 2; ++et) { u2 o; o.x = pk2(S[et][0], S[et][1]); o.y = pk2(S[et][2], S[et][3]); \
            *(LAS u2*)(L + O_ST + (buf ^ 1) * STB + (et * 16 + (lane & 15)) * 272 + (w * 16 + (lane >> 4) * 4) * 2) = o; \
            if ((MODE == 0 || MODE == 3) && (s) + 1 < 68) *(u2*)(gn + et * 4 * 64 * 8) = o; } } }
    GDN_LOAD(s0, 0) GDN_LOAD(s1, 1) GDN_LOAD(s2, 2) GDN_LOAD(s3, 3) GDN_LOAD(s4, 4)
    for (int s = 0; s < 65; s += 5) { GDN_STEP(s, s0) GDN_STEP(s + 1, s1) GDN_STEP(s + 2, s2) GDN_STEP(s + 3, s3) GDN_STEP(s + 4, s4) }
    GDN_STEP(65, s0) GDN_STEP(66, s1) GDN_STEP(67, s2)
#undef GDN_LOAD
#undef GDN_STEP
}

__device__ __forceinline__ void gdn_out_unit(const Ctx& c, int l, int b, int h, int blk) {
    int tid = c.tid; asm volatile("" : "+v"(tid));
    const int lane = tid & 63, w = __builtin_amdgcn_readfirstlane(tid >> 6);
    const int tt = w & 3, ehh = w >> 2, t = tt * 16 + (lane & 15), row = blk_row0(b, blk) + t;
    float* red = (float*)c.lds;
    f32x4 acc[4];
#pragma unroll
    for (int i = 0; i < 4; ++i) acc[i] = (f32x4){0.f, 0.f, 0.f, 0.f};
#pragma unroll
    for (int dir = 0; dir < 2; ++dir) { const size_t ud = (size_t)(((b * 4 + h) * UDS + blk) * 2 + dir);
        const bf16* gq = c.GDQP() + ud * 8192 + ((size_t)(tt * 4) * 64 + lane) * 8;
        bf16x8 qf[4], sf[4][4]; u2 o0v[4];
#pragma unroll
        for (int ks = 0; ks < 4; ++ks) qf[ks] = *(const bf16x8*)(gq + ks * 512);
#pragma unroll
        for (int e4 = 0; e4 < 4; ++e4) { const int etile = ehh * 4 + e4; const bf16* gs = c.GDST() + ud * 16384 + ((size_t)(etile * 4) * 64 + lane) * 8;
            o0v[e4] = *(const u2*)(c.GDO0() + (ud * 64 + t) * 128 + etile * 16 + (lane >> 4) * 4);
#pragma unroll
            for (int ks = 0; ks < 4; ++ks) sf[e4][ks] = *(const bf16x8*)(gs + ks * 512); }
        __builtin_amdgcn_sched_barrier(0);
#pragma unroll
        for (int e4 = 0; e4 < 4; ++e4) { acc[e4] += bf4_to_f32(o0v[e4]);
#pragma unroll
            for (int ks = 0; ks < 4; ++ks) acc[e4] = MFMA16(sf[e4][ks], qf[ks], acc[e4]); }
        __builtin_amdgcn_sched_barrier(0); }
    float ss = 0.f;
#pragma unroll
    for (int e4 = 0; e4 < 4; ++e4) ss += acc[e4][0] * acc[e4][0] + acc[e4][1] * acc[e4][1] + acc[e4][2] * acc[e4][2] + acc[e4][3] * acc[e4][3];
    ss += __shfl_xor(ss, 16); ss += __shfl_xor(ss, 32);
    __syncthreads();
    if (lane < 16) red[ehh * 64 + t] = ss;
    __syncthreads();
    const float rstd = 1.0f / sqrtf((red[t] + red[64 + t]) * (1.0f / 128.f) + 1e-6f);
    const float* nw = c.gdn_norm_w() + l * 128;
#pragma unroll
    for (int e4 = 0; e4 < 4; ++e4) { const int e0 = (ehh * 4 + e4) * 16 + (lane >> 4) * 4;
        const u2 zr = *(const u2*)(c.P() + (size_t)row * NP + PC_GDZ + h * 128 + e0); const f32x4 z = bf4_to_f32(zr); const f4 nv = *(const f4*)(nw + e0);
        u2 o; o.x = pk2(acc[e4][0] * rstd * nv.x * silu_f(z[0]), acc[e4][1] * rstd * nv.y * silu_f(z[1])); o.y = pk2(acc[e4][2] * rstd * nv.z * silu_f(z[2]), acc[e4][3] * rstd * nv.w * silu_f(z[3]));
        *(u2*)(c.CAT() + (size_t)row * D + 1536 + h * 128 + e0) = o; }
}
__device__ __forceinline__ void gla_out_unit(const Ctx& c, int l, int b, int h, int blk);
__device__ __forceinline__ void ph_combine2(const Ctx& c, int l) {
    const int nb = l == 0 ? 68 : 64, nunit = 8 * nb;
    for (int u = blockIdx.x; u < 2 * nunit; u += gridDim.x) { const int kind = u >= nunit, uu = kind ? u - nunit : u, bh = uu / nb, blk = (uu % nb) + (68 - nb);
        if (kind == 0) gdn_out_unit(c, l, bh >> 2, bh & 3, blk); else gla_out_unit(c, l, bh >> 2, bh & 3, blk); }
}

__device__ __forceinline__ void gla_scan2(const Ctx& c, int b, int h, int dir, int eh) {
    LAS unsigned char* L = (LAS unsigned char*)c.lds;
    constexpr int O_QT = 0, O_KT = 9216, O_KH = 18432, O_VT = 27648, O_ATT = 36864, O_ST = 46080, O_CP = 64512, O_DEC = O_CP + 2048;
    const int tid = c.tid, lane = c.lane, w = c.wave, d = tid & 63, part = tid >> 6;
    LAS float* CP = (LAS float*)(L + O_CP); LAS float* DEC = (LAS float*)(L + O_DEC);
    const float* LQp = c.LQ(); const float* LKp = c.LK(); const float* LAp = c.LA() + (size_t)dir * MROWS * 256; const bf16* Pp = c.P();
    f32x4 S[2];
    S[0] = (f32x4){0.f, 0.f, 0.f, 0.f}; S[1] = S[0];
    __syncthreads();
    for (int i = tid; i < 9216 / 16; i += NTHREADS) *(LAS u4*)(L + O_ST + i * 16) = (u4){0u, 0u, 0u, 0u};
    float la[8], qv[8], kv[8]; unsigned vv[8];
    { const int row0 = blk_row0(b, scan_blk(0, dir));
#pragma unroll
        for (int ii = 0; ii < 8; ++ii) { const int i = part * 8 + ii, row = row0 + (dir ? 63 - i : i);
            la[ii] = LAp[(size_t)row * 256 + h * 64 + d]; qv[ii] = LQp[(size_t)row * 256 + h * 64 + d]; kv[ii] = LKp[(size_t)row * 256 + h * 64 + d]; vv[ii] = Pp[(size_t)row * NP + PC_GLV + h * 128 + eh * 64 + d]; } }
    for (int s = 0; s < 68; ++s) {
        const int blk = scan_blk(s, dir), row0 = blk_row0(b, blk), buf = s & 1;
        float p[8]; float run = 0.f;
#pragma unroll
        for (int ii = 0; ii < 8; ++ii) { run += la[ii]; p[ii] = run; }
        CP[part * 64 + d] = run;
        RAW_BAR();
        float off = 0.f, tot = 0.f;
#pragma unroll
        for (int pp = 0; pp < 8; ++pp) { const float xx = CP[pp * 64 + d]; tot += xx; off += (pp < part) ? xx : 0.f; }
        unsigned kh[8];
#pragma unroll
        for (int ii = 0; ii < 8; ++ii) { const float cum = off + p[ii]; const int i = part * 8 + ii;
            *(LAS bf16*)(L + O_QT + i * 144 + d * 2) = (bf16)f2bf(qv[ii] * __expf(cum)); *(LAS bf16*)(L + O_KT + i * 144 + d * 2) = (bf16)f2bf(kv[ii] * __expf(-cum)); kh[ii] = f2bf(kv[ii] * __expf(tot - cum)); }
        { u4 o; o.x = kh[0] | (kh[1] << 16); o.y = kh[2] | (kh[3] << 16); o.z = kh[4] | (kh[5] << 16); o.w = kh[6] | (kh[7] << 16); *(LAS u4*)(L + O_KH + d * 144 + part * 16) = o;
          u4 v; v.x = vv[0] | (vv[1] << 16); v.y = vv[2] | (vv[3] << 16); v.z = vv[4] | (vv[5] << 16); v.w = vv[6] | (vv[7] << 16); *(LAS u4*)(L + O_VT + d * 144 + part * 16) = v; }
        if (part == 0) DEC[d] = __expf(tot);
        if (s + 1 < 68) { const int rown = blk_row0(b, scan_blk(s + 1, dir));
#pragma unroll
            for (int ii = 0; ii < 8; ++ii) { const int i = part * 8 + ii, row = rown + (dir ? 63 - i : i);
                la[ii] = LAp[(size_t)row * 256 + h * 64 + d]; qv[ii] = LQp[(size_t)row * 256 + h * 64 + d]; kv[ii] = LKp[(size_t)row * 256 + h * 64 + d]; vv[ii] = Pp[(size_t)row * NP + PC_GLV + h * 128 + eh * 64 + d]; } }
        RAW_BAR();
        const int tt = w & 3, wh = w >> 2, ti = tt * 16 + (lane & 15);
#pragma unroll
        for (int i2 = 0; i2 < 2; ++i2) { const int st = 2 * wh + i2; f32x4 acc = {0.f, 0.f, 0.f, 0.f};
#pragma unroll
            for (int ks = 0; ks < 2; ++ks) acc = MFMA16(ldfrag(L + O_KT, 144, st * 16, ks, lane), ldfrag(L + O_QT, 144, tt * 16, ks, lane), acc);
            const int s0 = st * 16 + (lane >> 4) * 4;
            u2 o; o.x = pk2(s0 + 0 <= ti ? acc[0] : 0.f, s0 + 1 <= ti ? acc[1] : 0.f); o.y = pk2(s0 + 2 <= ti ? acc[2] : 0.f, s0 + 3 <= ti ? acc[3] : 0.f);
            *(LAS u2*)(L + O_ATT + ti * 144 + s0 * 2) = o; }
        RAW_BAR();
        { const int trow = row0 + (dir ? 63 - ti : ti); float* og = c.OGLA() + ((size_t)dir * MROWS + trow) * 512 + h * 128 + eh * 64 + (lane >> 4) * 4;
            const LAS unsigned char* ST = L + O_ST + buf * 9216;
#pragma unroll
            for (int i2 = 0; i2 < 2; ++i2) { const int et = 2 * wh + i2; f32x4 acc = {0.f, 0.f, 0.f, 0.f};
#pragma unroll
                for (int ks = 0; ks < 2; ++ks) acc = MFMA16(ldfrag(L + O_VT, 144, et * 16, ks, lane), ldfrag(L + O_ATT, 144, tt * 16, ks, lane), acc);
#pragma unroll
                for (int ks = 0; ks < 2; ++ks) acc = MFMA16(ldfrag(ST, 144, et * 16, ks, lane), ldfrag(L + O_QT, 144, tt * 16, ks, lane), acc);
                *(f32x4*)(og + et * 16) = acc; }
            const f4 dec = *(const LAS f4*)(DEC + tt * 16 + (lane >> 4) * 4);
#pragma unroll
            for (int i2 = 0; i2 < 2; ++i2) { const int et = 2 * wh + i2; S[i2] = S[i2] * dec;
#pragma unroll
                for (int ks = 0; ks < 2; ++ks) S[i2] = MFMA16(ldfrag(L + O_KH, 144, tt * 16, ks, lane), ldfrag(L + O_VT, 144, et * 16, ks, lane), S[i2]);
                u2 o; o.x = pk2(S[i2][0], S[i2][1]); o.y = pk2(S[i2][2], S[i2][3]);
                *(LAS u2*)(L + O_ST + (buf ^ 1) * 9216 + (et * 16 + (lane & 15)) * 144 + (tt * 16 + (lane >> 4) * 4) * 2) = o; } }
    }
}

__device__ __forceinline__ void gla_tiles_unit(const Ctx& c, int lsel, int ud) {
    LAS unsigned char* L = (LAS unsigned char*)c.lds;
    constexpr int O_QT = 0, O_KT = 9216, O_KH = 18432, O_VT = 27648, O_CP = 46080;
    int tid = c.tid; asm volatile("" : "+v"(tid));
    const int d = tid & 63, part = tid >> 6;
    const int dir = ud & 1, blk = (ud >> 1) % UDS, bh = (ud >> 1) / UDS, b = bh >> 2, h = bh & 3, row0 = blk_row0(b, blk);
    LAS float* CP = (LAS float*)(L + O_CP);
    const bf16* Pp = c.P();
    float la[8], qv[8], kv[8];
    { const float* gwp = c.gla_gate_w() + ((size_t)(lsel * 2 + dir) * 16) * 256 + h * 64 + d; const float gbias = c.gla_gate_b()[(size_t)(lsel * 2 + dir) * 256 + h * 64 + d];
        float gwv[16];
#pragma unroll
        for (int r = 0; r < 16; ++r) gwv[r] = gwp[(size_t)r * 256];
        const bool latent = blk >= 4; const int half = d >> 5, fi = d & 15; const bool lo = (d & 16) == 0;
        unsigned qraw[8], kraw[8];
        float pva, pvb;
        { const int ia = part * 8 + (d >> 4), ib = ia + 4; pva = c.PS()[(size_t)(row0 + (dir ? 63 - ia : ia)) * 64 + dir * 16 + (d & 15)]; pvb = c.PS()[(size_t)(row0 + (dir ? 63 - ib : ib)) * 64 + dir * 16 + (d & 15)]; }
#pragma unroll
        for (int ii = 0; ii < 8; ++ii) { const int i = part * 8 + ii, row = row0 + (dir ? 63 - i : i);
            qraw[ii] = Pp[(size_t)row * NP + PC_GLQ + h * 64 + d]; kraw[ii] = Pp[(size_t)row * NP + PC_GLK + h * 64 + d]; }
#pragma unroll
        for (int ii = 0; ii < 8; ++ii) { const int i = part * 8 + ii, tk = dir ? 63 - i : i, row = row0 + tk;
            float q = bf2f(qraw[ii]), k = bf2f(kraw[ii]);
            const float qo = __shfl_xor(q, 16), ko = __shfl_xor(k, 16);
            if (latent) { const int t = (blk - 4) * 64 + tk, pos = half ? (t & 63) : (t >> 6); const float cs = c.ROPE()[(pos * 16 + fi) * 2], sn = c.ROPE()[(pos * 16 + fi) * 2 + 1];
                q = lo ? q * cs - qo * sn : q * cs + qo * sn; k = lo ? k * cs - ko * sn : k * cs + ko * sn; }
            qv[ii] = q * 0.125f; kv[ii] = k;
            float z = gbias;
#pragma unroll
            for (int r = 0; r < 16; ++r) z += __int_as_float(__builtin_amdgcn_readlane(__float_as_int(ii < 4 ? pva : pvb), (ii & 3) * 16 + r)) * gwv[r];
            la[ii] = logsigmoid_f(z) * 0.0625f; } }
    unsigned vv[16];
    { const int e = tid & 127, qtr = tid >> 7;
#pragma unroll
        for (int ii = 0; ii < 16; ++ii) { const int i = qtr * 16 + ii, row = row0 + (dir ? 63 - i : i); vv[ii] = Pp[(size_t)row * NP + PC_GLV + h * 128 + e]; } }
    float p[8]; float run = 0.f;
#pragma unroll
    for (int ii = 0; ii < 8; ++ii) { run += la[ii]; p[ii] = run; }
    CP[part * 64 + d] = run;
    __syncthreads();
    float off = 0.f, tot = 0.f;
#pragma unroll
    for (int pp = 0; pp < 8; ++pp) { const float xx = CP[pp * 64 + d]; tot += xx; off += (pp < part) ? xx : 0.f; }
    unsigned kh[8];
#pragma unroll
    for (int ii = 0; ii < 8; ++ii) { const float cum = off + p[ii]; const int i = part * 8 + ii;
        *(LAS bf16*)(L + O_QT + i * 144 + d * 2) = (bf16)f2bf(qv[ii] * __expf(cum)); *(LAS bf16*)(L + O_KT + i * 144 + d * 2) = (bf16)f2bf(kv[ii] * __expf(-cum)); kh[ii] = f2bf(kv[ii] * __expf(tot - cum)); }
    { u4 o; o.x = kh[0] | (kh[1] << 16); o.y = kh[2] | (kh[3] << 16); o.z = kh[4] | (kh[5] << 16); o.w = kh[6] | (kh[7] << 16); *(LAS u4*)(L + O_KH + d * 144 + part * 16) = o; }
    { const int e = tid & 127, qtr = tid >> 7; u4 v0, v1;
        v0.x = vv[0] | (vv[1] << 16); v0.y = vv[2] | (vv[3] << 16); v0.z = vv[4] | (vv[5] << 16); v0.w = vv[6] | (vv[7] << 16);
        v1.x = vv[8] | (vv[9] << 16); v1.y = vv[10] | (vv[11] << 16); v1.z = vv[12] | (vv[13] << 16); v1.w = vv[14] | (vv[15] << 16);
        *(LAS u4*)(L + O_VT + e * 144 + qtr * 32) = v0; *(LAS u4*)(L + O_VT + e * 144 + qtr * 32 + 16) = v1; }
    if (part == 0) c.GLDEC()[(size_t)ud * 64 + d] = __expf(tot);
    __syncthreads();
    { const int f = tid >> 6, lp = tid & 63, r = (f >> 1) * 16 + (lp & 15), kc = (f & 1) * 4 + (lp >> 4);
        *(u4*)(c.GLQT() + (size_t)ud * 4096 + tid * 8) = *(const LAS u4*)(L + O_QT + r * 144 + kc * 16);
        *(u4*)(c.GLKT() + (size_t)ud * 4096 + tid * 8) = *(const LAS u4*)(L + O_KT + r * 144 + kc * 16);
        *(u4*)(c.GLKH() + (size_t)ud * 4096 + tid * 8) = *(const LAS u4*)(L + O_KH + r * 144 + kc * 16);
#pragma unroll
        for (int hh = 0; hh < 2; ++hh) { const int j = tid + 512 * hh, f2 = j >> 6, r2 = (f2 >> 1) * 16 + (lp & 15), kc2 = (f2 & 1) * 4 + (lp >> 4);
            *(u4*)(c.GLVT() + (size_t)ud * 8192 + j * 8) = *(const LAS u4*)(L + O_VT + r2 * 144 + kc2 * 16); } }
}

struct GlaSet { bf16x8 vt[2][2], kh[2]; f4 dec; };
__device__ __forceinline__ void gla_scan3(const Ctx& c, int b, int h, int dir, int eh) {
    int tid = c.tid; asm volatile("" : "+v"(tid));
    const int lane = tid & 63, w = __builtin_amdgcn_readfirstlane(tid >> 6);
    const int tt = w & 3, wh = w >> 2;
    f32x4 S[2];
    S[0] = (f32x4){0.f, 0.f, 0.f, 0.f}; S[1] = S[0];
    const int udb = (b * 4 + h) * UDS;
    const int gst_off = (((eh * 4 + 2 * wh) * 2 + (tt >> 1)) * 64 + (lane & 15) + 16 * ((tt & 1) * 2 + (lane >> 5))) * 8 + ((lane >> 4) & 1) * 4;
    { bf16* g0 = c.GLST() + (size_t)((udb + scan_blk(0, dir)) * 2 + dir) * 8192 + gst_off; *(u2*)g0 = (u2){0u, 0u}; *(u2*)(g0 + 2 * 64 * 8) = (u2){0u, 0u}; }
    GlaSet s0, s1, s2, s3, s4;
#define GLA_LOAD(SET, sn) { const size_t udn = (size_t)((udb + scan_blk((sn), dir)) * 2 + dir); \
        _Pragma("unroll") for (int ks = 0; ks < 2; ++ks) { \
            SET.kh[ks] = *(const bf16x8*)(c.GLKH() + udn * 4096 + ((tt * 2 + ks) * 64 + lane) * 8); \
            _Pragma("unroll") for (int i2 = 0; i2 < 2; ++i2) SET.vt[i2][ks] = *(const bf16x8*)(c.GLVT() + udn * 8192 + (((eh * 4 + 2 * wh + i2) * 2 + ks) * 64 + lane) * 8); } \
        SET.dec = *(const f4*)(c.GLDEC() + udn * 64 + tt * 16 + (lane >> 4) * 4); }
#define GLA_STEP(s, SET) { \
        _Pragma("unroll") for (int i2 = 0; i2 < 2; ++i2) { S[i2] = S[i2] * SET.dec; S[i2] = MFMA16(SET.kh[0], SET.vt[i2][0], S[i2]); S[i2] = MFMA16(SET.kh[1], SET.vt[i2][1], S[i2]); } \
        GLA_LOAD(SET, ((s) + 5 < 68 ? (s) + 5 : 67)) \
        if ((s) + 1 < 68) { bf16* gn = c.GLST() + (size_t)((udb + scan_blk((s) + 1, dir)) * 2 + dir) * 8192 + gst_off; \
            _Pragma("unroll") for (int i2 = 0; i2 < 2; ++i2) { u2 o; o.x = pk2(S[i2][0], S[i2][1]); o.y = pk2(S[i2][2], S[i2][3]); *(u2*)(gn + i2 * 2 * 64 * 8) = o; } } }
    GLA_LOAD(s0, 0) GLA_LOAD(s1, 1) GLA_LOAD(s2, 2) GLA_LOAD(s3, 3) GLA_LOAD(s4, 4)
    for (int s = 0; s < 65; s += 5) { GLA_STEP(s, s0) GLA_STEP(s + 1, s1) GLA_STEP(s + 2, s2) GLA_STEP(s + 3, s3) GLA_STEP(s + 4, s4) }
    GLA_STEP(65, s0) GLA_STEP(66, s1) GLA_STEP(67, s2)
#undef GLA_LOAD
#undef GLA_STEP
}

__device__ __forceinline__ void gla_out_unit(const Ctx& c, int l, int b, int h, int blk) {
    LAS unsigned char* L = (LAS unsigned char*)c.lds;
    constexpr int O_ATT = 0, O_O = 9216, OST = 132;
    int tid = c.tid; asm volatile("" : "+v"(tid));
    const int lane = tid & 63, w = __builtin_amdgcn_readfirstlane(tid >> 6);
    const int tt = w & 3, ehh = w >> 2, ti = tt * 16 + (lane & 15), row0 = blk_row0(b, blk);
    LAS float* Ob = (LAS float*)(L + O_O);
#pragma unroll 1
    for (int dir = 0; dir < 2; ++dir) { const size_t ud = (size_t)(((b * 4 + h) * UDS + blk) * 2 + dir);
        const bf16x8 q0 = *(const bf16x8*)(c.GLQT() + ud * 4096 + ((tt * 2 + 0) * 64 + lane) * 8), q1 = *(const bf16x8*)(c.GLQT() + ud * 4096 + ((tt * 2 + 1) * 64 + lane) * 8);
        __syncthreads();
        bf16x8 vf[4][2], sf[4][2];
#pragma unroll
        for (int e4 = 0; e4 < 4; ++e4) { const int etile = ehh * 4 + e4;
            const bf16* gv = c.GLVT() + ud * 8192 + ((size_t)(etile * 2) * 64 + lane) * 8; const bf16* gs = c.GLST() + ud * 8192 + ((size_t)(etile * 2) * 64 + lane) * 8;
            vf[e4][0] = *(const bf16x8*)gv; vf[e4][1] = *(const bf16x8*)(gv + 512); sf[e4][0] = *(const bf16x8*)gs; sf[e4][1] = *(const bf16x8*)(gs + 512); }
        if (ehh == 0) {
            bf16x8 kf[4][2];
#pragma unroll
            for (int st = 0; st < 4; ++st) { kf[st][0] = *(const bf16x8*)(c.GLKT() + ud * 4096 + ((st * 2 + 0) * 64 + lane) * 8); kf[st][1] = *(const bf16x8*)(c.GLKT() + ud * 4096 + ((st * 2 + 1) * 64 + lane) * 8); }
#pragma unroll
            for (int st = 0; st < 4; ++st) { f32x4 acc = {0.f, 0.f, 0.f, 0.f};
                acc = MFMA16(kf[st][0], q0, acc); acc = MFMA16(kf[st][1], q1, acc);
                const int s0i = st * 16 + (lane >> 4) * 4;
                u2 o; o.x = pk2(s0i + 0 <= ti ? acc[0] : 0.f, s0i + 1 <= ti ? acc[1] : 0.f); o.y = pk2(s0i + 2 <= ti ? acc[2] : 0.f, s0i + 3 <= ti ? acc[3] : 0.f);
                *(LAS u2*)(L + O_ATT + ti * 144 + s0i * 2) = o; } }
        __syncthreads();
        const bf16x8 at0 = ldfrag(L + O_ATT, 144, tt * 16, 0, lane), at1 = ldfrag(L + O_ATT, 144, tt * 16, 1, lane);
        const int tok = dir ? 63 - ti : ti;
#pragma unroll
        for (int e4 = 0; e4 < 4; ++e4) { const int etile = ehh * 4 + e4; f32x4 acc = {0.f, 0.f, 0.f, 0.f};
            acc = MFMA16(vf[e4][0], at0, acc); acc = MFMA16(vf[e4][1], at1, acc);
            acc = MFMA16(sf[e4][0], q0, acc); acc = MFMA16(sf[e4][1], q1, acc);
            LAS float* op = Ob + tok * OST + etile * 16 + (lane >> 4) * 4;
            if (dir == 0) *(LAS f32x4*)op = acc; else { const f32x4 prev = *(LAS f32x4*)op; *(LAS f32x4*)op = prev + acc; } }
    }
    __syncthreads();
    const float* nw = c.gla_norm_w() + l * 128;
    unsigned grv[8];
#pragma unroll
    for (int i = 0; i < 8; ++i) grv[i] = *(const unsigned*)(c.P() + (size_t)(row0 + w * 8 + i) * NP + PC_GLG + h * 128 + 2 * lane);
    const float nw0 = nw[2 * lane], nw1 = nw[2 * lane + 1];
#pragma unroll
    for (int i = 0; i < 8; ++i) { const int tok = w * 8 + i, row = row0 + tok;
        const float o0 = Ob[tok * OST + 2 * lane], o1 = Ob[tok * OST + 2 * lane + 1];
        const float ss = wave_sum(o0 * o0 + o1 * o1);
        const float rstd = 1.0f / sqrtf(ss * (1.0f / 128.f) + 1e-6f);
        const unsigned gr = grv[i];
        *(unsigned*)(c.CAT() + (size_t)row * D + 1024 + h * 128 + 2 * lane) = pk2(o0 * rstd * nw0 * silu_f(bf2f(gr & 0xffffu)), o1 * rstd * nw1 * silu_f(bf2f(gr >> 16))); }
}

__device__ __forceinline__ void ph_scan_na2(const Ctx& c, int l) {
    for (int bt = blockIdx.x; bt < 64; bt += gridDim.x) { const int kind = bt >> 5, dir = (bt >> 4) & 1, b = (bt >> 3) & 1, h = (bt >> 1) & 3, eh = bt & 1;
        if (kind == 0) gla_scan2(c, b, h, dir, eh); else gdn_scan2<0>(c, b, h, dir, eh); }
    __syncthreads();
    const int ntask = ML * 16 + (l == 0 ? MC * 16 : 0), nchunk = ntask / 512;
    int* sh = (int*)(c.lds + MISC_OFF + 64);
    for (;;) {
        __syncthreads();
        if (c.tid == 0) *sh = (int)atomicAdd(c.ctl() + CW_NAQ + 64 * (l + 2 * c.rep), 1u);
        __syncthreads();
        const int ch = *sh;
        if (ch >= nchunk) break;
        for (int i = 0; i < 64; ++i) na_task(c, l, ch * 512 + c.wave * 64 + i, c.lane);
    }
}

__device__ __forceinline__ void na_unit(const Ctx& c, int l, int unit, int& nxt, unsigned* qhead) {
    LAS unsigned char* L = (LAS unsigned char*)c.lds;
    constexpr int VST = 1936, O_VT = 0, O_RPB = 64 * VST + 64, O_KC = O_RPB + 1984, KST = 144, CTXC = 704;
    static_assert(O_KC + 256 * KST <= MISC_OFF, "NA LDS map");
    int tid = c.tid; asm volatile("" : "+v"(tid));
    const int lane = tid & 63, w = __builtin_amdgcn_readfirstlane(tid >> 6);
    const int ql = lane & 15, kg = lane >> 4;
    const bool lat = unit < 512;
    int b, h, r0 = 0, rs0 = 0, nlr = 0, half = 0;
    if (lat) { b = unit >> 8; h = (unit >> 4) & 15; r0 = (unit & 15) * 4; rs0 = min(max(r0 - 4, 0), 56); nlr = min(max(r0 - 1, 0), 56) + 8 - rs0; }
    else { const int u = unit - 512; b = u >> 5; h = (u >> 1) & 15; half = u & 1; }
    const bf16* P = c.P();
    LAS float* RPB = (LAS float*)(L + O_RPB);
    const int g = w & 3;
    int r = lat ? r0 + (w >> 2) : 0;
    int qrow0 = lat ? b * SEQ + r * 64 + 16 * g : ML + b * CTX + half * 128 + w * 16;
    bf16x8 qf0, qf1;
    { const bf16* qp = P + (size_t)(qrow0 + ql) * NP + PC_NAQ + h * 64 + kg * 8; qf0 = *(const bf16x8*)qp; qf1 = *(const bf16x8*)(qp + 32); }
    { const int npl = nlr * 32, npairs = npl + 128;
        u4 va[8], vb[8], kc[4];
#pragma unroll
        for (int it = 0; it < 8; ++it) { const int id = tid + NTHREADS * it, dc = id & 7, pi = id >> 3;
            if (pi < npairs) { const int row = pi < npl ? b * SEQ + rs0 * 64 + 2 * pi : ML + b * CTX + 2 * (pi - npl);
                const bf16* vp = P + (size_t)row * NP + PC_NAV + h * 64 + dc * 8; va[it] = *(const u4*)vp; vb[it] = *(const u4*)(vp + NP); } }
#pragma unroll
        for (int it = 0; it < 4; ++it) { const int id = tid + NTHREADS * it; kc[it] = *(const u4*)(P + (size_t)(ML + b * CTX + (id >> 3)) * NP + PC_NAK + h * 64 + (id & 7) * 8); }
#pragma unroll
        for (int it = 0; it < 8; ++it) { const int id = tid + NTHREADS * it, dc = id & 7, pi = id >> 3;
            if (pi < npairs) { const int col = pi < npl ? 2 * pi : CTXC + 2 * (pi - npl); const u4 a = va[it], bb = vb[it];
                LAS unsigned char* dst = L + O_VT + (dc * 8) * VST + col * 2;
                *(LAS unsigned*)(dst + 0 * VST) = (a.x & 0xffffu) | (bb.x << 16); *(LAS unsigned*)(dst + 1 * VST) = (a.x >> 16) | (bb.x & 0xffff0000u);
                *(LAS unsigned*)(dst + 2 * VST) = (a.y & 0xffffu) | (bb.y << 16); *(LAS unsigned*)(dst + 3 * VST) = (a.y >> 16) | (bb.y & 0xffff0000u);
                *(LAS unsigned*)(dst + 4 * VST) = (a.z & 0xffffu) | (bb.z << 16); *(LAS unsigned*)(dst + 5 * VST) = (a.z >> 16) | (bb.z & 0xffff0000u);
                *(LAS unsigned*)(dst + 6 * VST) = (a.w & 0xffffu) | (bb.w << 16); *(LAS unsigned*)(dst + 7 * VST) = (a.w >> 16) | (bb.w & 0xffff0000u); } }
#pragma unroll
        for (int it = 0; it < 4; ++it) { const int id = tid + NTHREADS * it; *(LAS u4*)(L + O_KC + (id >> 3) * KST + (id & 7) * 16) = kc[it]; }
        if (lat) for (int i = tid; i < 465; i += NTHREADS) RPB[i] = c.na_rpb()[(size_t)(l * 16 + h) * 465 + i] * 1.44269504f; }
    __syncthreads();
#define NA_LOADK(CH, RS) { _Pragma("unroll") for (int tl = 0; tl < 8; ++tl) { const int krow = b * SEQ + ((RS) + 4 * (CH) + (tl >> 1)) * 64 + c0 + 16 * (tl & 1); \
        const unsigned char* kb = (const unsigned char*)(P + (size_t)krow * NP + PC_NAK + h * 64);     \
        kf[tl][0] = *(const bf16x8*)(kb + loff); kf[tl][1] = *(const bf16x8*)(kb + loff + 64); } }
#define NA_QK_G() { _Pragma("unroll") for (int tl = 0; tl < 8; ++tl) { f32x4 acc = {0.f, 0.f, 0.f, 0.f}; acc = MFMA16(kf[tl][0], qf0, acc); acc = MFMA16(kf[tl][1], qf1, acc); S[tl] = acc; } }
#define NA_QK_L(CH) { _Pragma("unroll") for (int hb = 0; hb < 4; ++hb) { bf16x8 kl[2][2]; \
        __builtin_amdgcn_sched_barrier(0); \
        _Pragma("unroll") for (int t4 = 0; t4 < 2; ++t4) { const LAS unsigned char* kp = L + O_KC + (((CH) - 2) * 128 + (hb * 2 + t4) * 16 + ql) * KST + kg * 16; \
            kl[t4][0] = *(const LAS bf16x8*)kp; kl[t4][1] = *(const LAS bf16x8*)(kp + 64); } \
        __builtin_amdgcn_sched_barrier(0); \
        _Pragma("unroll") for (int t4 = 0; t4 < 2; ++t4) { f32x4 acc = {0.f, 0.f, 0.f, 0.f}; acc = MFMA16(kl[t4][0], qf0, acc); acc = MFMA16(kl[t4][1], qf1, acc); S[hb * 2 + t4] = acc; } } }
#define NA_CHUNK(CH, AFTER_QK) { f32x4 S[8]; \
        if ((CH) < 2) NA_QK_G() else NA_QK_L(CH) \
        __builtin_amdgcn_sched_barrier(0); \
        AFTER_QK \
        __builtin_amdgcn_sched_barrier(0); \
        float cm = -INFINITY; \
        _Pragma("unroll") for (int tl = 0; tl < 8; ++tl) _Pragma("unroll") for (int jj = 0; jj < 4; ++jj) { float sv; \
            if ((CH) < 2) { const float bv = rpl[(4 * (CH) + (tl >> 1)) * 31 + 16 * (tl & 1) + jj]; sv = __builtin_fmaf(S[tl][jj], 0.18033688f, vld[(tl & 1) * 4 + jj] ? bv : -INFINITY); } \
            else sv = S[tl][jj] * 0.18033688f; \
            S[tl][jj] = sv; cm = fmaxf(cm, sv); } \
        cm = fmaxf(cm, __shfl_xor(cm, 16)); cm = fmaxf(cm, __shfl_xor(cm, 32)); \
        const float mn = fmaxf(m, cm), alpha = __builtin_amdgcn_exp2f(m - mn); m = mn; \
        lsum *= alpha; \
        _Pragma("unroll") for (int dt = 0; dt < 4; ++dt) O[dt] = O[dt] * alpha; \
        bf16x8 pfr[4]; \
        _Pragma("unroll") for (int s4 = 0; s4 < 4; ++s4) { float p[8]; \
            _Pragma("unroll") for (int jj = 0; jj < 4; ++jj) { p[jj] = __builtin_amdgcn_exp2f(S[2 * s4][jj] - m); p[4 + jj] = __builtin_amdgcn_exp2f(S[2 * s4 + 1][jj] - m); lsum += p[jj] + p[4 + jj]; } \
            u4 pw; pw.x = pk2(p[0], p[1]); pw.y = pk2(p[2], p[3]); pw.z = pk2(p[4], p[5]); pw.w = pk2(p[6], p[7]); \
            pfr[s4] = __builtin_bit_cast(bf16x8, pw); } \
        _Pragma("unroll") for (int sh = 0; sh < 2; ++sh) { bf16x8 vfr[2][4]; \
            __builtin_amdgcn_sched_barrier(0); \
            _Pragma("unroll") for (int s2 = 0; s2 < 2; ++s2) { const int s4 = 2 * sh + s2; \
                const int colA = ((CH) < 2) ? (rs - rs0 + 4 * (CH) + s4) * 64 + c0 + 4 * kg : CTXC + ((CH) - 2) * 128 + 32 * s4 + 4 * kg; \
                _Pragma("unroll") for (int dt = 0; dt < 4; ++dt) { const LAS unsigned char* vp = L + O_VT + (dt * 16 + ql) * VST + colA * 2; \
                    const u2 va = *(const LAS u2*)vp, vb = *(const LAS u2*)(vp + 32); \
                    u4 vw; vw.x = va.x; vw.y = va.y; vw.z = vb.x; vw.w = vb.y; vfr[s2][dt] = __builtin_bit_cast(bf16x8, vw); } } \
            __builtin_amdgcn_sched_barrier(0); \
            _Pragma("unroll") for (int s2 = 0; s2 < 2; ++s2) _Pragma("unroll") for (int dt = 0; dt < 4; ++dt) O[dt] = MFMA16(vfr[s2][dt], pfr[2 * sh + s2], O[dt]); } \
        __builtin_amdgcn_sched_barrier(0); }
#define NA_FINISH() { lsum += __shfl_xor(lsum, 16); lsum += __shfl_xor(lsum, 32); const float inv = 1.0f / lsum; \
        bf16* op = c.CAT() + (size_t)(qrow0 + ql) * D + h * 64 + 4 * kg; \
        _Pragma("unroll") for (int dt = 0; dt < 4; ++dt) { u2 o; o.x = pk2(O[dt][0] * inv, O[dt][1] * inv); o.y = pk2(O[dt][2] * inv, O[dt][3] * inv); *(u2*)(op + dt * 16) = o; } }
    if (lat) {
        const int c0 = min(max(16 * g - 8, 0), 32), cq = 16 * g + ql, cs = min(max(cq - 8, 0), 48);
        bool vld[8];
#pragma unroll
        for (int i = 0; i < 8; ++i) vld[i] = (unsigned)(c0 + 16 * (i >> 2) + 4 * kg + (i & 3) - cs) < 16u;
        bf16x8 kf[8][2];
        int rs = min(max(r - 4, 0), 56);
        const unsigned loff = (unsigned)(ql * NP + kg * 8) * 2u;
        NA_LOADK(0, rs)
#define NA_TASK(FIRST) { \
            const LAS float* rpl = RPB + ((rs - r + 7) * 31 + (c0 + 4 * kg - cq + 15)); \
            const int rsn = min(max(r - 2, 0), 56); \
            float m = -INFINITY, lsum = 0.f; \
            f32x4 O[4]; \
            _Pragma("unroll") for (int dt = 0; dt < 4; ++dt) O[dt] = (f32x4){0.f, 0.f, 0.f, 0.f}; \
            NA_CHUNK(2, ) \
            NA_CHUNK(0, NA_LOADK(1, rs)) \
            NA_CHUNK(3, ) \
            NA_CHUNK(1, if (FIRST) { NA_LOADK(0, rsn) const bf16* qp = P + (size_t)(qrow0 + 128 + ql) * NP + PC_NAQ + h * 64 + kg * 8; qf0 = *(const bf16x8*)qp; qf1 = *(const bf16x8*)(qp + 32); }) \
            NA_FINISH() \
            r += 2; rs = rsn; qrow0 += 128; }
        NA_TASK(1)
        if (c.tid == 0) nxt = (int)atomicAdd(qhead, 1u);
        NA_TASK(0)
#undef NA_TASK
    } else {
        const int rs = 0, c0 = 0; const LAS float* rpl = RPB; const bool vld[8] = {true, true, true, true, true, true, true, true};
        float m = -INFINITY, lsum = 0.f;
        f32x4 O[4];
#pragma unroll
        for (int dt = 0; dt < 4; ++dt) O[dt] = (f32x4){0.f, 0.f, 0.f, 0.f};
        bf16x8 kf[8][2];
        if (c.tid == 0) nxt = (int)atomicAdd(qhead, 1u);
        NA_CHUNK(2, ) NA_CHUNK(3, )
        NA_FINISH()
    }
#undef NA_LOADK
#undef NA_QK_G
#undef NA_QK_L
#undef NA_CHUNK
#undef NA_FINISH
}
#ifndef TPROBE
#define TPROBE -1
#endif
#define TP_MARK(k) do { if (TPROBE >= 0 && l == 0 && c.tid == 0) atomicMax(c.ctl() + CW_TP + 64 * (k), (unsigned)(wall_clock64() - tp0)); } while (0)
__device__ __forceinline__ void ph_scan_na3(const Ctx& c, int l) {
    const unsigned long long tp0 = TPROBE >= 0 ? wall_clock64() : 0ull;
    for (int bt = blockIdx.x; bt < 96; bt += gridDim.x) { const int kind = bt >= 32, bq = kind ? bt - 32 : bt;
        const int dir = kind ? (bq >> 5) & 1 : (bq >> 4) & 1, b = kind ? (bq >> 4) & 1 : (bq >> 3) & 1, h = kind ? (bq >> 2) & 3 : (bq >> 1) & 3, eh = kind ? bq & 3 : bq & 1;
        if (kind == 0) { gla_scan3(c, b, h, dir, eh); __syncthreads(); TP_MARK(0); }
        else { gdn_scan2<0>(c, b, h, dir, eh); __syncthreads(); TP_MARK(1); } }
    const int nunit = 512 + (l == 0 ? 64 : 0);
    int* sh = (int*)(c.lds + MISC_OFF + 64);
    unsigned* qhead = c.ctl() + CW_NAQ + 64 * (l + 2 * c.rep);
    int nxt = 0; if (c.tid == 0) nxt = (int)atomicAdd(qhead, 1u);
    for (;;) {
        __syncthreads();
        if (c.tid == 0) *sh = nxt;
        __syncthreads();
        const int u = __builtin_amdgcn_readfirstlane(*sh);
        if (u >= nunit) break;
        if (TPROBE == 3 && l == 0 && u == 0) { const unsigned long long t1 = wall_clock64(); na_unit(c, l, u, nxt, qhead); __syncthreads(); if (c.tid == 0) atomicMax(c.ctl() + CW_TP + 64 * 3, (unsigned)(wall_clock64() - t1)); }
#ifndef NO_NA
        else na_unit(c, l, u, nxt, qhead);
#endif
    }
    TP_MARK(2);
}

__device__ __forceinline__ void ctx_outproj(const Ctx& c) {
    int tid = c.tid; asm volatile("" : "+v"(tid));
    const int lane = tid & 63, w = __builtin_amdgcn_readfirstlane(tid >> 6), fr = lane & 15, fq = lane >> 4;
    for (int tile = blockIdx.x; tile < 256; tile += gridDim.x) {
        const int mt = tile >> 5, nt = tile & 31, r0 = ML + mt * 64 + (w & 3) * 16, n0 = nt * 64 + (w >> 2) * 32;
        const bf16* ap = c.CAT() + (size_t)(r0 + fr) * D + fq * 8;
        const bf16* bp0 = c.WOUT() + (size_t)(n0 + fr) * D + fq * 8; const bf16* bp1 = bp0 + (size_t)16 * D;
        f32x4 acc0 = {0.f, 0.f, 0.f, 0.f}, acc1 = {0.f, 0.f, 0.f, 0.f};
        bf16x8 pa[2][4], pb0[2][4], pb1[2][4];
#define CO_LOAD(P, KB) { _Pragma("unroll") for (int i = 0; i < 4; ++i) { const int ko = ((KB) * 4 + i) * 32; pa[P][i] = *(const bf16x8*)(ap + ko); pb0[P][i] = *(const bf16x8*)(bp0 + ko); pb1[P][i] = *(const bf16x8*)(bp1 + ko); } }
#define CO_MMA(P) { _Pragma("unroll") for (int i = 0; i < 4; ++i) { acc0 = MFMA16(pb0[P][i], pa[P][i], acc0); acc1 = MFMA16(pb1[P][i], pa[P][i], acc1); } }
        CO_LOAD(0, 0)
#pragma unroll 1
        for (int kb = 0; kb < 16; kb += 2) {
            CO_LOAD(1, kb + 1)
            __builtin_amdgcn_sched_barrier(0);
            CO_MMA(0)
            __builtin_amdgcn_sched_barrier(0);
            { const int kn = kb + 2 < 16 ? kb + 2 : 15; CO_LOAD(0, kn) }
            __builtin_amdgcn_sched_barrier(0);
            CO_MMA(1)
            __builtin_amdgcn_sched_barrier(0);
        }
#undef CO_LOAD
#undef CO_MMA
        const int row = r0 + fr; float* dst = c.HX() + (size_t)row * D; const float* src = c.ctxin() + (size_t)(row - ML) * D; const float* g1 = c.MOD() + (size_t)2 * MODW + 2 * D;
        { const int col = n0 + 4 * fq; *(f32x4*)(dst + col) = *(const f32x4*)(src + col) + *(const f32x4*)(g1 + col) * acc0; }
        { const int col = n0 + 16 + 4 * fq; *(f32x4*)(dst + col) = *(const f32x4*)(src + col) + *(const f32x4*)(g1 + col) * acc1; }
    }
}
constexpr int NPH_LAYER = 12, NPHASES = 2 + 2 * NPH_LAYER;
__global__ void __launch_bounds__(NTHREADS, 2) fwd(Params p) {
    extern __shared__ __attribute__((aligned(16))) unsigned char lds[];
    Ctx cb;
    cb.lds = lds; cb.tid = threadIdx.x; cb.lane = cb.tid & 63; cb.wave = __builtin_amdgcn_readfirstlane(cb.tid >> 6);
    cb.gw = blockIdx.x * NWAVES + cb.wave; cb.ngw = gridDim.x * NWAVES;
    cb.kp = (KParams)__builtin_amdgcn_kernarg_segment_ptr(); cb.ws = p.ws;
    LAS unsigned char* ldsl = (LAS unsigned char*)lds;
    volatile LAS unsigned* MISC = (volatile LAS unsigned*)(ldsl + MISC_OFF);
    if (cb.tid < 64) MISC[cb.tid] = 0u;
    __syncthreads();
    const int lo = p.ph_lo, hi = p.ph_hi;
    XcdBarrier bar; bar.bar = cb.ctl() + CW_BAR; bar.x = 0; bar.st = MISC;
    if (hi - lo > 1) bar = xcd_barrier_post(cb.ctl() + CW_BAR, MISC);
#ifndef REPMASK
#define REPMASK 0
#endif
#ifndef PHMASK
#define PHMASK 0xffff
#endif
#define RUN(ty, k, ...) do { if constexpr (((PHMASK) >> (ty)) & 1) { if (lo <= (k) && (k) < hi) for (int rep_ = 0; rep_ < ((((REPMASK) >> (ty)) & 1) ? 2 : 1); ++rep_) { Ctx c = cb; c.rep = rep_; asm volatile("" : "+s"(c.ws)); asm volatile("" : "+s"(c.kp)); asm volatile("" : "+v"(c.tid)); c.lane = c.tid & 63; c.wave = __builtin_amdgcn_readfirstlane(c.tid >> 6); c.gw = blockIdx.x * NWAVES + c.wave; __VA_ARGS__; if ((k) + 1 < hi || rep_ == 0 && ((((REPMASK) >> (ty)) & 1))) xcd_barrier(bar); } } } while (0)
    RUN(0, 0, ph_prologue(c));
    for (int l = 0; l < 2; ++l) {
        const int pb = 1 + NPH_LAYER * l;
        RUN(1, pb + 0, ph_norm1(c, l));
        RUN(2, pb + 1, { pg8::Gemm g{c.NX(), c.WIN() + (size_t)l * NP * D, MROWS, NP, D}; pg8::StaticOrder S; S.init(MROWS, NP, (int)gridDim.x, (int)blockIdx.x); EpiP E{c.P(), c.PS()};
                      pg8::gemm_phase<EpiP, pg8::StaticOrder>(ldsl, g, S, E, nullptr); });
        RUN(3, pb + 2, ph_prep(c, l));
        RUN(4, pb + 3, ph_gdn_chunk(c, l));
        RUN(5, pb + 4, ph_scan_na3(c, l));
        RUN(6, pb + 5, ph_combine2(c, l));
        RUN(7, pb + 6, { pg8::Gemm g{c.CAT(), c.WOUT() + (size_t)l * D * D, MROWS, D, D}; pg8::StaticOrder S; S.init(ML, D, (int)gridDim.x, (int)blockIdx.x); EpiResid E{c.x(), c.ctxin(), c.MOD(), c.HX(), l};
                      pg8::gemm_phase<EpiResid, pg8::StaticOrder>(ldsl, g, S, E, nullptr); if (l == 0) ctx_outproj(c); });
        RUN(8, pb + 7, ph_norm2_router(c, l));
        RUN(9, pb + 8, ph_topk(c, l));
        RUN(10, pb + 9, ph_gather(c, l));
        RUN(11, pb + 10, { MoeOrder S{l == 0 ? 5 : 4, 16, (int)gridDim.x, (int)blockIdx.x};
                      if (!(((F8MASK) >> l) & 1)) { pg8::Gemm g{c.AMOE(), c.WGU() + (size_t)l * NE * 4096 * D, NE * ESLOT, NE * 4096, D}; EpiSwiglu E{c.HID()};
                          pg8::gemm_phase<EpiSwiglu, MoeOrder>(ldsl, g, S, E, nullptr); }
                      else { pg8::Gemm g{c.AMOE(), c.WGU() + (size_t)l * NE * 4096 * D, NE * ESLOT, NE * 4096, D / 2}; EpiSwiglu8 E{(unsigned char*)c.HID()};
                          pg8::gemm_phase<EpiSwiglu8, MoeOrder, false, true>(ldsl, g, S, E, nullptr); } });
        RUN(12, pb + 11, { MoeOrder S{l == 0 ? 5 : 4, 8, (int)gridDim.x, (int)blockIdx.x}; EpiY E{c.Y()};
                      if (!(((F8MASK) >> l) & 1)) { pg8::Gemm g{c.HID(), c.WDN() + (size_t)l * NE * D * FF, NE * ESLOT, NE * D, FF};
                          pg8::gemm_phase<EpiY, MoeOrder>(ldsl, g, S, E, nullptr); }
                      else { pg8::Gemm g{c.HID(), c.WDN() + (size_t)l * NE * D * FF, NE * ESLOT, NE * D, FF / 2};
                          pg8::gemm_phase<EpiY, MoeOrder, false, true>(ldsl, g, S, E, nullptr); } });
    }
    RUN(13, NPHASES - 1, ph_final(c));
#undef RUN
}

extern "C" void kernel_launch(void* const* d_in, const int* in_sizes, int n_in, void* d_out, int out_size, void* d_ws, size_t ws_size, hipStream_t stream) {
    static int grid = 0;
    if (grid == 0) {
        if (n_in != 23 || ws_size < WS_END) { fprintf(stderr, "kernel_launch: need 23 inputs and %zu bytes of workspace (got %d, %zu)\n", (size_t)WS_END, n_in, ws_size); grid = -1; return; }
        int dev = 0, cus = 0, per_cu = 0;
        if (hipGetDevice(&dev) != hipSuccess || hipDeviceGetAttribute(&cus, hipDeviceAttributeMultiprocessorCount, dev) != hipSuccess) { grid = -1; return; }
        if (hipFuncSetAttribute((const void*)fwd, hipFuncAttributeMaxDynamicSharedMemorySize, LDS_BYTES) != hipSuccess) { fprintf(stderr, "kernel_launch: hipFuncSetAttribute failed\n"); grid = -1; return; }
        if (hipOccupancyMaxActiveBlocksPerMultiprocessor(&per_cu, (const void*)fwd, NTHREADS, LDS_BYTES) != hipSuccess || per_cu < 1) { fprintf(stderr, "kernel_launch: occupancy query says %d\n", per_cu); per_cu = 1; }
        grid = cus;
    }
    if (grid <= 0) return;
    hipMemsetAsync((char*)d_ws + WS_CTL, 0, CTL_BYTES, stream);
    Params p; memset(&p, 0, sizeof(p));
    for (int i = 0; i < 23; ++i) p.in[i] = (GASP const float*)d_in[i];
    p.out = (GASP float*)d_out; p.ws = (GASP unsigned char*)d_ws;
#if ONE_LAUNCH
    p.ph_lo = 0; p.ph_hi = NPHASES;
    hipLaunchKernelGGL(fwd, dim3(grid), dim3(NTHREADS), LDS_BYTES, stream, p);
#else
    for (int k = 0; k < NPHASES; ++k) { p.ph_lo = k; p.ph_hi = k + 1; hipLaunchKernelGGL(fwd, dim3(grid), dim3(NTHREADS), LDS_BYTES, stream, p); }
#endif
}
```
